# Optimizing an MI355X kernel written in HIP

```python
import jax, jax.numpy as jnp
from jax import lax
import numpy as np

D_MODEL = 1024
BATCH = 4
SEQ = 8192
DEPTH = 2

GRID_W = 64
CTX_LEN = 256
N_MIXERS = 2
CHUNK = 128
D_FF = 2816
FFN_RES = 0.5
NORM_EPS = 1e-6
N_MOD = 9

M_HEADS = 8
M_DK = D_MODEL // 16
M_DV = D_MODEL // M_HEADS
M_QK = M_HEADS * M_DK
M_V = M_HEADS * M_DV
CONV_W = 5
M_IN = 2 * M_QK + 2 * M_V + 4 * M_HEADS
M_INIT = -1e30

R_HEADS = 4
R_DK = D_MODEL // R_HEADS
R_DV = 2 * R_DK
R_QK = R_HEADS * R_DK
R_V = R_HEADS * R_DV
R_IN = 2 * R_QK + 2 * R_V
ROPE_BASE = 10000.0

N_A = (DEPTH + 1) // 2
N_B = DEPTH // 2

kernel_name = "hybrid_mlstm_retention_macaron_dit"

F32 = jnp.float32


def rmsnorm(h, g):
    hf = h.astype(F32)
    y = hf * lax.rsqrt(jnp.mean(hf * hf, axis=-1, keepdims=True) + NORM_EPS)
    return (y * g.astype(F32)).astype(h.dtype)


def modnorm(h, g, mod, j):
    return rmsnorm(h, g) * (1 + mod[:, :, 3 * j + 1]) + mod[:, :, 3 * j]


def swiglu(h, w13, w2):
    a, b = jnp.split(h @ w13, 2, axis=-1)
    return (jax.nn.silu(a) * b) @ w2


def half_ffn(h, mod, g, w13, w2, j):
    return h + FFN_RES * mod[:, :, 3 * j + 2] * swiglu(modnorm(h, g, mod, j), w13, w2)


def to_heads(a, n_heads):
    B, T, _ = a.shape
    return a.reshape(B, T, n_heads, -1).transpose(0, 2, 1, 3)


def head_norm(o):
    mu = jnp.mean(o, axis=-1, keepdims=True)
    var = jnp.mean(jnp.square(o - mu), axis=-1, keepdims=True)
    o = (o - mu) * lax.rsqrt(var + NORM_EPS)
    B, H, T, d = o.shape
    return o.transpose(0, 2, 1, 3).reshape(B, T, H * d)


def to_chunks(a):
    B, H, T = a.shape[:3]
    a = a.reshape(B, H, T // CHUNK, CHUNK, *a.shape[3:])
    return jnp.moveaxis(a, 2, 0)


def from_chunks(a):
    a = jnp.moveaxis(a, 0, 2)
    return a.reshape(a.shape[0], a.shape[1], -1, *a.shape[4:])


def centred_dwconv(a, w):
    C = a.shape[-1]
    return lax.conv_general_dilated(
        a, w[:, None, :].astype(a.dtype), window_strides=(1,),
        padding=[(CONV_W // 2, CONV_W // 2)],
        dimension_numbers=("NWC", "WIO", "NWC"), feature_group_count=C)


def run_bidirectional(scan_fw, scan_bw, ctx_fw, ctx_bw, lat_fw, lat_bw, init):
    flip = lambda xs: tuple(jnp.flip(a, axis=2) for a in xs)
    oc_f, st_f = scan_fw(ctx_fw, init)
    ox_f, _ = scan_fw(lat_fw, st_f)
    oc_b, st_b = scan_bw(flip(ctx_bw), init)
    ox_b, _ = scan_bw(flip(lat_bw), st_b)
    return oc_f + jnp.flip(oc_b, axis=2), ox_f + jnp.flip(ox_b, axis=2)


def mlstm_scan(inputs, state):
    tri = jnp.tril(jnp.ones((CHUNK, CHUNK), dtype=bool))

    def step(carry, inp):
        C, n, m = carry
        q, k, v, ig, lf = inp
        b = jnp.cumsum(lf, axis=-1)
        a = b + m[..., None]
        d = jnp.where(tri, b[..., :, None] - b[..., None, :] + ig[..., None, :], -jnp.inf)
        m_t = jnp.maximum(a, jnp.max(d, axis=-1))
        w_inter = jnp.exp(a - m_t)
        s = jnp.einsum("bhtd,bhsd->bhts", q, k) * jnp.exp(d - m_t[..., None])
        num = w_inter[..., None] * jnp.einsum("bhtd,bhde->bhte", q, C) + jnp.einsum("bhts,bhse->bhte", s, v)
        den = w_inter * jnp.einsum("bhtd,bhd->bht", q, n) + jnp.sum(s, axis=-1)
        h = num / jnp.maximum(jnp.abs(den), jnp.exp(-m_t))[..., None]
        g_prev = b[..., -1] + m
        g_s = b[..., -1:] - b + ig
        m_new = jnp.maximum(g_prev, jnp.max(g_s, axis=-1))
        w_prev = jnp.exp(g_prev - m_new)
        w_s = jnp.exp(g_s - m_new[..., None])
        C = w_prev[..., None, None] * C + jnp.einsum("bhs,bhsd,bhse->bhde", w_s, k, v)
        n = w_prev[..., None] * n + jnp.einsum("bhs,bhsd->bhd", w_s, k)
        return (C, n, m_new), h

    state, h = lax.scan(step, state, tuple(to_chunks(a) for a in inputs))
    return from_chunks(h), state


def retention_scan(inputs, R, lg):
    pos = jnp.arange(CHUNK, dtype=F32)
    diff = pos[:, None] - pos[None, :]
    dec = jnp.exp(jnp.where(diff >= 0, diff[None] * lg[:, None, None], -jnp.inf))
    xi = jnp.exp((pos[None] + 1.0) * lg[:, None])
    zeta = jnp.exp((CHUNK - 1.0 - pos)[None] * lg[:, None])
    g_chunk = jnp.exp(CHUNK * lg)

    def step(R, inp):
        q, k, v = inp
        s = jnp.einsum("bhtd,bhsd->bhts", q, k) * dec
        o = jnp.einsum("bhts,bhse->bhte", s, v) + jnp.einsum("bhtd,bhde->bhte", q, R) * xi[..., None]
        R = g_chunk[:, None, None] * R + jnp.einsum("bhsd,bhse->bhde", k * zeta[..., None], v)
        return R, o

    R, o = lax.scan(step, R, tuple(to_chunks(a) for a in inputs))
    return from_chunks(o), R


def axial_rope(a, rows):
    n_pairs = a.shape[-1] // 2
    n_f = n_pairs // 2
    inv = jnp.power(ROPE_BASE, -jnp.arange(n_f, dtype=F32) / n_f)
    row = jnp.broadcast_to(jnp.arange(rows, dtype=F32)[:, None], (rows, GRID_W)).reshape(-1)
    col = jnp.broadcast_to(jnp.arange(GRID_W, dtype=F32)[None, :], (rows, GRID_W)).reshape(-1)
    ang = jnp.concatenate([row[:, None] * inv, col[:, None] * inv], axis=-1)
    cos, sin = jnp.cos(ang), jnp.sin(ang)
    ap = a.reshape(*a.shape[:-1], n_pairs, 2)
    ae, ao = ap[..., 0], ap[..., 1]
    return jnp.stack([ae * cos - ao * sin, ae * sin + ao * cos], axis=-1).reshape(a.shape)


def mlstm_mixer(hc, hx, w_in, gate_b, conv_w, norm_g, w_out, with_ctx_out):
    def project(h):
        B, T, _ = h.shape
        u = h @ w_in
        qk, v, o, gates = jnp.split(u, [2 * M_QK, 2 * M_QK + M_V, 2 * M_QK + 2 * M_V], axis=-1)
        qk = jax.nn.silu(centred_dwconv(qk, conv_w))
        q, k = jnp.split(qk, 2, axis=-1)
        q = to_heads(q, M_HEADS).astype(F32)
        k = to_heads(k, M_HEADS).astype(F32) * (M_DK ** -0.5)
        v = to_heads(v, M_HEADS).astype(F32)
        g = (gates + gate_b).astype(F32).reshape(B, T, 4, M_HEADS).transpose(2, 0, 3, 1)
        fw = (q, k, v, g[0], jax.nn.log_sigmoid(g[1]))
        bw = (q, k, v, g[2], jax.nn.log_sigmoid(g[3]))
        return fw, bw, o

    c_fw, c_bw, oc = project(hc)
    x_fw, x_bw, ox = project(hx)
    B = hx.shape[0]
    init = (jnp.zeros((B, M_HEADS, M_DK, M_DV), F32), jnp.zeros((B, M_HEADS, M_DK), F32),
            jnp.full((B, M_HEADS), M_INIT, F32))
    hc_sum, hx_sum = run_bidirectional(mlstm_scan, mlstm_scan, c_fw, c_bw, x_fw, x_bw, init)

    def out(hs, o, ref):
        y = head_norm(hs) * norm_g.astype(F32) * jax.nn.sigmoid(o.astype(F32))
        return y.astype(ref.dtype) @ w_out

    yx = out(hx_sum, ox, hx)
    yc = out(hc_sum, oc, hc) if with_ctx_out else None
    return yx, yc


def retention_mixer(hc, hx, rows, w_in, decay_logit, norm_g, w_out, with_ctx_out):
    def project(h, rope):
        u = h @ w_in
        q, k, v, g = jnp.split(u, [R_QK, 2 * R_QK, 2 * R_QK + R_V], axis=-1)
        q = to_heads(q, R_HEADS).astype(F32)
        k = to_heads(k, R_HEADS).astype(F32) * (R_DK ** -0.5)
        v = to_heads(v, R_HEADS).astype(F32)
        if rope:
            q, k = axial_rope(q, rows), axial_rope(k, rows)
        return (q, k, v), g

    lg = jax.nn.log_sigmoid(decay_logit.astype(F32))
    c_in, gc = project(hc, False)
    x_in, gx = project(hx, True)
    B = hx.shape[0]
    init = jnp.zeros((B, R_HEADS, R_DK, R_DV), F32)
    scan_fw = lambda inp, st: retention_scan(inp, st, lg[0])
    scan_bw = lambda inp, st: retention_scan(inp, st, lg[1])
    oc_sum, ox_sum = run_bidirectional(scan_fw, scan_bw, c_in, c_in, x_in, x_in, init)

    def out(o, g, ref):
        y = head_norm(o) * norm_g.astype(F32) * jax.nn.silu(g.astype(F32))
        return y.astype(ref.dtype) @ w_out

    yx = out(ox_sum, gx, hx)
    yc = out(oc_sum, gc, hc) if with_ctx_out else None
    return yx, yc


def setup_inputs(seed: int = 0) -> dict:
    key = jax.random.key(seed)
    ks = jax.random.split(key, 20)
    nrm = lambda k, shape, s: jax.random.normal(k, shape, F32) * s
    x = nrm(ks[0], (BATCH, SEQ, D_MODEL), 1.0)
    c = nrm(ks[1], (BATCH, D_MODEL), 1.0)
    ctx = nrm(ks[2], (BATCH, CTX_LEN, D_MODEL), 1.0)
    c_ctx = nrm(ks[3], (D_MODEL,), 1.0)
    mod_w = nrm(ks[4], (DEPTH, D_MODEL, N_MOD * D_MODEL), 0.5 * D_MODEL ** -0.5)
    mod_b = nrm(ks[5], (DEPTH, N_MOD * D_MODEL), 0.01)
    norm_g = 1.0 + nrm(ks[6], (DEPTH, 3, D_MODEL), 0.01)
    ffn_w13 = nrm(ks[7], (DEPTH, 2, D_MODEL, 2 * D_FF), D_MODEL ** -0.5)
    ffn_w2 = nrm(ks[8], (DEPTH, 2, D_FF, D_MODEL), D_FF ** -0.5)
    m_w_in = nrm(ks[9], (N_A, D_MODEL, M_IN), D_MODEL ** -0.5)
    f_bias = jnp.linspace(3.0, 6.0, M_HEADS, dtype=F32)
    zero_h = jnp.zeros((M_HEADS,), F32)
    m_gate_b = jnp.concatenate([zero_h, f_bias, zero_h, f_bias]) + nrm(ks[10], (N_A, 4 * M_HEADS), 0.1)
    m_conv_w = nrm(ks[11], (N_A, CONV_W, 2 * M_QK), CONV_W ** -0.5)
    m_norm_g = 1.0 + nrm(ks[12], (N_A, M_V), 0.01)
    m_w_out = nrm(ks[13], (N_A, M_V, D_MODEL), M_V ** -0.5)
    r_w_in = nrm(ks[14], (N_B, D_MODEL, R_IN), D_MODEL ** -0.5)
    decay0 = jnp.log(jnp.exp2(5.0 + jnp.arange(R_HEADS, dtype=F32)) - 1.0)
    r_decay = decay0 + nrm(ks[15], (N_B, 2, R_HEADS), 0.05)
    r_norm_g = 1.0 + nrm(ks[16], (N_B, R_V), 0.01)
    r_w_out = nrm(ks[17], (N_B, R_V, D_MODEL), R_V ** -0.5)
    final_g = 1.0 + nrm(ks[18], (D_MODEL,), 0.01)
    return {"x": x, "c": c, "ctx": ctx, "c_ctx": c_ctx, "mod_w": mod_w, "mod_b": mod_b,
            "norm_g": norm_g, "ffn_w13": ffn_w13, "ffn_w2": ffn_w2, "m_w_in": m_w_in,
            "m_gate_b": m_gate_b, "m_conv_w": m_conv_w, "m_norm_g": m_norm_g, "m_w_out": m_w_out,
            "r_w_in": r_w_in, "r_decay": r_decay, "r_norm_g": r_norm_g, "r_w_out": r_w_out,
            "final_g": final_g}


def reference(x, c, ctx, c_ctx, mod_w, mod_b, norm_g, ffn_w13, ffn_w2, m_w_in, m_gate_b, m_conv_w,
              m_norm_g, m_w_out, r_w_in, r_decay, r_norm_g, r_w_out, final_g):
    B, T, D = x.shape
    rows = T // GRID_W
    sc = jax.nn.silu(c)
    scc = jax.nn.silu(c_ctx)
    for i in range(DEPTH):
        mod_x = (sc @ mod_w[i] + mod_b[i]).reshape(B, 1, N_MOD, D)
        mod_c = (scc @ mod_w[i] + mod_b[i]).reshape(1, 1, N_MOD, D)
        last = i == DEPTH - 1
        j = i // N_MIXERS
        x = half_ffn(x, mod_x, norm_g[i, 0], ffn_w13[i, 0], ffn_w2[i, 0], 0)
        ctx = half_ffn(ctx, mod_c, norm_g[i, 0], ffn_w13[i, 0], ffn_w2[i, 0], 0)
        hx = modnorm(x, norm_g[i, 1], mod_x, 1)
        hc = modnorm(ctx, norm_g[i, 1], mod_c, 1)
        if i % N_MIXERS == 0:
            yx, yc = mlstm_mixer(hc, hx, m_w_in[j], m_gate_b[j], m_conv_w[j], m_norm_g[j], m_w_out[j], not last)
        else:
            yx, yc = retention_mixer(hc, hx, rows, r_w_in[j], r_decay[j], r_norm_g[j], r_w_out[j], not last)
        x = x + mod_x[:, :, 5] * yx
        x = half_ffn(x, mod_x, norm_g[i, 2], ffn_w13[i, 1], ffn_w2[i, 1], 2)
        if not last:
            ctx = ctx + mod_c[:, :, 5] * yc
            ctx = half_ffn(ctx, mod_c, norm_g[i, 2], ffn_w13[i, 1], ffn_w2[i, 1], 2)
    return rmsnorm(x, final_g)
```

```cpp
#include <hip/hip_runtime.h>
#include <hip/hip_cooperative_groups.h>
#include <cstdio>
#include <cstring>
namespace cg = cooperative_groups;

typedef unsigned short u16;
typedef short bf16x8 __attribute__((ext_vector_type(8)));
typedef short s16x4 __attribute__((ext_vector_type(4)));
typedef float f32x4 __attribute__((ext_vector_type(4)));
typedef unsigned u32x4 __attribute__((ext_vector_type(4)));
typedef unsigned u32x2 __attribute__((ext_vector_type(2)));
#define LAS __attribute__((address_space(3)))
typedef LAS unsigned char* ldsp;

#define NT 33792
#define NL 32768
#define LDS_BYTES 155648

enum { PH_INIT = 0, PH_NORM, PH_GEMM, PH_MCONV, PH_MA, PH_MB, PH_MC, PH_RA, PH_RB, PH_RC, PH_FINAL, PH_NOP };
enum { EPI_SWIGLU = 0, EPI_RESID, EPI_MLSTM_U, EPI_RET_U, EPI_GATE };

struct Phase { int type, M, N, K; int i0, i1; float f0; int pad; const void* A; const void* B; void* O; const void* X; };
#define MAXPH 56
#ifndef SPLITF
#define SPLITF 1
#endif
#define NSPL (SPLITF ? 11 : 0)
#ifndef DUP_TYPES
#define DUP_TYPES 0u
#endif
#ifndef DUP_EPIS
#define DUP_EPIS 0u
#endif
struct Ctx {
  const float *x, *c, *ctx, *c_ctx, *mod_w, *mod_b, *norm_g, *w13, *w2, *m_w_in, *m_gate_b, *m_conv_w, *m_norm_g, *m_w_out, *r_w_in, *r_decay, *r_norm_g, *r_w_out, *final_g;
  float* out; float* modv; float* rope; float* gates; float* mst_n; float* mst_s; float* xr;
  u16* hb; u16* wb; u16* big; u16* y; unsigned* bar; float* part; float* part2;
};
struct Params { Ctx c; int nph; int pad; Phase ph[MAXPH]; };

typedef __bf16 bf16x2_t __attribute__((ext_vector_type(2)));
__device__ __forceinline__ u16 f2bf(float f) { return __builtin_bit_cast(u16, (__bf16)f); }
__device__ __forceinline__ float bf2f(u16 b) { return __uint_as_float(((unsigned)b) << 16); }
__device__ __forceinline__ unsigned pack2(float a, float b) { bf16x2_t v; v[0] = (__bf16)a; v[1] = (__bf16)b; return __builtin_bit_cast(unsigned, v); }
__device__ __forceinline__ float lo2f(unsigned w) { return __uint_as_float(w << 16); }
__device__ __forceinline__ float hi2f(unsigned w) { return __uint_as_float(w & 0xffff0000u); }
__device__ __forceinline__ float4 ldnt4(const float4* p) { const f32x4 v = __builtin_nontemporal_load((const f32x4*)p); return make_float4(v[0], v[1], v[2], v[3]); }
__device__ __forceinline__ void stnt4(float4* p, float4 v) { f32x4 t; t[0] = v.x; t[1] = v.y; t[2] = v.z; t[3] = v.w; __builtin_nontemporal_store(t, (f32x4*)p); }
__device__ __forceinline__ float siluf(float a) { return a * __builtin_amdgcn_rcpf(1.f + __expf(-a)); }
__device__ __forceinline__ float sigmf(float a) { return __builtin_amdgcn_rcpf(1.f + __expf(-a)); }
__device__ __forceinline__ float logsig(float a) { return fminf(a, 0.f) - log1pf(expf(-fabsf(a))); }

__device__ __forceinline__ bf16x8 frag_row(ldsp base, int pitch, int idx0, int k0, int lane) {
  return *(const LAS bf16x8*)(base + (idx0 + (lane & 15)) * pitch + (k0 + 8 * (lane >> 4)) * 2);
}
__device__ __forceinline__ bf16x8 frag_tr(ldsp base, int pitch, int idx0, int k0, int lane) {
  const int g = lane >> 4, li = lane & 15, q = li >> 2, p = li & 3;
  ldsp a = base + (k0 + 8 * g + q) * pitch + (idx0 + 4 * p) * 2;
  s16x4 lo = __builtin_amdgcn_ds_read_tr16_b64_v4i16((LAS s16x4*)a);
  s16x4 hi = __builtin_amdgcn_ds_read_tr16_b64_v4i16((LAS s16x4*)(a + 4 * pitch));
  bf16x8 r; r[0] = lo[0]; r[1] = lo[1]; r[2] = lo[2]; r[3] = lo[3]; r[4] = hi[0]; r[5] = hi[1]; r[6] = hi[2]; r[7] = hi[3]; return r;
}
#define LDS_BAR() do { asm volatile("s_waitcnt lgkmcnt(0)" ::: "memory"); __builtin_amdgcn_s_barrier(); asm volatile("" ::: "memory"); } while (0)
#define SWEEP(NT, DEPTH, FRAG, A, ACC) do { bf16x8 bq_[DEPTH]; \
    _Pragma("unroll") for (int n_ = 0; n_ < DEPTH; ++n_) bq_[n_] = FRAG(n_); __builtin_amdgcn_sched_barrier(0); \
    _Pragma("unroll") for (int n_ = 0; n_ < NT; ++n_) { const bf16x8 cur_ = bq_[n_ % DEPTH]; if (n_ + DEPTH < NT) bq_[n_ % DEPTH] = FRAG(n_ + DEPTH); ACC[n_] = MFMA16(A, cur_, ACC[n_]); __builtin_amdgcn_sched_barrier(0); } } while (0)
#define MFMA16(a, b, c) __builtin_amdgcn_mfma_f32_16x16x32_bf16((a), (b), (c), 0, 0, 0)
__device__ __forceinline__ float shx(float v, int m, int lane) { return __int_as_float(__builtin_amdgcn_ds_bpermute((lane ^ m) << 2, __float_as_int(v))); }
__device__ __forceinline__ float shup(float v, int d, int lane, float ident) { const int src = lane - d; const float r = __int_as_float(__builtin_amdgcn_ds_bpermute(src << 2, __float_as_int(v))); return src >= 0 ? r : ident; }
__device__ __forceinline__ float shdn(float v, int d, int lane, float ident) { const int src = lane + d; const float r = __int_as_float(__builtin_amdgcn_ds_bpermute(src << 2, __float_as_int(v))); return src < 64 ? r : ident; }
__device__ __forceinline__ float lane63(float v) { return __int_as_float(__builtin_amdgcn_readlane(__float_as_int(v), 63)); }
__device__ __forceinline__ float red16l(float v, int lane) { v += shx(v, 1, lane); v += shx(v, 2, lane); v += shx(v, 4, lane); v += shx(v, 8, lane); return v; }

namespace pg8 {
constexpr int BM = 256, BK = 64, HALF = 128, HTB = HALF * BK * 2, NXCD = 8, WGM = 8;
__device__ __forceinline__ int lds_byte(int r, int c) { const int st = (r >> 4) * 2 + (c >> 5), rr = r & 15, cc = c & 31, ob = rr * 64 + cc * 2; return st * 1024 + (ob ^ (((ob >> 9) & 1) << 5)); }
__device__ __forceinline__ void stage_rc(int b, int& R, int& C) { const int st = b / 1024, sb = b % 1024, swz = sb ^ (((sb >> 9) & 1) << 5); R = (st >> 1) * 16 + swz / 64; C = (st & 1) * 32 + (swz % 64) / 2; }
struct Unit { int pm, pn, k0, nt, at; };
struct StaticOrder {
  int nM, nN, nwg, G, c, nsplit, nsu, ntf;
  __device__ void init(int M, int N, int K, int split, int G_, int c_) { nM = M / BM; nN = N / BM; nsplit = 0; nsu = 0; ntf = K / BK;
    if (split) { nM = NL / BM; nsplit = K / 256; nsu = (M / BM - nM) * nN * nsplit; }
    nwg = nM * nN; G = G_; c = c_; }
  __device__ bool next(int i, Unit& u) const {
    const long L = (long)i * G + c;
    int pm = 0, pn = 0, k0 = 0, nt = ntf, at = 0; bool ok = true;
    if (L >= nwg) {
      const long s = L - nwg;
      if (s >= nsu) ok = false;
      else { const int ks = (int)(s % nsplit), r = (int)(s / nsplit); pn = r % nN; pm = nM + r / nN; k0 = ks * 256; nt = 4; at = ks + 1; }
    } else {
      int wgid = (int)L; { const int q = nwg / NXCD, r = nwg % NXCD, xcd = wgid % NXCD, off = wgid / NXCD; wgid = (xcd < r ? xcd * (q + 1) : r * (q + 1) + (xcd - r) * q) + off; }
      const int nig = WGM * nN, gid = wgid / nig, fm = gid * WGM, gsz = (nM - fm) < WGM ? (nM - fm) : WGM;
      pm = fm + ((wgid % nig) % gsz); pn = (wgid % nig) / gsz;
    }
    u.pm = pm; u.pn = pn; u.k0 = k0; u.nt = nt; u.at = at; return ok;
  }
};
}

__device__ __forceinline__ int perm32(int rho) { const int n = rho >> 4, i = rho & 15; return 8 * (i >> 2) + 4 * n + (i & 3); }
__device__ __forceinline__ void epi_apply(const Phase& ph, const Ctx& c, const f32x4 (&acc)[2][2][4][2], int pm, int pn, int at, int wr, int wc, int fr, int fq) {
  const int row0 = pm * 256 + wr * 64 + fr;
  const int epi = ph.i0;
  if (epi == EPI_SWIGLU) {
    u16* O = (u16*)ph.O;
    const int hc = pn * 128 + wc * 32 + fq * 8;
#pragma unroll
    for (int ai = 0; ai < 2; ++ai)
#pragma unroll
      for (int m = 0; m < 4; ++m) {
        const size_t row = row0 + ai * 128 + m * 16;
        const f32x4 a0 = acc[ai][0][m][0], b0 = acc[ai][1][m][0], a1 = acc[ai][0][m][1], b1 = acc[ai][1][m][1];
        u32x4 o; o.x = pack2(siluf(a0[0]) * b0[0], siluf(a0[1]) * b0[1]); o.y = pack2(siluf(a0[2]) * b0[2], siluf(a0[3]) * b0[3]);
        o.z = pack2(siluf(a1[0]) * b1[0], siluf(a1[1]) * b1[1]); o.w = pack2(siluf(a1[2]) * b1[2], siluf(a1[3]) * b1[3]);
        *(u32x4*)(O + row * 2816 + hc) = o;
      }
  } else if (epi == EPI_RESID) {
    float* X = (float*)ph.O; const float* gate = (const float*)ph.X; const float f0 = ph.f0;
    const int r256 = pm * 256; const int set = r256 < NL ? (r256 >> 13) : 4;
    const float* Xs = ((ph.i1 & 2) && r256 < NL) ? c.x : (const float*)X;
    gate += (size_t)set * 9216;
    if (at) {
      float* P = ((ph.i1 & 4) ? c.part2 : c.part) + ((size_t)(at - 1) * 1024 - NL) * 1024;
#pragma unroll
      for (int bj = 0; bj < 2; ++bj)
#pragma unroll
        for (int n = 0; n < 2; ++n) {
          const int col = pn * 256 + bj * 128 + wc * 32 + n * 16 + fq * 4;
#pragma unroll
          for (int ai = 0; ai < 2; ++ai)
#pragma unroll
            for (int m = 0; m < 4; ++m) { const size_t row = row0 + ai * 128 + m * 16; *(f32x4*)(P + row * 1024 + col) = acc[ai][bj][m][n]; }
        }
    } else {
#pragma unroll
      for (int bj = 0; bj < 2; ++bj)
#pragma unroll
        for (int n = 0; n < 2; ++n) {
          const int col = pn * 256 + bj * 128 + wc * 32 + n * 16 + fq * 4;
          const f32x4 g = *(const f32x4*)(gate + col);
#pragma unroll
          for (int ai = 0; ai < 2; ++ai)
#pragma unroll
            for (int m = 0; m < 4; ++m) {
              const size_t row = row0 + ai * 128 + m * 16;
              f32x4 xv = *(const f32x4*)(Xs + row * 1024 + col); const f32x4 a = acc[ai][bj][m][n];
              xv[0] += f0 * g[0] * a[0]; xv[1] += f0 * g[1] * a[1]; xv[2] += f0 * g[2] * a[2]; xv[3] += f0 * g[3] * a[3];
              *(f32x4*)(X + row * 1024 + col) = xv;
            }
        }
    }
  } else if (epi == EPI_MLSTM_U) {
    if (pn < 12) {
      u16* O = (u16*)ph.O;
#pragma unroll
      for (int ai = 0; ai < 2; ++ai)
#pragma unroll
        for (int m = 0; m < 4; ++m) {
          const size_t row = row0 + ai * 128 + m * 16;
#pragma unroll
          for (int bj = 0; bj < 2; ++bj) {
            const int col = pn * 256 + bj * 128 + wc * 32 + fq * 8; const f32x4 a0 = acc[ai][bj][m][0], a1 = acc[ai][bj][m][1];
            u32x4 o; o.x = pack2(a0[0], a0[1]); o.y = pack2(a0[2], a0[3]); o.z = pack2(a1[0], a1[1]); o.w = pack2(a1[2], a1[3]);
            *(u32x4*)(O + row * 3072 + col) = o;
          }
        }
    } else if (wc == 0) {
      float* G = c.gates; const float* gb = c.m_gate_b;
#pragma unroll
      for (int n = 0; n < 2; ++n) {
        const int col = fq * 8 + n * 4; const f32x4 b = *(const f32x4*)(gb + col);
#pragma unroll
        for (int ai = 0; ai < 2; ++ai)
#pragma unroll
          for (int m = 0; m < 4; ++m) {
            const size_t row = row0 + ai * 128 + m * 16; const f32x4 a = acc[ai][0][m][n];
            f32x4 o; o[0] = a[0] + b[0]; o[1] = a[1] + b[1]; o[2] = a[2] + b[2]; o[3] = a[3] + b[3];
            *(f32x4*)(G + row * 32 + col) = o;
          }
      }
    }
  } else if (epi == EPI_RET_U) {
    u16* O = (u16*)ph.O; const float* rope = c.rope;
    const bool dorope = (pn < 4) && (pm * 256 < NL);
#pragma unroll
    for (int ai = 0; ai < 2; ++ai)
#pragma unroll
      for (int m = 0; m < 4; ++m) {
        const size_t row = row0 + ai * 128 + m * 16; const int t = (int)(row & 8191);
#pragma unroll
        for (int bj = 0; bj < 2; ++bj) {
          const int col = pn * 256 + bj * 128 + wc * 32 + fq * 8; f32x4 a0 = acc[ai][bj][m][0], a1 = acc[ai][bj][m][1];
          if (dorope) {
            const int p0 = (col & 255) >> 1;
            const f32x4 c0 = *(const f32x4*)(rope + ((size_t)t * 128 + p0) * 2), c1 = *(const f32x4*)(rope + ((size_t)t * 128 + p0) * 2 + 4);
            const float e0 = a0[0] * c0[0] - a0[1] * c0[1], o0 = a0[0] * c0[1] + a0[1] * c0[0];
            const float e1 = a0[2] * c0[2] - a0[3] * c0[3], o1 = a0[2] * c0[3] + a0[3] * c0[2];
            const float e2 = a1[0] * c1[0] - a1[1] * c1[1], o2 = a1[0] * c1[1] + a1[1] * c1[0];
            const float e3 = a1[2] * c1[2] - a1[3] * c1[3], o3 = a1[2] * c1[3] + a1[3] * c1[2];
            a0[0] = e0; a0[1] = o0; a0[2] = e1; a0[3] = o1; a1[0] = e2; a1[1] = o2; a1[2] = e3; a1[3] = o3;
          }
          u32x4 o; o.x = pack2(a0[0], a0[1]); o.y = pack2(a0[2], a0[3]); o.z = pack2(a1[0], a1[1]); o.w = pack2(a1[2], a1[3]);
          *(u32x4*)(O + row * 2048 + col) = o;
        }
      }
  } else {
    u16* O = (u16*)ph.O;
#pragma unroll
    for (int ai = 0; ai < 2; ++ai)
#pragma unroll
      for (int m = 0; m < 4; ++m) {
        const size_t row = row0 + ai * 128 + m * 16;
#pragma unroll
        for (int bj = 0; bj < 2; ++bj) {
          const int col = pn * 256 + bj * 128 + wc * 32 + fq * 8; const f32x4 a0 = acc[ai][bj][m][0], a1 = acc[ai][bj][m][1];
          u32x4* yp = (u32x4*)(O + row * 2048 + col); u32x4 yv = *yp;
          yv.x = pack2(lo2f(yv.x) * siluf(a0[0]), hi2f(yv.x) * siluf(a0[1])); yv.y = pack2(lo2f(yv.y) * siluf(a0[2]), hi2f(yv.y) * siluf(a0[3]));
          yv.z = pack2(lo2f(yv.z) * siluf(a1[0]), hi2f(yv.z) * siluf(a1[1])); yv.w = pack2(lo2f(yv.w) * siluf(a1[2]), hi2f(yv.w) * siluf(a1[3]));
          *yp = yv;
        }
      }
  }
}

__device__ __forceinline__ void gemm_phase(ldsp lds, const Phase& ph, const Ctx& c) {
  using namespace pg8;
  int tid = threadIdx.x; asm volatile("" : "+v"(tid)); const int wid = __builtin_amdgcn_readfirstlane(tid >> 6), lane = tid & 63, wr = wid >> 2, wc = wid & 3, fr = lane & 15, fq = lane >> 4;
  const int K = ph.K;
  StaticOrder S; S.init(ph.M, ph.N, ph.K, ph.i1 & 1, gridDim.x, blockIdx.x);
  unsigned voffA[2];
#pragma unroll
  for (int i = 0; i < 2; ++i) { int R, C; stage_rc(tid * 16 + i * 8192, R, C); voffA[i] = (unsigned)(R * K + C) * 2u; }
  const size_t kstep = (size_t)(BK * 2);
  const size_t hstep = (size_t)HALF * K * 2;
  const size_t tstep = 2 * hstep;
  const unsigned ldsw = (unsigned)wid * 1024u;
  const int aoff = lds_byte(wr * 64 + fr, fq * 8), boff = lds_byte(wc * 32 + fr, fq * 8);
#define PG8_SA(b, h) (((b) * 2 + (h)) * HTB)
#define PG8_SB(b, h) ((4 + (b) * 2 + (h)) * HTB)
#define PG8_STAGE(bufoff, gbase, voff) do { _Pragma("unroll") for (int _i = 0; _i < 2; ++_i) \
    __builtin_amdgcn_global_load_lds((const unsigned*)((const char*)(gbase) + (voff)[_i]), (LAS unsigned*)(lds + (bufoff) + ldsw + _i * 8192), 16, 0, 0); } while (0)
#define PG8_LDA(dst, b, h) do { _Pragma("unroll") for (int m = 0; m < 4; ++m) _Pragma("unroll") for (int k = 0; k < 2; ++k) dst[m][k] = *(const LAS bf16x8*)(lds + PG8_SA(b, h) + aoff + m * 2048 + k * 1024); } while (0)
#define PG8_LDB(dst, b, h) do { _Pragma("unroll") for (int n = 0; n < 2; ++n) _Pragma("unroll") for (int k = 0; k < 2; ++k) dst[n][k] = *(const LAS bf16x8*)(lds + PG8_SB(b, h) + boff + n * 2048 + k * 1024); } while (0)
#define PG8_MMA(ai, bj, At, Bt) do { __builtin_amdgcn_s_setprio(1); _Pragma("unroll") for (int m = 0; m < 4; ++m) _Pragma("unroll") for (int n = 0; n < 2; ++n) _Pragma("unroll") for (int k = 0; k < 2; ++k) \
    acc[ai][bj][m][n] = __builtin_amdgcn_mfma_f32_16x16x32_bf16(Bt[n][k], At[m][k], acc[ai][bj][m][n], 0, 0, 0); __builtin_amdgcn_s_setprio(0); } while (0)
#define PG8_WAIT_V(n) asm volatile("s_waitcnt vmcnt(" #n ")" ::: "memory")
#define PG8_WAIT_L(n) asm volatile("s_waitcnt lgkmcnt(" #n ")" ::: "memory")
#define PG8_BAR __builtin_amdgcn_s_barrier()
#define PG8_SCHED __builtin_amdgcn_sched_barrier(0)
  Unit cur, nxt; int ui = 0;
  if (!S.next(0, cur)) return;
  f32x4 acc[2][2][4][2];
#pragma unroll
  for (int a = 0; a < 2; ++a)
#pragma unroll
    for (int b = 0; b < 2; ++b)
#pragma unroll
      for (int m = 0; m < 4; ++m)
#pragma unroll
        for (int n = 0; n < 2; ++n) acc[a][b][m][n] = (f32x4){0.f, 0.f, 0.f, 0.f};
  bf16x8 At[4][2], B0[2][2], B1[2][2];
  const char* cA = (const char*)ph.A + (size_t)cur.pm * tstep + (size_t)cur.k0 * 2; const char* cB = (const char*)ph.B + (size_t)cur.pn * tstep + (size_t)cur.k0 * 2;
  PG8_STAGE(PG8_SB(0, 0), cB, voffA); PG8_STAGE(PG8_SA(0, 0), cA, voffA); PG8_STAGE(PG8_SB(0, 1), cB + hstep, voffA); PG8_STAGE(PG8_SA(0, 1), cA + hstep, voffA);
  if (wr == 1) PG8_BAR;
  PG8_WAIT_V(4); PG8_BAR;
  PG8_STAGE(PG8_SB(1, 0), cB + kstep, voffA); PG8_STAGE(PG8_SA(1, 0), cA + kstep, voffA); PG8_STAGE(PG8_SB(1, 1), cB + hstep + kstep, voffA);
  PG8_WAIT_V(6); PG8_BAR;
  for (;;) {
    const bool has_next = S.next(ui + 1, nxt);
    const char* nA = has_next ? (const char*)ph.A + (size_t)nxt.pm * tstep + (size_t)nxt.k0 * 2 : cA; const char* nB = has_next ? (const char*)ph.B + (size_t)nxt.pn * tstep + (size_t)nxt.k0 * 2 : cB;
    const int nt = cur.nt;
    for (int t = 0; t < nt; t += 2) {
      const bool last = (t == nt - 2);
      const char* a1 = cA + (size_t)(t + 1) * kstep;
      const char* a2 = last ? nA : cA + (size_t)(t + 2) * kstep; const char* b2 = last ? nB : cB + (size_t)(t + 2) * kstep;
      const char* a3 = a2 + kstep; const char* b3 = b2 + kstep;
      PG8_LDB(B0, 0, 0); PG8_SCHED; PG8_LDA(At, 0, 0); PG8_STAGE(PG8_SA(1, 1), a1 + hstep, voffA);
      PG8_WAIT_L(8); PG8_BAR; PG8_WAIT_L(0); PG8_MMA(0, 0, At, B0); PG8_BAR; PG8_SCHED;
      PG8_LDB(B1, 0, 1); PG8_STAGE(PG8_SB(0, 0), b2, voffA);
      PG8_BAR; PG8_WAIT_L(0); PG8_MMA(0, 1, At, B1); PG8_BAR;
      PG8_LDA(At, 0, 1); PG8_STAGE(PG8_SA(0, 0), a2, voffA);
      PG8_BAR; PG8_WAIT_L(0); PG8_MMA(1, 0, At, B0); PG8_BAR; PG8_SCHED;
      PG8_STAGE(PG8_SB(0, 1), b2 + hstep, voffA);
      PG8_WAIT_V(6); PG8_BAR; PG8_MMA(1, 1, At, B1); PG8_BAR;
      PG8_LDB(B0, 1, 0); PG8_SCHED; PG8_LDA(At, 1, 0); PG8_STAGE(PG8_SA(0, 1), a2 + hstep, voffA);
      PG8_WAIT_L(8); PG8_BAR; PG8_WAIT_L(0); PG8_MMA(0, 0, At, B0); PG8_BAR; PG8_SCHED;
      PG8_LDB(B1, 1, 1); PG8_STAGE(PG8_SB(1, 0), b3, voffA);
      PG8_BAR; PG8_WAIT_L(0); PG8_MMA(0, 1, At, B1); PG8_BAR;
      PG8_LDA(At, 1, 1); PG8_STAGE(PG8_SA(1, 0), a3, voffA);
      PG8_BAR; PG8_WAIT_L(0); PG8_MMA(1, 0, At, B0); PG8_BAR; PG8_SCHED;
      PG8_STAGE(PG8_SB(1, 1), b3 + hstep, voffA);
      PG8_WAIT_V(6); PG8_BAR; PG8_MMA(1, 1, At, B1); PG8_BAR;
    }
    epi_apply(ph, c, acc, cur.pm, cur.pn, cur.at, wr, wc, fr, fq);
    if (!has_next) break;
#pragma unroll
    for (int a = 0; a < 2; ++a)
#pragma unroll
      for (int b = 0; b < 2; ++b)
#pragma unroll
        for (int m = 0; m < 4; ++m)
#pragma unroll
          for (int n = 0; n < 2; ++n) acc[a][b][m][n] = (f32x4){0.f, 0.f, 0.f, 0.f};
    cur = nxt; cA = nA; cB = nB; ++ui;
  }
  PG8_WAIT_V(0);
  if (wr == 0) PG8_BAR;
  PG8_BAR;
}

__device__ void phase_init(ldsp lds, const Ctx& c) {
  int tid = threadIdx.x; asm volatile("" : "+v"(tid)); const int wid = tid >> 6, lane = tid & 63;
  LAS float* sc = (LAS float*)lds;
  LAS float* red = (LAS float*)(lds + 20480);
  for (int i = tid; i < 5120; i += 512) { const int s = i >> 10, k = i & 1023; const float v = s < 4 ? c.c[s * 1024 + k] : c.c_ctx[k]; sc[i] = siluf(v); }
  __syncthreads();
  for (int item = blockIdx.x; item < 288; item += gridDim.x) {
    const int l = item / 144, j0 = (item % 144) * 64;
    const float* w = c.mod_w + (size_t)l * 1024 * 9216 + j0 + lane;
    float a0 = 0, a1 = 0, a2 = 0, a3 = 0, a4 = 0;
    for (int k = wid * 128; k < wid * 128 + 128; ++k) {
      const float wv = w[(size_t)k * 9216];
      a0 += sc[k] * wv; a1 += sc[1024 + k] * wv; a2 += sc[2048 + k] * wv; a3 += sc[3072 + k] * wv; a4 += sc[4096 + k] * wv;
    }
    red[(wid * 5 + 0) * 64 + lane] = a0; red[(wid * 5 + 1) * 64 + lane] = a1; red[(wid * 5 + 2) * 64 + lane] = a2; red[(wid * 5 + 3) * 64 + lane] = a3; red[(wid * 5 + 4) * 64 + lane] = a4;
    __syncthreads();
    if (tid < 320) { const int s = tid >> 6; float v = 0; for (int ww = 0; ww < 8; ++ww) v += red[(ww * 5 + s) * 64 + lane];
      c.modv[(size_t)(l * 5 + s) * 9216 + j0 + lane] = v + c.mod_b[l * 9216 + j0 + lane]; }
    __syncthreads();
  }
  const size_t gt = (size_t)blockIdx.x * 512 + tid, gs = (size_t)gridDim.x * 512;
  for (size_t i = gt; i < (size_t)8192 * 128; i += gs) {
    const int t = (int)(i >> 7), p = (int)(i & 127); const int f = p & 63; const int pos = p < 64 ? (t >> 6) : (t & 63);
    const double inv = (double)exp2f(-(float)f * 0.20762050593046015f);
    const double rev = (double)pos * inv * 0.15915494309189535; const float fr = (float)(rev - rint(rev));
    c.rope[i * 2] = __builtin_amdgcn_cosf(fr); c.rope[i * 2 + 1] = __builtin_amdgcn_sinf(fr);
  }
  const float4* cs = (const float4*)c.ctx; float4* xd = (float4*)c.xr;
  for (size_t i = gt; i < (size_t)(NT - NL) * 256; i += gs) xd[(size_t)NL * 256 + i] = cs[i];
}

struct TileD { const float* src; u16* dst; int ld, nvalid, sc0, K, n0, k0, perm; float scale; };
__device__ __forceinline__ void tile_desc(const Ctx& c, int kind, int l, int f, int it, TileD& d) {
  const float* src; u16* dst; int ld, nvalid, sc0, K, n0, k0, perm = 1; float scale = 1.f;
  if (kind == 0) {
    if (it < 1408) { const int nb = it >> 4, kb = it & 15; const int pn = nb >> 2, q = nb & 3;
      src = c.w13 + (size_t)(l * 2 + f) * 1024 * 5632; dst = c.wb; ld = 5632; nvalid = 5632; sc0 = (q < 2 ? 0 : 2816) + 128 * pn + (q & 1) * 64; K = 1024; n0 = nb * 64; k0 = kb * 64; }
    else { const int i2 = it - 1408; const int nb = i2 / 44, kb = i2 % 44;
      perm = 0; src = c.w2 + (size_t)(l * 2 + f) * 2816 * 1024; dst = c.wb + (size_t)5632 * 1024; ld = 1024; nvalid = 1024; sc0 = nb * 64; K = 2816; n0 = nb * 64; k0 = kb * 64; }
  } else if (kind == 1) {
    if (it < 832) { const int nb = it >> 4, kb = it & 15; src = c.m_w_in; dst = c.wb; ld = 3104; nvalid = 3104; sc0 = nb * 64; K = 1024; n0 = nb * 64; k0 = kb * 64; }
    else { const int i2 = it - 832; const int nb = i2 >> 4, kb = i2 & 15; perm = 0; src = c.m_w_out; dst = c.wb + (size_t)3328 * 1024; ld = 1024; nvalid = 1024; sc0 = nb * 64; K = 1024; n0 = nb * 64; k0 = kb * 64; }
  } else {
    if (it < 1536) { const int nb = it >> 4, kb = it & 15; const int n = nb * 64; int s0;
      if (n < 4096) { const int hp = n >> 11, r = n & 2047; if (r < 512) s0 = hp * 512 + r; else if (r < 1024) { s0 = 1024 + hp * 512 + (r - 512); scale = 0.0625f; } else s0 = 2048 + hp * 1024 + (r - 1024); }
      else s0 = n;
      src = c.r_w_in; dst = c.wb; ld = 6144; nvalid = 6144; sc0 = s0; K = 1024; n0 = n; k0 = kb * 64; }
    else { const int i2 = it - 1536; const int nb = i2 >> 5, kb = i2 & 31; perm = 0; src = c.r_w_out; dst = c.wb + (size_t)6144 * 1024; ld = 1024; nvalid = 1024; sc0 = nb * 64; K = 2048; n0 = nb * 64; k0 = kb * 64; }
  }
  d.src = src; d.dst = dst; d.ld = ld; d.nvalid = nvalid; d.sc0 = sc0; d.K = K; d.n0 = n0; d.k0 = k0; d.perm = perm; d.scale = scale;
}
__device__ __forceinline__ void tile_load(const TileD& d, int tid, float4& v0, float4& v1) {
  const int kk = tid >> 4, c4 = (tid & 15) * 4; const int col = d.sc0 + c4;
  v0 = make_float4(0.f, 0.f, 0.f, 0.f); v1 = v0;
  if (col < d.nvalid) { const float* p = d.src + (size_t)(d.k0 + kk) * d.ld + col; v0 = *(const float4*)p; v1 = *(const float4*)(p + (size_t)32 * d.ld); }
}

__device__ void phase_norm(ldsp lds, const Phase& ph, const Ctx& c) {
  int tid = threadIdx.x; asm volatile("" : "+v"(tid)); const int wid = tid >> 6, lane = tid & 63;
  const int l = ph.i0, j = ph.i1, kind = ph.pad;
  {
    const int ntile = kind == 0 ? 2112 : (kind == 1 ? 1088 : 2048);
    LAS float* tile = (LAS float*)lds;
    TileD d; float4 p0, p1; int it = blockIdx.x;
    if (it < ntile) { tile_desc(c, kind, l, ph.K, it, d); tile_load(d, tid, p0, p1); }
#pragma unroll 1
    for (; it < ntile; it += gridDim.x) {
      const float sc = d.scale; const int dperm = d.perm; u16* dptr = d.dst + (size_t)(d.n0 + (tid >> 3)) * d.K + d.k0 + (tid & 7) * 8;
      { const int kk = tid >> 4, c4 = (tid & 15) * 4;
        tile[kk * 65 + c4] = p0.x * sc; tile[kk * 65 + c4 + 1] = p0.y * sc; tile[kk * 65 + c4 + 2] = p0.z * sc; tile[kk * 65 + c4 + 3] = p0.w * sc;
        tile[(kk + 32) * 65 + c4] = p1.x * sc; tile[(kk + 32) * 65 + c4 + 1] = p1.y * sc; tile[(kk + 32) * 65 + c4 + 2] = p1.z * sc; tile[(kk + 32) * 65 + c4 + 3] = p1.w * sc; }
      if (it + (int)gridDim.x < ntile) { tile_desc(c, kind, l, ph.K, it + gridDim.x, d); tile_load(d, tid, p0, p1); }
      LDS_BAR();
      { const int nd = tid >> 3, kc = (tid & 7) * 8; const int n = dperm ? (nd & 32) + perm32(nd & 31) : nd; u32x4 o;
        o.x = pack2(tile[(kc + 0) * 65 + n], tile[(kc + 1) * 65 + n]); o.y = pack2(tile[(kc + 2) * 65 + n], tile[(kc + 3) * 65 + n]);
        o.z = pack2(tile[(kc + 4) * 65 + n], tile[(kc + 5) * 65 + n]); o.w = pack2(tile[(kc + 6) * 65 + n], tile[(kc + 7) * 65 + n]);
        *(u32x4*)dptr = o; }
      LDS_BAR();
    }
  }
  const float* g = c.norm_g + (size_t)(l * 3 + j) * 1024;
  const int nsplit = ph.N >> 8; const float* pbase = (ph.N & 2) ? c.part2 : c.part;
  const int rstride = gridDim.x * 8;
  float4 nv[4];
  { const int row = blockIdx.x * 8 + wid;
    if (row < ph.M) { const float4* xp = (const float4*)((((ph.N & 1) && row < NL) ? c.x : c.xr) + (size_t)row * 1024);
#pragma unroll
      for (int i = 0; i < 4; ++i) nv[i] = ldnt4(xp + lane + 64 * i); } }
  for (int row = blockIdx.x * 8 + wid; row < ph.M; row += rstride) {
    float4 v[4]; float ss = 0.f;
#pragma unroll
    for (int i = 0; i < 4; ++i) v[i] = nv[i];
    { const int nrow = row + rstride;
      if (nrow < ph.M) { const float4* xp = (const float4*)((((ph.N & 1) && nrow < NL) ? c.x : c.xr) + (size_t)nrow * 1024);
#pragma unroll
        for (int i = 0; i < 4; ++i) nv[i] = ldnt4(xp + lane + 64 * i); } }
    if (nsplit > 0 && row >= NL) {
      const float4* gp = (const float4*)((const float*)ph.X + (size_t)4 * 9216);
#pragma unroll
      for (int i = 0; i < 4; ++i) { float4 a = make_float4(0.f, 0.f, 0.f, 0.f);
        for (int ks = 0; ks < nsplit; ++ks) { const float4 pv = ((const float4*)(pbase + ((size_t)ks * 1024 + (row - NL)) * 1024))[lane + 64 * i]; a.x += pv.x; a.y += pv.y; a.z += pv.z; a.w += pv.w; }
        const float4 g4 = gp[lane + 64 * i]; const float f0 = ph.f0;
        v[i].x += f0 * g4.x * a.x; v[i].y += f0 * g4.y * a.y; v[i].z += f0 * g4.z * a.z; v[i].w += f0 * g4.w * a.w;
        ((float4*)(c.xr + (size_t)row * 1024))[lane + 64 * i] = v[i]; }
    }
#pragma unroll
    for (int i = 0; i < 4; ++i) ss += v[i].x * v[i].x + v[i].y * v[i].y + v[i].z * v[i].z + v[i].w * v[i].w;
#pragma unroll
    for (int o = 1; o < 64; o <<= 1) ss += shx(ss, o, lane);
    const float rstd = rsqrtf(ss * (1.f / 1024.f) + 1e-6f);
    const int set = row < NL ? (row >> 13) : 4;
    const float* sh = c.modv + (size_t)(l * 5 + set) * 9216 + (3 * j) * 1024; const float* sc = sh + 1024;
#pragma unroll
    for (int i = 0; i < 4; ++i) {
      const int q = lane + 64 * i; const float4 g4 = ((const float4*)g)[q], s4 = ((const float4*)sh)[q], c4 = ((const float4*)sc)[q];
      u32x2 o; o.x = pack2(v[i].x * rstd * g4.x * (1.f + c4.x) + s4.x, v[i].y * rstd * g4.y * (1.f + c4.y) + s4.y);
      o.y = pack2(v[i].z * rstd * g4.z * (1.f + c4.z) + s4.z, v[i].w * rstd * g4.w * (1.f + c4.w) + s4.w);
      *(u32x2*)(c.hb + (size_t)row * 1024 + q * 4) = o;
    }
  }
}

__device__ void phase_final(const Ctx& c) {
  int tid = threadIdx.x; asm volatile("" : "+v"(tid)); const int wid = tid >> 6, lane = tid & 63;
  for (int row = blockIdx.x * 8 + wid; row < NL; row += gridDim.x * 8) {
    const float4* xp = (const float4*)(c.xr + (size_t)row * 1024);
    float4 v[4]; float ss = 0.f;
#pragma unroll
    for (int i = 0; i < 4; ++i) { v[i] = ldnt4(xp + lane + 64 * i); ss += v[i].x * v[i].x + v[i].y * v[i].y + v[i].z * v[i].z + v[i].w * v[i].w; }
#pragma unroll
    for (int o = 1; o < 64; o <<= 1) ss += shx(ss, o, lane);
    const float rstd = rsqrtf(ss * (1.f / 1024.f) + 1e-6f);
#pragma unroll
    for (int i = 0; i < 4; ++i) { const int q = lane + 64 * i; const float4 g4 = ((const float4*)c.final_g)[q];
      float4 o; o.x = v[i].x * rstd * g4.x; o.y = v[i].y * rstd * g4.y; o.z = v[i].z * rstd * g4.z; o.w = v[i].w * rstd * g4.w;
      stnt4((float4*)(c.out + (size_t)row * 1024) + q, o); }
  }
}

#define MPRE_ELEMS ((size_t)NT * 3072)
__device__ __forceinline__ int m_chunk_row0(int b, int dir, int cs) {
  if (cs < 2) { const int j = dir ? 1 - cs : cs; return NL + b * 256 + j * 128; }
  const int j = dir ? 65 - cs : cs - 2; return b * 8192 + j * 128;
}

__device__ void phase_mconv(const Ctx& c) {
  const u16* pre = c.big; const float* cw = c.m_conv_w;
  int tid = threadIdx.x; asm volatile("" : "+v"(tid)); const size_t gt = (size_t)blockIdx.x * 512 + tid, gs = (size_t)gridDim.x * 512;
  for (size_t i = gt; i < (size_t)NT * 128; i += gs) {
    const int r = (int)(i >> 7), cg = (int)(i & 127) * 8;
    int pos, len; if (r < NL) { pos = r & 8191; len = 8192; } else { pos = (r - NL) & 255; len = 256; }
    float a[8];
#pragma unroll
    for (int q = 0; q < 8; ++q) a[q] = 0.f;
#pragma unroll
    for (int j = 0; j < 5; ++j) {
      const int pp = pos + j - 2;
      if (pp >= 0 && pp < len) {
        const u32x4 u = *(const u32x4*)(pre + (size_t)(r + j - 2) * 3072 + cg);
        const float4 w0 = *(const float4*)(cw + j * 1024 + cg), w1 = *(const float4*)(cw + j * 1024 + cg + 4);
        a[0] += w0.x * lo2f(u.x); a[1] += w0.y * hi2f(u.x); a[2] += w0.z * lo2f(u.y); a[3] += w0.w * hi2f(u.y);
        a[4] += w1.x * lo2f(u.z); a[5] += w1.y * hi2f(u.z); a[6] += w1.z * lo2f(u.w); a[7] += w1.w * hi2f(u.w);
      }
    }
    const float sc = cg >= 512 ? 0.125f : 1.f;
    u32x4 o; o.x = pack2(siluf(a[0]) * sc, siluf(a[1]) * sc); o.y = pack2(siluf(a[2]) * sc, siluf(a[3]) * sc);
    o.z = pack2(siluf(a[4]) * sc, siluf(a[5]) * sc); o.w = pack2(siluf(a[6]) * sc, siluf(a[7]) * sc);
    *(u32x4*)(c.hb + (size_t)r * 1024 + cg) = o;
  }
}

__device__ void phase_ma(ldsp lds, const Ctx& c) {
  int tid = threadIdx.x; asm volatile("" : "+v"(tid)); const int wid = tid >> 6, lane = tid & 63;
  ldsp sK = lds; ldsp sV = lds + 128 * 144; LAS float* sf = (LAS float*)(lds + 128 * 144 + 128 * 272);
  const u16* pre = c.big; u16* mc = c.big + MPRE_ELEMS;
  for (int item = blockIdx.x; item < 2 * 4 * 8 * 65; item += gridDim.x) {
    const int cs = item % 65; const int sq = item / 65; const int h = sq & 7, b = (sq >> 3) & 3, dir = sq >> 5;
    const int row0 = m_chunk_row0(b, dir, cs);
    if (wid == 0) {
      const float* gp = c.gates + (size_t)(row0 + 2 * lane) * 32 + dir * 16 + h;
      const float ig0 = gp[0], lf0 = logsig(gp[8]), ig1 = gp[32], lf1 = logsig(gp[40]);
      const float s2 = lf0 + lf1; float inc = s2;
#pragma unroll
      for (int d = 1; d < 64; d <<= 1) inc += shup(inc, d, lane, 0.f);
      const float total = lane63(inc); const float ex = inc - s2;
      const float g0 = (dir ? ex : total - ex - lf0) + ig0;
      const float g1 = (dir ? ex + lf0 : total - ex - lf0 - lf1) + ig1;
      float mx = fmaxf(g0, g1);
#pragma unroll
      for (int m = 1; m < 64; m <<= 1) mx = fmaxf(mx, shx(mx, m, lane));
      sf[256 + 2 * lane] = __expf(g0 - mx); sf[257 + 2 * lane] = __expf(g1 - mx);
      if (lane == 0) { c.mst_s[4224 + sq * 66 + cs] = total; c.mst_s[sq * 66 + cs] = mx; }
    }
    LDS_BAR();
    { const int row = tid >> 2, part = tid & 3; const float w = sf[256 + row];
      const u16* kp = c.hb + (size_t)(row0 + row) * 1024 + 512 + h * 64 + part * 16;
#pragma unroll
      for (int q = 0; q < 2; ++q) { const u32x4 u = *(const u32x4*)(kp + q * 8); u32x4 o;
        o.x = pack2(lo2f(u.x) * w, hi2f(u.x) * w); o.y = pack2(lo2f(u.y) * w, hi2f(u.y) * w); o.z = pack2(lo2f(u.z) * w, hi2f(u.z) * w); o.w = pack2(lo2f(u.w) * w, hi2f(u.w) * w);
        *(LAS u32x4*)(sK + row * 144 + part * 32 + q * 16) = o; }
      const u16* vp = pre + (size_t)(row0 + row) * 3072 + 1024 + h * 128 + part * 32;
#pragma unroll
      for (int q = 0; q < 4; ++q) *(LAS u32x4*)(sV + row * 272 + part * 64 + q * 16) = *(const u32x4*)(vp + q * 8);
    }
    LDS_BAR();
    f32x4 acc[4];
#pragma unroll
    for (int n = 0; n < 4; ++n) acc[n] = (f32x4){0.f, 0.f, 0.f, 0.f};
#pragma unroll
    for (int k0 = 0; k0 < 128; k0 += 32) {
      const bf16x8 a = frag_tr(sV, 272, wid * 16, k0, lane);
#pragma unroll
      for (int n = 0; n < 4; ++n) { const bf16x8 bb = frag_tr(sK, 144, n * 16, k0, lane); acc[n] = MFMA16(a, bb, acc[n]); }
    }
    u16* dst = mc + (size_t)(sq * 66 + cs) * 8192;
#pragma unroll
    for (int n = 0; n < 4; ++n)
#pragma unroll
      for (int r = 0; r < 4; ++r) dst[(wid * 16 + 4 * (lane >> 4) + r) * 64 + n * 16 + (lane & 15)] = f2bf(acc[n][r]);
    { float s = 0.f;
#pragma unroll
      for (int p = 0; p < 16; ++p) s += bf2f(*(LAS u16*)(sK + (wid * 16 + p) * 144 + lane * 2));
      sf[384 + wid * 64 + lane] = s; }
    LDS_BAR();
    if (tid < 64) { float s = 0.f;
#pragma unroll
      for (int w8 = 0; w8 < 8; ++w8) s += sf[384 + w8 * 64 + tid];
      c.mst_n[(size_t)(sq * 66 + cs) * 64 + tid] = s; }
    LDS_BAR();
  }
}

__device__ void phase_mb(const Ctx& c) {
  int tid = threadIdx.x; asm volatile("" : "+v"(tid));
  u16* mc = c.big + MPRE_ELEMS;
  for (int item = blockIdx.x; item < 64 * 8; item += gridDim.x) {
    const int sq = item >> 3, slab = item & 7;
    unsigned* p = (unsigned*)(mc + (size_t)sq * 66 * 8192 + slab * 1024 + tid * 2);
    const bool nth = (slab == 0 && tid < 64);
    float* np = c.mst_n + (size_t)sq * 66 * 64 + tid;
    float m = -1e30f, c0 = 0.f, c1 = 0.f, cn = 0.f;
#pragma unroll 1
    for (int cb = 0; cb < 66; cb += 11) {
      unsigned loc[11]; float nl[11], bl[11], ml[11];
#pragma unroll
      for (int q = 0; q < 11; ++q) { const int cs = cb + q; loc[q] = 0u; nl[q] = 0.f; bl[q] = 0.f; ml[q] = 0.f;
        if (cs < 65) { loc[q] = p[(size_t)cs * 4096]; bl[q] = c.mst_s[4224 + sq * 66 + cs]; ml[q] = c.mst_s[sq * 66 + cs]; if (nth) nl[q] = np[cs * 64]; } }
#pragma unroll
      for (int q = 0; q < 11; ++q) { const int cs = cb + q;
        p[(size_t)cs * 4096] = pack2(c0, c1);
        if (nth) np[cs * 64] = cn;
        if (slab == 0 && tid == 0) c.mst_s[8448 + sq * 66 + cs] = m;
        if (cs < 65) {
          const float mn = fmaxf(bl[q] + m, ml[q]); const float wp = __expf(bl[q] + m - mn), wl = __expf(ml[q] - mn);
          c0 = wp * c0 + wl * lo2f(loc[q]); c1 = wp * c1 + wl * hi2f(loc[q]); cn = wp * cn + wl * nl[q]; m = mn;
        } }
    }
  }
}

__device__ void phase_mc(ldsp lds, const Ctx& c) {
  int tid = threadIdx.x; asm volatile("" : "+v"(tid)); const int wid = tid >> 6, lane = tid & 63;
  ldsp sQ = lds, sK = lds + 18432, sV = lds + 36864, sP = lds + 71680, sC0 = lds + 106496, sC1 = lds + 124928;
  LAS float* sf = (LAS float*)(lds + 143360);
  const u16* pre = c.big; const u16* mc = c.big + MPRE_ELEMS;
  for (int item = blockIdx.x; item < 4 * 8 * 66; item += gridDim.x) {
    const int j = item % 66; const int bh = item / 66; const int h = bh & 7, b = bh >> 3;
    const int row0 = j < 2 ? NL + b * 256 + j * 128 : b * 8192 + (j - 2) * 128;
    const int csf = j, csb = j < 2 ? 1 - j : 67 - j;
    const int sqf = b * 8 + h, sqb = 32 + b * 8 + h;
    const int d2 = tid >> 7, po = tid & 127;
    if (wid < 2) {
      const int dd = wid;
      const float* gp = c.gates + (size_t)(row0 + 2 * lane) * 32 + dd * 16 + h;
      const float ig0 = gp[0], lf0 = logsig(gp[8]), ig1 = gp[32], lf1 = logsig(gp[40]);
      const float s2 = lf0 + lf1; float inc = s2;
#pragma unroll
      for (int d = 1; d < 64; d <<= 1) inc += shup(inc, d, lane, 0.f);
      const float total = lane63(inc); const float ex = inc - s2;
      const float bb0 = dd ? total - ex : ex + lf0;
      const float bb1 = dd ? total - ex - lf0 : ex + s2;
      const float e0 = ig0 - bb0, e1 = ig1 - bb1, e01 = fmaxf(e0, e1);
      const float mpre = c.mst_s[8448 + (dd ? sqb * 66 + csb : sqf * 66 + csf)];
      float pm0, pm1;
      if (!dd) { float P = e01;
#pragma unroll
        for (int d = 1; d < 64; d <<= 1) P = fmaxf(P, shup(P, d, lane, -3.0e38f));
        const float xp = shup(P, 1, lane, -3.0e38f); pm0 = fmaxf(xp, e0); pm1 = fmaxf(xp, e01); }
      else { float S = e01;
#pragma unroll
        for (int d = 1; d < 64; d <<= 1) S = fmaxf(S, shdn(S, d, lane, -3.0e38f));
        const float xs = shdn(S, 1, lane, -3.0e38f); pm1 = fmaxf(xs, e1); pm0 = fmaxf(xs, e01); }
      const float M0 = fmaxf(mpre, pm0), M1 = fmaxf(mpre, pm1);
      const int o = dd * 128 + 2 * lane;
      sf[768 + o] = bb0; sf[769 + o] = bb1; sf[256 + o] = e0; sf[257 + o] = e1; sf[512 + o] = M0; sf[513 + o] = M1;
      sf[1024 + o] = __expf(mpre - M0); sf[1025 + o] = __expf(mpre - M1);
    }
    if (tid >= 256 && tid < 384) { const int q = tid - 256; const int d3 = q >> 6, dd = q & 63; sf[1536 + q] = c.mst_n[(size_t)(d3 ? sqb * 66 + csb : sqf * 66 + csf) * 64 + dd]; }
    { const int row = tid >> 2, part = tid & 3;
      const u16* qp = c.hb + (size_t)(row0 + row) * 1024 + h * 64 + part * 16;
#pragma unroll
      for (int q = 0; q < 2; ++q) { *(LAS u32x4*)(sQ + row * 144 + part * 32 + q * 16) = *(const u32x4*)(qp + q * 8); *(LAS u32x4*)(sK + row * 144 + part * 32 + q * 16) = *(const u32x4*)(qp + 512 + q * 8); }
      const u16* vp = pre + (size_t)(row0 + row) * 3072 + 1024 + h * 128 + part * 32;
#pragma unroll
      for (int q = 0; q < 4; ++q) *(LAS u32x4*)(sV + row * 272 + part * 64 + q * 16) = *(const u32x4*)(vp + q * 8);
      const u16* cf = mc + (size_t)(sqf * 66 + csf) * 8192 + row * 64 + part * 16; const u16* cb = mc + (size_t)(sqb * 66 + csb) * 8192 + row * 64 + part * 16;
#pragma unroll
      for (int q = 0; q < 2; ++q) { *(LAS u32x4*)(sC0 + row * 144 + part * 32 + q * 16) = *(const u32x4*)(cf + q * 8); *(LAS u32x4*)(sC1 + row * 144 + part * 32 + q * 16) = *(const u32x4*)(cb + q * 8); }
    }
    LDS_BAR();
    { const int row = tid >> 2, part = tid & 3; float qf = 0.f, qb = 0.f;
#pragma unroll
      for (int q = 0; q < 2; ++q) { const u32x4 u = *(const LAS u32x4*)(sQ + row * 144 + part * 32 + q * 16); const int d0 = part * 16 + q * 8;
        const float v0 = lo2f(u.x), v1 = hi2f(u.x), v2 = lo2f(u.y), v3 = hi2f(u.y), v4 = lo2f(u.z), v5 = hi2f(u.z), v6 = lo2f(u.w), v7 = hi2f(u.w);
        qf += v0 * sf[1536 + d0] + v1 * sf[1537 + d0] + v2 * sf[1538 + d0] + v3 * sf[1539 + d0] + v4 * sf[1540 + d0] + v5 * sf[1541 + d0] + v6 * sf[1542 + d0] + v7 * sf[1543 + d0];
        qb += v0 * sf[1600 + d0] + v1 * sf[1601 + d0] + v2 * sf[1602 + d0] + v3 * sf[1603 + d0] + v4 * sf[1604 + d0] + v5 * sf[1605 + d0] + v6 * sf[1606 + d0] + v7 * sf[1607 + d0]; }
      qf += shx(qf, 1, lane); qf += shx(qf, 2, lane); qb += shx(qb, 1, lane); qb += shx(qb, 2, lane);
      if (part == 0) { sf[1280 + row] = qf; sf[1408 + row] = qb; } }
    f32x4 accS[8];
#pragma unroll
    for (int n = 0; n < 8; ++n) accS[n] = (f32x4){0.f, 0.f, 0.f, 0.f};
#pragma unroll
    for (int k0 = 0; k0 < 64; k0 += 32) {
      const bf16x8 a = frag_row(sQ, 144, wid * 16, k0, lane);
#pragma unroll
      for (int n = 0; n < 8; ++n) { const bf16x8 bb = frag_row(sK, 144, n * 16, k0, lane); accS[n] = MFMA16(a, bb, accS[n]); }
    }
    LDS_BAR();
    f32x4 hs[8];
#pragma unroll
    for (int n = 0; n < 8; ++n) hs[n] = (f32x4){0.f, 0.f, 0.f, 0.f};
    const int tb = wid * 16 + 4 * (lane >> 4), sl = lane & 15;
#pragma unroll 1
    for (int dir = 0; dir < 2; ++dir) {
      float rs[4] = {0.f, 0.f, 0.f, 0.f}; float Mt[4];
#pragma unroll
      for (int r = 0; r < 4; ++r) Mt[r] = sf[512 + dir * 128 + tb + r];
#pragma unroll
      for (int n = 0; n < 8; ++n) { const int s = n * 16 + sl; const float es = sf[256 + dir * 128 + s];
#pragma unroll
        for (int r = 0; r < 4; ++r) { const int t = tb + r; const bool in = dir ? (s >= t) : (s <= t);
          const float pv = in ? accS[n][r] * __expf(es - Mt[r]) : 0.f; rs[r] += pv; *(LAS u16*)(sP + t * 272 + s * 2) = f2bf(pv); } }
#pragma unroll
      for (int r = 0; r < 4; ++r) rs[r] = red16l(rs[r], lane);
      float wi4[4], inv4[4];
#pragma unroll
      for (int r = 0; r < 4; ++r) { const int t = tb + r; const float wi = sf[1024 + dir * 128 + t];
        const float den = wi * sf[1280 + dir * 128 + t] + rs[r]; const float mt = sf[768 + dir * 128 + t] + Mt[r];
        wi4[r] = wi; inv4[r] = 1.f / fmaxf(fabsf(den), __expf(-mt)); }
      ldsp sC = dir ? sC1 : sC0;
#pragma unroll
      for (int eh = 0; eh < 2; ++eh) {
        f32x4 a1[4], a2[4];
#pragma unroll
        for (int n = 0; n < 4; ++n) { a1[n] = (f32x4){0.f, 0.f, 0.f, 0.f}; a2[n] = (f32x4){0.f, 0.f, 0.f, 0.f}; }
#pragma unroll
        for (int k0 = 0; k0 < 128; k0 += 32) { const bf16x8 a = frag_row(sP, 272, wid * 16, k0, lane);
#pragma unroll

#define FR_(n) frag_tr(sV, 272, (eh * 4 + (n)) * 16, k0, lane)
          SWEEP(4, 4, FR_, a, a1);
#undef FR_
        }
#pragma unroll
        for (int k0 = 0; k0 < 64; k0 += 32) { const bf16x8 a = frag_row(sQ, 144, wid * 16, k0, lane);
#pragma unroll

#define FR_(n) frag_row(sC, 144, (eh * 4 + (n)) * 16, k0, lane)
          SWEEP(4, 4, FR_, a, a2);
#undef FR_
        }
#pragma unroll
        for (int r = 0; r < 4; ++r)
#pragma unroll
          for (int n = 0; n < 4; ++n) hs[eh * 4 + n][r] += (a1[n][r] + wi4[r] * a2[n][r]) * inv4[r];
      }
    }
#pragma unroll
    for (int r = 0; r < 4; ++r) {
      float s = 0.f;
#pragma unroll
      for (int n = 0; n < 8; ++n) s += hs[n][r];
      const float mu = red16l(s, lane) * (1.f / 128.f); float v = 0.f;
#pragma unroll
      for (int n = 0; n < 8; ++n) { const float d = hs[n][r] - mu; v += d * d; }
      const float rstd = rsqrtf(red16l(v, lane) * (1.f / 128.f) + 1e-6f);
      const size_t row = row0 + tb + r;
#pragma unroll
      for (int n = 0; n < 8; ++n) { const int e = h * 128 + n * 16 + sl;
        const float og = bf2f(pre[row * 3072 + 2048 + e]);
        c.y[row * 1024 + e] = f2bf((hs[n][r] - mu) * rstd * c.m_norm_g[e] * sigmf(og)); }
    }
    LDS_BAR();
  }
}

#define RUQ_ELEMS ((size_t)NT * 2048)
__device__ __forceinline__ float ret_lg(const Ctx& c, int dir, int h) { return logsig(c.r_decay[dir * 4 + h]); }

__device__ void phase_ra(ldsp lds, const Phase& ph, const Ctx& c) {
  int tid = threadIdx.x; asm volatile("" : "+v"(tid)); const int wid = tid >> 6, lane = tid & 63;
  ldsp sV = lds; ldsp sK = lds + 64 * 272;
  const u16* uq = c.big; u16* rst = c.big + RUQ_ELEMS; const int hp = ph.i0;
  for (int item = blockIdx.x; item < 1024; item += gridDim.x) {
    const int eq = item & 3, J = (item >> 2) & 15, hl = (item >> 6) & 1, b = (item >> 7) & 3, dir = item >> 9;
    const int sq = (dir * 4 + b) * 2 + hl; const float lg = ret_lg(c, dir, hp * 2 + hl);
    int row0, L; if (J == 0) { row0 = NL + b * 256; L = 256; } else { L = 512; row0 = b * 8192 + (dir ? 16 - J : J - 1) * 512; }
    f32x4 acc[16];
#pragma unroll
    for (int n = 0; n < 16; ++n) acc[n] = (f32x4){0.f, 0.f, 0.f, 0.f};
    const u16* vp = uq + (size_t)(row0 + (tid >> 4)) * 2048 + 1024 + hl * 512 + eq * 128 + (tid & 15) * 8;
    const u16* kp = uq + (size_t)(row0 + (tid >> 5)) * 2048 + 512 + hl * 256 + (tid & 31) * 8;
    u32x4 pv[2], pk[4];
#pragma unroll
    for (int q = 0; q < 2; ++q) pv[q] = *(const u32x4*)(vp + (size_t)q * 32 * 2048);
#pragma unroll
    for (int q = 0; q < 4; ++q) pk[q] = *(const u32x4*)(kp + (size_t)q * 16 * 2048);
    LDS_BAR();
#pragma unroll 1
    for (int s0 = 0; s0 < L; s0 += 64) {
      {
#pragma unroll
        for (int q = 0; q < 2; ++q) *(LAS u32x4*)(sV + (q * 32 + (tid >> 4)) * 272 + (tid & 15) * 16) = pv[q];
#pragma unroll
        for (int q = 0; q < 4; ++q) { const int krow = q * 16 + (tid >> 5); const int o = s0 + krow; const float z = __expf(lg * (float)(dir ? o : L - 1 - o)); const u32x4 u = pk[q]; u32x4 w;
          w.x = pack2(lo2f(u.x) * z, hi2f(u.x) * z); w.y = pack2(lo2f(u.y) * z, hi2f(u.y) * z); w.z = pack2(lo2f(u.z) * z, hi2f(u.z) * z); w.w = pack2(lo2f(u.w) * z, hi2f(u.w) * z);
          *(LAS u32x4*)(sK + krow * 528 + (tid & 31) * 16) = w; }
      }
      if (s0 + 64 < L) {
        const size_t adv = (size_t)(s0 + 64) * 2048;
#pragma unroll
        for (int q = 0; q < 2; ++q) pv[q] = *(const u32x4*)(vp + adv + (size_t)q * 32 * 2048);
#pragma unroll
        for (int q = 0; q < 4; ++q) pk[q] = *(const u32x4*)(kp + adv + (size_t)q * 16 * 2048);
      }
      LDS_BAR();
#pragma unroll
      for (int k0 = 0; k0 < 64; k0 += 32) { const bf16x8 a0 = frag_tr(sV, 272, (wid >> 1) * 32, k0, lane), a1 = frag_tr(sV, 272, (wid >> 1) * 32 + 16, k0, lane);
        bf16x8 bq[4];
#pragma unroll
        for (int n = 0; n < 4; ++n) bq[n] = frag_tr(sK, 528, (wid & 1) * 128 + n * 16, k0, lane);
        __builtin_amdgcn_sched_barrier(0);
#pragma unroll
        for (int n = 0; n < 8; ++n) { const bf16x8 cur = bq[n & 3]; if (n + 4 < 8) bq[n & 3] = frag_tr(sK, 528, (wid & 1) * 128 + (n + 4) * 16, k0, lane);
          acc[n] = MFMA16(a0, cur, acc[n]); acc[8 + n] = MFMA16(a1, cur, acc[8 + n]); __builtin_amdgcn_sched_barrier(0); }
      }
      LDS_BAR();
    }
    u16* dst = rst + (size_t)(sq * 16 + J) * 131072 + (size_t)(eq * 128 + (wid >> 1) * 32 + 4 * (lane >> 4)) * 256 + (wid & 1) * 128 + (lane & 15);
#pragma unroll
    for (int mi = 0; mi < 2; ++mi)
#pragma unroll
      for (int n = 0; n < 8; ++n)
#pragma unroll
        for (int r = 0; r < 4; ++r) dst[(mi * 16 + r) * 256 + n * 16] = f2bf(acc[mi * 8 + n][r]);
  }
}

__device__ void phase_rb(const Phase& ph, const Ctx& c) {
  int tid = threadIdx.x; asm volatile("" : "+v"(tid)); u16* rst = c.big + RUQ_ELEMS; const int hp = ph.i0;
  for (int item = blockIdx.x; item < 16 * 32; item += gridDim.x) {
    const int sq = item >> 5, slab = item & 31; const int hl = sq & 1, dir = sq >> 3;
    const float g512 = __expf(512.f * ret_lg(c, dir, hp * 2 + hl));
    u32x4* p = (u32x4*)(rst + (size_t)sq * 16 * 131072 + slab * 4096 + tid * 8);
    float cr[8];
#pragma unroll
    for (int q = 0; q < 8; ++q) cr[q] = 0.f;
    u32x4 uu[16];
#pragma unroll
    for (int J = 0; J < 16; ++J) uu[J] = p[(size_t)J * 16384];
#pragma unroll
    for (int J = 0; J < 16; ++J) {
      const u32x4 u = uu[J];
      cr[0] = g512 * cr[0] + lo2f(u.x); cr[1] = g512 * cr[1] + hi2f(u.x); cr[2] = g512 * cr[2] + lo2f(u.y); cr[3] = g512 * cr[3] + hi2f(u.y);
      cr[4] = g512 * cr[4] + lo2f(u.z); cr[5] = g512 * cr[5] + hi2f(u.z); cr[6] = g512 * cr[6] + lo2f(u.w); cr[7] = g512 * cr[7] + hi2f(u.w);
      u32x4 o; o.x = pack2(cr[0], cr[1]); o.y = pack2(cr[2], cr[3]); o.z = pack2(cr[4], cr[5]); o.w = pack2(cr[6], cr[7]);
      p[(size_t)J * 16384] = o;
    }
  }
}

__device__ __forceinline__ bf16x8 scale_frag(bf16x8 a, float s) {
  bf16x8 r;
#pragma unroll
  for (int q = 0; q < 8; ++q) r[q] = (short)f2bf(bf2f((u16)a[q]) * s);
  return r;
}

__device__ void phase_rc(ldsp lds, const Phase& ph, const Ctx& c) {
  int tid = threadIdx.x; asm volatile("" : "+v"(tid)); const int wid = tid >> 6, lane = tid & 63;
  ldsp sQ = lds, sKP = lds + 67584, sV = lds + 102400;
  const u16* uq = c.big; const u16* rst = c.big + RUQ_ELEMS; const int hp = ph.i0;
  for (int item = blockIdx.x; item < 512; item += gridDim.x) {
    const int i = item & 3, Jo = (item >> 2) & 15, hl = (item >> 6) & 1, b = item >> 7;
    const int h = hp * 2 + hl; const float lgf = ret_lg(c, 0, h), lgb = ret_lg(c, 1, h);
    const int rowb = b * 8192 + Jo * 512;
    const unsigned kofs = (unsigned)((rowb + (tid >> 4)) * 2048 + 512 + hl * 256 + (tid & 15) * 8);
    const unsigned vofs = (unsigned)((rowb + (tid >> 6)) * 2048 + 1024 + hl * 512 + (tid & 63) * 8);
    const unsigned rofs = (unsigned)((tid >> 2) * 256 + (tid & 3) * 8);
    const u16* rs0 = rst + (size_t)(((0 * 4 + b) * 2 + hl) * 16 + Jo) * 131072;
    const u16* rs1 = rst + (size_t)(((1 * 4 + b) * 2 + hl) * 16 + (15 - Jo)) * 131072;
#define kbase (uq + kofs)
#define vbase (uq + vofs)
#define rbase0 (rs0 + rofs)
#define rbase1 (rs1 + rofs)
    const unsigned dK = (unsigned)((tid >> 4) * 272 + (tid & 15) * 16), dV = (unsigned)((tid >> 6) * 1040 + (tid & 63) * 16), dR = (unsigned)((tid >> 2) * 80 + (tid & 3) * 16);
    constexpr int KQ = 32 * 2048, VQ = 8 * 2048, RQ = 128 * 256, KD = 32 * 272, VD = 8 * 1040, RD = 128 * 80;
    u32x4 pf[4];
#pragma unroll
    for (int q = 0; q < 4; ++q) pf[q] = *(const u32x4*)(kbase + q * KQ);
    { const int row = tid >> 5, ch = tid & 31; const u16* qp = uq + (size_t)(rowb + i * 128 + row) * 2048 + hl * 256 + ch * 8;
#pragma unroll
      for (int q = 0; q < 8; ++q) *(LAS u32x4*)(sQ + (q * 16 + row) * 528 + ch * 16) = *(const u32x4*)(qp + (size_t)q * 16 * 2048); }
    f32x4 acc[32];
#pragma unroll
    for (int n = 0; n < 32; ++n) acc[n] = (f32x4){0.f, 0.f, 0.f, 0.f};
    const int tb = wid * 16 + 4 * (lane >> 4), sl = lane & 15;
#pragma unroll 1
    for (int j = 0; j < 4; ++j) {
      f32x4 accS[8];
#pragma unroll
      for (int n = 0; n < 8; ++n) accS[n] = (f32x4){0.f, 0.f, 0.f, 0.f};
#pragma unroll 1
      for (int dh = 0; dh < 2; ++dh) {
        LDS_BAR();
#pragma unroll
        for (int q = 0; q < 4; ++q) *(LAS u32x4*)(sKP + dK + q * KD) = pf[q];
        { const u16* src = dh == 0 ? kbase + (size_t)j * 128 * 2048 + 128 : vbase + (size_t)(j * 128) * 2048; const int qs = dh == 0 ? KQ : VQ;
#pragma unroll
          for (int q = 0; q < 4; ++q) pf[q] = *(const u32x4*)(src + q * qs); }
        LDS_BAR();
#pragma unroll
        for (int k0 = 0; k0 < 128; k0 += 32) { const bf16x8 a = frag_row(sQ, 528, wid * 16, dh * 128 + k0, lane);
#pragma unroll
          for (int n = 0; n < 8; ++n) { const bf16x8 bb = frag_row(sKP, 272, n * 16, k0, lane); accS[n] = MFMA16(a, bb, accS[n]); } }
      }
      LDS_BAR();
#pragma unroll
      for (int n = 0; n < 8; ++n) { const int os = j * 128 + n * 16 + sl;
#pragma unroll
        for (int r = 0; r < 4; ++r) { const int t = tb + r; const int df = i * 128 + t - os;
          float w = 0.f; if (df >= 0) w += __expf(lgf * (float)df); if (df <= 0) w += __expf(-lgb * (float)df);
          *(LAS u16*)(sKP + t * 272 + (n * 16 + sl) * 2) = f2bf(accS[n][r] * w); } }
#pragma unroll 1
      for (int s4 = 0; s4 < 4; ++s4) {
        LDS_BAR();
#pragma unroll
        for (int q = 0; q < 4; ++q) *(LAS u32x4*)(sV + dV + q * VD) = pf[q];
        { const u16* src = s4 < 3 ? vbase + (size_t)(j * 128 + (s4 + 1) * 32) * 2048 : (j < 3 ? kbase + (size_t)(j + 1) * 128 * 2048 : rbase0); const int qs = s4 < 3 ? VQ : (j < 3 ? KQ : RQ);
#pragma unroll
          for (int q = 0; q < 4; ++q) pf[q] = *(const u32x4*)(src + q * qs); }
        LDS_BAR();
        const bf16x8 a = frag_row(sKP, 272, wid * 16, s4 * 32, lane);
#pragma unroll

#define FR_(n) frag_tr(sV, 1040, (n) * 16, 0, lane)
        SWEEP(32, 6, FR_, a, acc);
#undef FR_
      }
    }
#pragma unroll 1
    for (int dir = 0; dir < 2; ++dir) {
      const int off = i * 128 + wid * 16 + sl;
      const float xi = dir ? __expf(lgb * (float)(512 - off)) : __expf(lgf * (float)(off + 1));
#pragma unroll 1
      for (int ds = 0; ds < 8; ++ds) {
        LDS_BAR();
#pragma unroll
        for (int q = 0; q < 4; ++q) *(LAS u32x4*)(sV + dR + q * RD) = pf[q];
        if (ds < 7 || dir == 0) { const u16* src = ds < 7 ? (dir ? rbase1 : rbase0) + (ds + 1) * 32 : rbase1;
#pragma unroll
          for (int q = 0; q < 4; ++q) pf[q] = *(const u32x4*)(src + q * RQ); }
        LDS_BAR();
        const bf16x8 a = scale_frag(frag_row(sQ, 528, wid * 16, ds * 32, lane), xi);
#pragma unroll

#define FR_(n) frag_row(sV, 80, (n) * 16, 0, lane)
        SWEEP(32, 6, FR_, a, acc);
#undef FR_
      }
    }
#undef kbase
#undef vbase
#undef rbase0
#undef rbase1
#pragma unroll
    for (int r = 0; r < 4; ++r) {
      float s = 0.f;
#pragma unroll
      for (int n = 0; n < 32; ++n) s += acc[n][r];
      const float mu = red16l(s, lane) * (1.f / 512.f); float v = 0.f;
#pragma unroll
      for (int n = 0; n < 32; ++n) { const float d = acc[n][r] - mu; v += d * d; }
      const float rstd = rsqrtf(red16l(v, lane) * (1.f / 512.f) + 1e-6f);
      const size_t row = rowb + i * 128 + tb + r;
#pragma unroll
      for (int n = 0; n < 32; ++n) { const int e = h * 512 + n * 16 + sl; c.y[row * 2048 + e] = f2bf((acc[n][r] - mu) * rstd * c.r_norm_g[e]); }
    }
    LDS_BAR();
  }
}

#define XB_TMO      128
#define XB_XCNT(j)  (256  + 64 * (j))
#define XB_XSUB(j)  (1280 + 64 * (j))
#define XB_XGEN(j)  (2304 + 64 * (j))
#define XB_TOP      3328
#define XB_TOPGEN   3392
#define XCD_BAR_WORDS 3456
#define XB_SPIN_CAP (1u << 18)
__device__ __forceinline__ unsigned xb_ld(unsigned* p)              { return __hip_atomic_load(p, __ATOMIC_RELAXED, __HIP_MEMORY_SCOPE_AGENT); }
__device__ __forceinline__ unsigned xb_add(unsigned* p, unsigned v) { return __hip_atomic_fetch_add(p, v, __ATOMIC_RELAXED, __HIP_MEMORY_SCOPE_AGENT); }
__device__ __forceinline__ unsigned xb_xcc_id() { return (unsigned)__builtin_amdgcn_s_getreg((3 << 11) | 20) & 0xFu; }
#define XB_SPIN(cond, bar) do { unsigned _sp = 0; while (cond) { __builtin_amdgcn_s_sleep(1); \
    if ((++_sp & 255u) == 0u) { if (xb_ld(&(bar)[XB_TMO])) break; if (_sp > XB_SPIN_CAP) { atomicAdd(&(bar)[XB_TMO], 1u); break; } } } } while (0)
struct XcdBarrier { unsigned* bar; unsigned x; volatile LAS unsigned* st; };
__device__ __forceinline__ XcdBarrier xcd_barrier_post(unsigned* bar, volatile LAS unsigned* st) {
    XcdBarrier b; b.bar = bar; b.x = xb_xcc_id(); b.st = st;
    if (threadIdx.x == 0) (void)xb_add(&bar[XB_XCNT(b.x)], 1u);
    return b;
}
__device__ __forceinline__ void xcd_barrier_complete(unsigned* bar, unsigned x, unsigned& nloc, unsigned& nx) {
    const unsigned G = gridDim.x * gridDim.y * gridDim.z;
    unsigned sum, cnt, mine, sp = 0u;
    for (;;) {
        sum = 0u; cnt = 0u; mine = 0u;
#pragma unroll
        for (unsigned j = 0; j < 16; ++j) { const unsigned c = xb_ld(&bar[XB_XCNT(j)]); sum += c; cnt += (c > 0u) ? 1u : 0u; mine = (j == x) ? c : mine; }
        if (sum == G) break;
        __builtin_amdgcn_s_sleep(1);
        if ((++sp & 255u) == 0u) { if (xb_ld(&bar[XB_TMO])) break; if (sp > XB_SPIN_CAP) { atomicAdd(&bar[XB_TMO], 1u); break; } }
    }
    nloc = mine > 0u ? mine : 1u; nx = cnt > 0u ? cnt : 1u;
}
__device__ __forceinline__ void xcd_barrier(const XcdBarrier& b) {
    asm volatile("s_waitcnt vmcnt(0)" ::: "memory");
    __syncthreads();
    if (threadIdx.x == 0) {
        unsigned* bar = b.bar;
        __builtin_amdgcn_s_waitcnt(0);
        unsigned nloc = b.st[0], nx = b.st[1];
        if (nloc == 0u) { xcd_barrier_complete(bar, b.x, nloc, nx); b.st[0] = nloc; b.st[1] = nx; }
        const unsigned old = xb_add(&bar[XB_XSUB(b.x)], 1u);
        const unsigned gen = old / nloc;
        if (old + 1u == (gen + 1u) * nloc) {
            __builtin_amdgcn_fence(__ATOMIC_RELEASE, "agent");
            asm volatile("s_waitcnt vmcnt(0)" ::: "memory");
            const unsigned og = xb_add(&bar[XB_TOP], 1u);
            const unsigned tg = og / nx;
            if (og + 1u == (tg + 1u) * nx) xb_add(&bar[XB_TOPGEN], 1u);
            else XB_SPIN(xb_ld(&bar[XB_TOPGEN]) == tg, bar);
            __builtin_amdgcn_fence(__ATOMIC_ACQUIRE, "agent");
            xb_add(&bar[XB_XGEN(b.x)], 1u);
            asm volatile("s_waitcnt vmcnt(0)" ::: "memory");
        } else {
            XB_SPIN(xb_ld(&bar[XB_XGEN(b.x)]) == gen, bar);
            __builtin_amdgcn_fence(__ATOMIC_ACQUIRE, "agent");
            asm volatile("s_waitcnt vmcnt(0)" ::: "memory");
        }
    }
    __syncthreads();
}

__global__ void __launch_bounds__(512) fwd_megakernel(Params p) {
  extern __shared__ __attribute__((aligned(16))) unsigned char shm[];
  ldsp lds = (ldsp)shm;
  cg::grid_group grid = cg::this_grid();
  volatile LAS unsigned* xst = (volatile LAS unsigned*)(lds + LDS_BYTES - 16);
  if (threadIdx.x == 0) { xst[0] = 0u; xst[1] = 0u; }
  __syncthreads();
  const XcdBarrier xb = xcd_barrier_post(p.c.bar, xst);
#pragma unroll 1
  for (int pi = 0; pi < p.nph; ++pi) {
    const Phase& ph = p.ph[pi];
    switch (ph.type) {
      case PH_INIT:
#ifndef NO_INIT
      phase_init(lds, p.c);
#endif
      break;
      case PH_NORM:
#ifndef NO_NORM
      phase_norm(lds, ph, p.c);
#endif
      break;
      case PH_GEMM:
#ifndef NO_GEMM
      gemm_phase(lds, ph, p.c);
#endif
      break;
      case PH_MCONV:
#ifndef NO_MCONV
      phase_mconv(p.c);
#endif
      break;
      case PH_MA:
#ifndef NO_MA
      phase_ma(lds, p.c);
#endif
      break;
      case PH_MB:
#ifndef NO_MB
      phase_mb(p.c);
#endif
      break;
      case PH_MC:
#ifndef NO_MC
      phase_mc(lds, p.c);
#endif
      break;
      case PH_RA:
#ifndef NO_RA
      phase_ra(lds, ph, p.c);
#endif
      break;
      case PH_RB:
#ifndef NO_RB
      phase_rb(ph, p.c);
#endif
      break;
      case PH_RC:
#ifndef NO_RC
      phase_rc(lds, ph, p.c);
#endif
      break;
      case PH_FINAL: phase_final(p.c); break;
      default: break;
    }
    if (pi == 0) grid.sync(); else xcd_barrier(xb);
  }
}

static void add_phase(Params& P, int type, int M, int N, int K, int i0, int i1, float f0, int pad, const void* A, const void* B, void* O, const void* X) {
  const int reps = (((DUP_TYPES >> type) & 1u) && (type != PH_GEMM || ((DUP_EPIS >> i0) & 1u))) ? 2 : 1;
  for (int rep = 0; rep < reps; ++rep) {
  Phase& ph = P.ph[P.nph++]; ph.type = type; ph.M = M; ph.N = N; ph.K = K; ph.i0 = i0; ph.i1 = i1; ph.f0 = f0; ph.pad = pad; ph.A = A; ph.B = B; ph.O = O; ph.X = X;
  }
}

extern "C" void kernel_launch(void* const* d_in, const int* in_sizes, int n_in, void* d_out, int out_size, void* d_ws, size_t ws_size, hipStream_t stream) {
  static int grid_blocks = 0;
  if (!grid_blocks) {
    int dev = 0, cus = 0, per_cu = 0;
    hipGetDevice(&dev);
    hipDeviceGetAttribute(&cus, hipDeviceAttributeMultiprocessorCount, dev);
    hipFuncSetAttribute((const void*)fwd_megakernel, hipFuncAttributeMaxDynamicSharedMemorySize, LDS_BYTES);
    hipOccupancyMaxActiveBlocksPerMultiprocessor(&per_cu, (const void*)fwd_megakernel, 512, LDS_BYTES);
    if (per_cu < 1) per_cu = 1;
    grid_blocks = cus * per_cu;
  }
  Params P; memset(&P, 0, sizeof(P));
  Ctx& c = P.c;
  c.x = (const float*)d_in[0]; c.c = (const float*)d_in[1]; c.ctx = (const float*)d_in[2]; c.c_ctx = (const float*)d_in[3];
  c.mod_w = (const float*)d_in[4]; c.mod_b = (const float*)d_in[5]; c.norm_g = (const float*)d_in[6]; c.w13 = (const float*)d_in[7]; c.w2 = (const float*)d_in[8];
  c.m_w_in = (const float*)d_in[9]; c.m_gate_b = (const float*)d_in[10]; c.m_conv_w = (const float*)d_in[11]; c.m_norm_g = (const float*)d_in[12]; c.m_w_out = (const float*)d_in[13];
  c.r_w_in = (const float*)d_in[14]; c.r_decay = (const float*)d_in[15]; c.r_norm_g = (const float*)d_in[16]; c.r_w_out = (const float*)d_in[17]; c.final_g = (const float*)d_in[18];
  c.out = (float*)d_out; c.y = (u16*)d_out;
  char* w = (char*)d_ws; size_t off = 0;
  auto take = [&](size_t bytes) { char* r = w + off; off += (bytes + 255) & ~(size_t)255; return r; };
  c.bar = (unsigned*)take((size_t)XCD_BAR_WORDS * 4);
  c.modv = (float*)take((size_t)2 * 5 * 9216 * 4);
  c.rope = (float*)take((size_t)8192 * 128 * 8);
  c.gates = (float*)take((size_t)NT * 32 * 4);
  c.mst_n = (float*)take((size_t)64 * 66 * 64 * 4);
  c.mst_s = (float*)take((size_t)3 * 4224 * 4);
  c.xr = (float*)take((size_t)NT * 1024 * 4);
  c.hb = (u16*)take((size_t)NT * 1024 * 2);
  c.wb = (u16*)take((size_t)(5632 + 2816) * 1024 * 2);
  c.big = (u16*)take((size_t)NT * 3072 * 2 + (size_t)64 * 66 * 8192 * 2);
  c.part = (float*)((char*)c.big + (size_t)NT * 2816 * 2);
  c.part2 = (float*)take((size_t)4 * 1024 * 1024 * 4);
  if (off > ws_size) { fprintf(stderr, "workspace too small: need %zu have %zu\n", off, ws_size); return; }
  u16* hid = c.big;
  for (int l = 0; l < 2; ++l) {
    if (l == 0) add_phase(P, PH_INIT, 0, 0, 0, 0, 0, 0.f, 0, nullptr, nullptr, nullptr, nullptr);
    const float* modl = c.modv + (size_t)l * 5 * 9216;
    add_phase(P, PH_NORM, NT, l == 0 ? 1 : (NSPL << 8), 0, l, 0, 0.5f, 0, nullptr, nullptr, nullptr, c.modv + 8 * 1024);
    add_phase(P, PH_GEMM, NT, 5632, 1024, EPI_SWIGLU, 0, 0.f, 0, c.hb, c.wb, hid, nullptr);
    add_phase(P, PH_GEMM, NT, 1024, 2816, EPI_RESID, SPLITF | (l == 0 ? 2 : 0), 0.5f, 0, hid, c.wb + (size_t)5632 * 1024, c.xr, modl + 2 * 1024);
    if (l == 0) {
      add_phase(P, PH_NORM, NT, NSPL << 8, 0, l, 1, 0.5f, 1, nullptr, nullptr, nullptr, modl + 2 * 1024);
      add_phase(P, PH_GEMM, NT, 3328, 1024, EPI_MLSTM_U, 0, 0.f, 0, c.hb, c.wb, c.big, nullptr);
      add_phase(P, PH_MCONV, 0, 0, 0, 0, 0, 0.f, 0, nullptr, nullptr, nullptr, nullptr);
      add_phase(P, PH_MA, 0, 0, 0, 0, 0, 0.f, 0, nullptr, nullptr, nullptr, nullptr);
      add_phase(P, PH_MB, 0, 0, 0, 0, 0, 0.f, 0, nullptr, nullptr, nullptr, nullptr);
      add_phase(P, PH_MC, 0, 0, 0, 0, 0, 0.f, 0, nullptr, nullptr, nullptr, nullptr);
      add_phase(P, PH_GEMM, NT, 1024, 1024, EPI_RESID, 1 | 4, 1.0f, 0, c.y, c.wb + (size_t)3328 * 1024, c.xr, modl + 5 * 1024);
    } else {
      add_phase(P, PH_NORM, NT, NSPL << 8, 0, l, 1, 0.5f, 2, nullptr, nullptr, nullptr, modl + 2 * 1024);
      for (int hp = 0; hp < 2; ++hp) {
        add_phase(P, PH_GEMM, NT, 2048, 1024, EPI_RET_U, 0, 0.f, 0, c.hb, c.wb + (size_t)hp * 2048 * 1024, c.big, nullptr);
        add_phase(P, PH_RA, 0, 0, 0, hp, 0, 0.f, 0, nullptr, nullptr, nullptr, nullptr);
        add_phase(P, PH_RB, 0, 0, 0, hp, 0, 0.f, 0, nullptr, nullptr, nullptr, nullptr);
        add_phase(P, PH_RC, 0, 0, 0, hp, 0, 0.f, 0, nullptr, nullptr, nullptr, nullptr);
      }
      add_phase(P, PH_GEMM, NL, 2048, 1024, EPI_GATE, 0, 0.f, 0, c.hb, c.wb + (size_t)4096 * 1024, c.y, nullptr);
      add_phase(P, PH_GEMM, NL, 1024, 2048, EPI_RESID, 0, 1.0f, 0, c.y, c.wb + (size_t)6144 * 1024, c.xr, modl + 5 * 1024);
    }
    const int M2 = l == 1 ? NL : NT;
    add_phase(P, PH_NORM, M2, l == 0 ? ((4 << 8) | 2) : 0, 1, l, 2, 1.0f, 0, nullptr, nullptr, nullptr, modl + 5 * 1024);
    add_phase(P, PH_GEMM, M2, 5632, 1024, EPI_SWIGLU, 0, 0.f, 0, c.hb, c.wb, hid, nullptr);
    add_phase(P, PH_GEMM, M2, 1024, 2816, EPI_RESID, l == 0 ? SPLITF : 0, 0.5f, 0, hid, c.wb + (size_t)5632 * 1024, c.xr, modl + 8 * 1024);
  }
#ifdef EXTRA_NOPS
  for (int q = 0; q < EXTRA_NOPS; ++q) add_phase(P, PH_NOP, 0, 0, 0, 0, 0, 0.f, 0, nullptr, nullptr, nullptr, nullptr);
#endif
  add_phase(P, PH_FINAL, 0, 0, 0, 0, 0, 0.f, 0, nullptr, nullptr, nullptr, nullptr);
  hipMemsetAsync(c.bar, 0, (size_t)XCD_BAR_WORDS * 4, stream);
  void* args[] = {&P};
  hipError_t e = hipLaunchCooperativeKernel((const void*)fwd_megakernel, dim3(grid_blocks), dim3(512), args, LDS_BYTES, stream);
  if (e != hipSuccess) fprintf(stderr, "cooperative launch failed: %s (grid %d)\n", hipGetErrorString(e), grid_blocks);
}
```

```cpp
#include <hip/hip_runtime.h>
#include <hip/hip_cooperative_groups.h>
#include <cstdio>
#include <cstring>
namespace cg = cooperative_groups;

typedef unsigned short u16;
typedef short bf16x8 __attribute__((ext_vector_type(8)));
typedef short s16x4 __attribute__((ext_vector_type(4)));
typedef float f32x4 __attribute__((ext_vector_type(4)));
typedef unsigned u32x4 __attribute__((ext_vector_type(4)));
typedef unsigned u32x2 __attribute__((ext_vector_type(2)));
#define LAS __attribute__((address_space(3)))
typedef LAS unsigned char* ldsp;

#define NT 33792
#define NL 32768
#define LDS_BYTES 155648

enum { PH_INIT = 0, PH_NORM, PH_GEMM, PH_MCONV, PH_MA, PH_MB, PH_MC, PH_RA, PH_RB, PH_RC, PH_FINAL, PH_NOP };
enum { EPI_SWIGLU = 0, EPI_RESID, EPI_MLSTM_U, EPI_RET_U, EPI_GATE };

struct Phase { int type, M, N, K; int i0, i1; float f0; int pad; const void* A; const void* B; void* O; const void* X; };
#define MAXPH 56
#ifndef SPLITF
#define SPLITF 1
#endif
#define NSPL (SPLITF ? 11 : 0)
#ifndef DUP_TYPES
#define DUP_TYPES 0u
#endif
#ifndef DUP_EPIS
#define DUP_EPIS 0u
#endif
struct Ctx {
  const float *x, *c, *ctx, *c_ctx, *mod_w, *mod_b, *norm_g, *w13, *w2, *m_w_in, *m_gate_b, *m_conv_w, *m_norm_g, *m_w_out, *r_w_in, *r_decay, *r_norm_g, *r_w_out, *final_g;
  float* out; float* modv; float* rope; float* gates; float* mst_n; float* mst_s; float* xr;
  u16* hb; u16* wb; u16* big; u16* y; unsigned* bar; float* part; float* part2;
};
struct Params { Ctx c; int nph; int pad; Phase ph[MAXPH]; };

typedef __bf16 bf16x2_t __attribute__((ext_vector_type(2)));
__device__ __forceinline__ u16 f2bf(float f) { return __builtin_bit_cast(u16, (__bf16)f); }
__device__ __forceinline__ float bf2f(u16 b) { return __uint_as_float(((unsigned)b) << 16); }
__device__ __forceinline__ unsigned pack2(float a, float b) { bf16x2_t v; v[0] = (__bf16)a; v[1] = (__bf16)b; return __builtin_bit_cast(unsigned, v); }
__device__ __forceinline__ float lo2f(unsigned w) { return __uint_as_float(w << 16); }
__device__ __forceinline__ float hi2f(unsigned w) { return __uint_as_float(w & 0xffff0000u); }
__device__ __forceinline__ float4 ldnt4(const float4* p) { const f32x4 v = __builtin_nontemporal_load((const f32x4*)p); return make_float4(v[0], v[1], v[2], v[3]); }
__device__ __forceinline__ void stnt4(float4* p, float4 v) { f32x4 t; t[0] = v.x; t[1] = v.y; t[2] = v.z; t[3] = v.w; __builtin_nontemporal_store(t, (f32x4*)p); }
__device__ __forceinline__ float siluf(float a) { return a * __builtin_amdgcn_rcpf(1.f + __expf(-a)); }
__device__ __forceinline__ float sigmf(float a) { return __builtin_amdgcn_rcpf(1.f + __expf(-a)); }
__device__ __forceinline__ float logsig(float a) { return fminf(a, 0.f) - log1pf(expf(-fabsf(a))); }

__device__ __forceinline__ bf16x8 frag_row(ldsp base, int pitch, int idx0, int k0, int lane) {
  return *(const LAS bf16x8*)(base + (idx0 + (lane & 15)) * pitch + (k0 + 8 * (lane >> 4)) * 2);
}
__device__ __forceinline__ bf16x8 frag_tr(ldsp base, int pitch, int idx0, int k0, int lane) {
  const int g = lane >> 4, li = lane & 15, q = li >> 2, p = li & 3;
  ldsp a = base + (k0 + 8 * g + q) * pitch + (idx0 + 4 * p) * 2;
  s16x4 lo = __builtin_amdgcn_ds_read_tr16_b64_v4i16((LAS s16x4*)a);
  s16x4 hi = __builtin_amdgcn_ds_read_tr16_b64_v4i16((LAS s16x4*)(a + 4 * pitch));
  bf16x8 r; r[0] = lo[0]; r[1] = lo[1]; r[2] = lo[2]; r[3] = lo[3]; r[4] = hi[0]; r[5] = hi[1]; r[6] = hi[2]; r[7] = hi[3]; return r;
}
#define LDS_BAR() do { asm volatile("s_waitcnt lgkmcnt(0)" ::: "memory"); __builtin_amdgcn_s_barrier(); asm volatile("" ::: "memory"); } while (0)
#define SWEEP(NT, DEPTH, FRAG, A, ACC) do { bf16x8 bq_[DEPTH]; \
    _Pragma("unroll") for (int n_ = 0; n_ < DEPTH; ++n_) bq_[n_] = FRAG(n_); __builtin_amdgcn_sched_barrier(0); \
    _Pragma("unroll") for (int n_ = 0; n_ < NT; ++n_) { const bf16x8 cur_ = bq_[n_ % DEPTH]; if (n_ + DEPTH < NT) bq_[n_ % DEPTH] = FRAG(n_ + DEPTH); ACC[n_] = MFMA16(A, cur_, ACC[n_]); __builtin_amdgcn_sched_barrier(0); } } while (0)
#define MFMA16(a, b, c) __builtin_amdgcn_mfma_f32_16x16x32_bf16((a), (b), (c), 0, 0, 0)
__device__ __forceinline__ float shx(float v, int m, int lane) { return __int_as_float(__builtin_amdgcn_ds_bpermute((lane ^ m) << 2, __float_as_int(v))); }
__device__ __forceinline__ float shup(float v, int d, int lane, float ident) { const int src = lane - d; const float r = __int_as_float(__builtin_amdgcn_ds_bpermute(src << 2, __float_as_int(v))); return src >= 0 ? r : ident; }
__device__ __forceinline__ float shdn(float v, int d, int lane, float ident) { const int src = lane + d; const float r = __int_as_float(__builtin_amdgcn_ds_bpermute(src << 2, __float_as_int(v))); return src < 64 ? r : ident; }
__device__ __forceinline__ float lane63(float v) { return __int_as_float(__builtin_amdgcn_readlane(__float_as_int(v), 63)); }
__device__ __forceinline__ float red16l(float v, int lane) { v += shx(v, 1, lane); v += shx(v, 2, lane); v += shx(v, 4, lane); v += shx(v, 8, lane); return v; }

namespace pg8 {
constexpr int BM = 256, BK = 64, HALF = 128, HTB = HALF * BK * 2, NXCD = 8, WGM = 8;
__device__ __forceinline__ int lds_byte(int r, int c) { const int st = (r >> 4) * 2 + (c >> 5), rr = r & 15, cc = c & 31, ob = rr * 64 + cc * 2; return st * 1024 + (ob ^ (((ob >> 9) & 1) << 5)); }
__device__ __forceinline__ void stage_rc(int b, int& R, int& C) { const int st = b / 1024, sb = b % 1024, swz = sb ^ (((sb >> 9) & 1) << 5); R = (st >> 1) * 16 + swz / 64; C = (st & 1) * 32 + (swz % 64) / 2; }
struct Unit { int pm, pn, k0, nt, at; };
struct StaticOrder {
  int nM, nN, nwg, G, c, nsplit, nsu, ntf;
  __device__ void init(int M, int N, int K, int split, int G_, int c_) { nM = M / BM; nN = N / BM; nsplit = 0; nsu = 0; ntf = K / BK;
    if (split) { nM = NL / BM; nsplit = K / 256; nsu = (M / BM - nM) * nN * nsplit; }
    nwg = nM * nN; G = G_; c = c_; }
  __device__ bool next(int i, Unit& u) const {
    const long L = (long)i * G + c;
    int pm = 0, pn = 0, k0 = 0, nt = ntf, at = 0; bool ok = true;
    if (L >= nwg) {
      const long s = L - nwg;
      if (s >= nsu) ok = false;
      else { const int ks = (int)(s % nsplit), r = (int)(s / nsplit); pn = r % nN; pm = nM + r / nN; k0 = ks * 256; nt = 4; at = ks + 1; }
    } else {
      int wgid = (int)L; { const int q = nwg / NXCD, r = nwg % NXCD, xcd = wgid % NXCD, off = wgid / NXCD; wgid = (xcd < r ? xcd * (q + 1) : r * (q + 1) + (xcd - r) * q) + off; }
      const int nig = WGM * nN, gid = wgid / nig, fm = gid * WGM, gsz = (nM - fm) < WGM ? (nM - fm) : WGM;
      pm = fm + ((wgid % nig) % gsz); pn = (wgid % nig) / gsz;
    }
    u.pm = pm; u.pn = pn; u.k0 = k0; u.nt = nt; u.at = at; return ok;
  }
};
}

__device__ __forceinline__ int perm32(int rho) { const int n = rho >> 4, i = rho & 15; return 8 * (i >> 2) + 4 * n + (i & 3); }
__device__ __forceinline__ void epi_apply(const Phase& ph, const Ctx& c, const f32x4 (&acc)[2][2][4][2], int pm, int pn, int at, int wr, int wc, int fr, int fq) {
  const int row0 = pm * 256 + wr * 64 + fr;
  const int epi = ph.i0;
  if (epi == EPI_SWIGLU) {
    u16* O = (u16*)ph.O;
    const int hc = pn * 128 + wc * 32 + fq * 8;
#pragma unroll
    for (int ai = 0; ai < 2; ++ai)
#pragma unroll
      for (int m = 0; m < 4; ++m) {
        const size_t row = row0 + ai * 128 + m * 16;
        const f32x4 a0 = acc[ai][0][m][0], b0 = acc[ai][1][m][0], a1 = acc[ai][0][m][1], b1 = acc[ai][1][m][1];
        u32x4 o; o.x = pack2(siluf(a0[0]) * b0[0], siluf(a0[1]) * b0[1]); o.y = pack2(siluf(a0[2]) * b0[2], siluf(a0[3]) * b0[3]);
        o.z = pack2(siluf(a1[0]) * b1[0], siluf(a1[1]) * b1[1]); o.w = pack2(siluf(a1[2]) * b1[2], siluf(a1[3]) * b1[3]);
        *(u32x4*)(O + row * 2816 + hc) = o;
      }
  } else if (epi == EPI_RESID) {
    float* X = (float*)ph.O; const float* gate = (const float*)ph.X; const float f0 = ph.f0;
    const int r256 = pm * 256; const int set = r256 < NL ? (r256 >> 13) : 4;
    const float* Xs = ((ph.i1 & 2) && r256 < NL) ? c.x : (const float*)X;
    gate += (size_t)set * 9216;
    if (at) {
      float* P = ((ph.i1 & 4) ? c.part2 : c.part) + ((size_t)(at - 1) * 1024 - NL) * 1024;
#pragma unroll
      for (int bj = 0; bj < 2; ++bj)
#pragma unroll
        for (int n = 0; n < 2; ++n) {
          const int col = pn * 256 + bj * 128 + wc * 32 + n * 16 + fq * 4;
#pragma unroll
          for (int ai = 0; ai < 2; ++ai)
#pragma unroll
            for (int m = 0; m < 4; ++m) { const size_t row = row0 + ai * 128 + m * 16; *(f32x4*)(P + row * 1024 + col) = acc[ai][bj][m][n]; }
        }
    } else {
#pragma unroll
      for (int bj = 0; bj < 2; ++bj)
#pragma unroll
        for (int n = 0; n < 2; ++n) {
          const int col = pn * 256 + bj * 128 + wc * 32 + n * 16 + fq * 4;
          const f32x4 g = *(const f32x4*)(gate + col);
#pragma unroll
          for (int ai = 0; ai < 2; ++ai)
#pragma unroll
            for (int m = 0; m < 4; ++m) {
              const size_t row = row0 + ai * 128 + m * 16;
              f32x4 xv = *(const f32x4*)(Xs + row * 1024 + col); const f32x4 a = acc[ai][bj][m][n];
              xv[0] += f0 * g[0] * a[0]; xv[1] += f0 * g[1] * a[1]; xv[2] += f0 * g[2] * a[2]; xv[3] += f0 * g[3] * a[3];
              *(f32x4*)(X + row * 1024 + col) = xv;
            }
        }
    }
  } else if (epi == EPI_MLSTM_U) {
    if (pn < 12) {
      u16* O = (u16*)ph.O;
#pragma unroll
      for (int ai = 0; ai < 2; ++ai)
#pragma unroll
        for (int m = 0; m < 4; ++m) {
          const size_t row = row0 + ai * 128 + m * 16;
#pragma unroll
          for (int bj = 0; bj < 2; ++bj) {
            const int col = pn * 256 + bj * 128 + wc * 32 + fq * 8; const f32x4 a0 = acc[ai][bj][m][0], a1 = acc[ai][bj][m][1];
            u32x4 o; o.x = pack2(a0[0], a0[1]); o.y = pack2(a0[2], a0[3]); o.z = pack2(a1[0], a1[1]); o.w = pack2(a1[2], a1[3]);
            *(u32x4*)(O + row * 3072 + col) = o;
          }
        }
    } else if (wc == 0) {
      float* G = c.gates; const float* gb = c.m_gate_b;
#pragma unroll
      for (int n = 0; n < 2; ++n) {
        const int col = fq * 8 + n * 4; const f32x4 b = *(const f32x4*)(gb + col);
#pragma unroll
        for (int ai = 0; ai < 2; ++ai)
#pragma unroll
          for (int m = 0; m < 4; ++m) {
            const size_t row = row0 + ai * 128 + m * 16; const f32x4 a = acc[ai][0][m][n];
            f32x4 o; o[0] = a[0] + b[0]; o[1] = a[1] + b[1]; o[2] = a[2] + b[2]; o[3] = a[3] + b[3];
            *(f32x4*)(G + row * 32 + col) = o;
          }
      }
    }
  } else if (epi == EPI_RET_U) {
    u16* O = (u16*)ph.O; const float* rope = c.rope;
    const bool dorope = (pn < 4) && (pm * 256 < NL);
#pragma unroll
    for (int ai = 0; ai < 2; ++ai)
#pragma unroll
      for (int m = 0; m < 4; ++m) {
        const size_t row = row0 + ai * 128 + m * 16; const int t = (int)(row & 8191);
#pragma unroll
        for (int bj = 0; bj < 2; ++bj) {
          const int col = pn * 256 + bj * 128 + wc * 32 + fq * 8; f32x4 a0 = acc[ai][bj][m][0], a1 = acc[ai][bj][m][1];
          if (dorope) {
            const int p0 = (col & 255) >> 1;
            const f32x4 c0 = *(const f32x4*)(rope + ((size_t)t * 128 + p0) * 2), c1 = *(const f32x4*)(rope + ((size_t)t * 128 + p0) * 2 + 4);
            const float e0 = a0[0] * c0[0] - a0[1] * c0[1], o0 = a0[0] * c0[1] + a0[1] * c0[0];
            const float e1 = a0[2] * c0[2] - a0[3] * c0[3], o1 = a0[2] * c0[3] + a0[3] * c0[2];
            const float e2 = a1[0] * c1[0] - a1[1] * c1[1], o2 = a1[0] * c1[1] + a1[1] * c1[0];
            const float e3 = a1[2] * c1[2] - a1[3] * c1[3], o3 = a1[2] * c1[3] + a1[3] * c1[2];
            a0[0] = e0; a0[1] = o0; a0[2] = e1; a0[3] = o1; a1[0] = e2; a1[1] = o2; a1[2] = e3; a1[3] = o3;
          }
          u32x4 o; o.x = pack2(a0[0], a0[1]); o.y = pack2(a0[2], a0[3]); o.z = pack2(a1[0], a1[1]); o.w = pack2(a1[2], a1[3]);
          *(u32x4*)(O + row * 2048 + col) = o;
        }
      }
  } else {
    u16* O = (u16*)ph.O;
#pragma unroll
    for (int ai = 0; ai < 2; ++ai)
#pragma unroll
      for (int m = 0; m < 4; ++m) {
        const size_t row = row0 + ai * 128 + m * 16;
#pragma unroll
        for (int bj = 0; bj < 2; ++bj) {
          const int col = pn * 256 + bj * 128 + wc * 32 + fq * 8; const f32x4 a0 = acc[ai][bj][m][0], a1 = acc[ai][bj][m][1];
          u32x4* yp = (u32x4*)(O + row * 2048 + col); u32x4 yv = *yp;
          yv.x = pack2(lo2f(yv.x) * siluf(a0[0]), hi2f(yv.x) * siluf(a0[1])); yv.y = pack2(lo2f(yv.y) * siluf(a0[2]), hi2f(yv.y) * siluf(a0[3]));
          yv.z = pack2(lo2f(yv.z) * siluf(a1[0]), hi2f(yv.z) * siluf(a1[1])); yv.w = pack2(lo2f(yv.w) * siluf(a1[2]), hi2f(yv.w) * siluf(a1[3]));
          *yp = yv;
        }
      }
  }
}

__device__ __forceinline__ void gemm_phase(ldsp lds, const Phase& ph, const Ctx& c) {
  using namespace pg8;
  int tid = threadIdx.x; asm volatile("" : "+v"(tid)); const int wid = __builtin_amdgcn_readfirstlane(tid >> 6), lane = tid & 63, wr = wid >> 2, wc = wid & 3, fr = lane & 15, fq = lane >> 4;
  const int K = ph.K;
  StaticOrder S; S.init(ph.M, ph.N, ph.K, ph.i1 & 1, gridDim.x, blockIdx.x);
  unsigned voffA[2];
#pragma unroll
  for (int i = 0; i < 2; ++i) { int R, C; stage_rc(tid * 16 + i * 8192, R, C); voffA[i] = (unsigned)(R * K + C) * 2u; }
  const size_t kstep = (size_t)(BK * 2);
  const size_t hstep = (size_t)HALF * K * 2;
  const size_t tstep = 2 * hstep;
  const unsigned ldsw = (unsigned)wid * 1024u;
  const int aoff = lds_byte(wr * 64 + fr, fq * 8), boff = lds_byte(wc * 32 + fr, fq * 8);
#define PG8_SA(b, h) (((b) * 2 + (h)) * HTB)
#define PG8_SB(b, h) ((4 + (b) * 2 + (h)) * HTB)
#define PG8_STAGE(bufoff, gbase, voff) do { _Pragma("unroll") for (int _i = 0; _i < 2; ++_i) \
    __builtin_amdgcn_global_load_lds((const unsigned*)((const char*)(gbase) + (voff)[_i]), (LAS unsigned*)(lds + (bufoff) + ldsw + _i * 8192), 16, 0, 0); } while (0)
#define PG8_LDA(dst, b, h) do { _Pragma("unroll") for (int m = 0; m < 4; ++m) _Pragma("unroll") for (int k = 0; k < 2; ++k) dst[m][k] = *(const LAS bf16x8*)(lds + PG8_SA(b, h) + aoff + m * 2048 + k * 1024); } while (0)
#define PG8_LDB(dst, b, h) do { _Pragma("unroll") for (int n = 0; n < 2; ++n) _Pragma("unroll") for (int k = 0; k < 2; ++k) dst[n][k] = *(const LAS bf16x8*)(lds + PG8_SB(b, h) + boff + n * 2048 + k * 1024); } while (0)
#define PG8_MMA(ai, bj, At, Bt) do { __builtin_amdgcn_s_setprio(1); _Pragma("unroll") for (int m = 0; m < 4; ++m) _Pragma("unroll") for (int n = 0; n < 2; ++n) _Pragma("unroll") for (int k = 0; k < 2; ++k) \
    acc[ai][bj][m][n] = __builtin_amdgcn_mfma_f32_16x16x32_bf16(Bt[n][k], At[m][k], acc[ai][bj][m][n], 0, 0, 0); __builtin_amdgcn_s_setprio(0); } while (0)
#define PG8_WAIT_V(n) asm volatile("s_waitcnt vmcnt(" #n ")" ::: "memory")
#define PG8_WAIT_L(n) asm volatile("s_waitcnt lgkmcnt(" #n ")" ::: "memory")
#define PG8_BAR __builtin_amdgcn_s_barrier()
#define PG8_SCHED __builtin_amdgcn_sched_barrier(0)
  Unit cur, nxt; int ui = 0;
  if (!S.next(0, cur)) return;
  f32x4 acc[2][2][4][2];
#pragma unroll
  for (int a = 0; a < 2; ++a)
#pragma unroll
    for (int b = 0; b < 2; ++b)
#pragma unroll
      for (int m = 0; m < 4; ++m)
#pragma unroll
        for (int n = 0; n < 2; ++n) acc[a][b][m][n] = (f32x4){0.f, 0.f, 0.f, 0.f};
  bf16x8 At[4][2], B0[2][2], B1[2][2];
  const char* cA = (const char*)ph.A + (size_t)cur.pm * tstep + (size_t)cur.k0 * 2; const char* cB = (const char*)ph.B + (size_t)cur.pn * tstep + (size_t)cur.k0 * 2;
  PG8_STAGE(PG8_SB(0, 0), cB, voffA); PG8_STAGE(PG8_SA(0, 0), cA, voffA); PG8_STAGE(PG8_SB(0, 1), cB + hstep, voffA); PG8_STAGE(PG8_SA(0, 1), cA + hstep, voffA);
  if (wr == 1) PG8_BAR;
  PG8_WAIT_V(4); PG8_BAR;
  PG8_STAGE(PG8_SB(1, 0), cB + kstep, voffA); PG8_STAGE(PG8_SA(1, 0), cA + kstep, voffA); PG8_STAGE(PG8_SB(1, 1), cB + hstep + kstep, voffA);
  PG8_WAIT_V(6); PG8_BAR;
  for (;;) {
    const bool has_next = S.next(ui + 1, nxt);
    const char* nA = has_next ? (const char*)ph.A + (size_t)nxt.pm * tstep + (size_t)nxt.k0 * 2 : cA; const char* nB = has_next ? (const char*)ph.B + (size_t)nxt.pn * tstep + (size_t)nxt.k0 * 2 : cB;
    const int nt = cur.nt;
    for (int t = 0; t < nt; t += 2) {
      const bool last = (t == nt - 2);
      const char* a1 = cA + (size_t)(t + 1) * kstep;
      const char* a2 = last ? nA : cA + (size_t)(t + 2) * kstep; const char* b2 = last ? nB : cB + (size_t)(t + 2) * kstep;
      const char* a3 = a2 + kstep; const char* b3 = b2 + kstep;
      PG8_LDB(B0, 0, 0); PG8_SCHED; PG8_LDA(At, 0, 0); PG8_STAGE(PG8_SA(1, 1), a1 + hstep, voffA);
      PG8_WAIT_L(8); PG8_BAR; PG8_WAIT_L(0); PG8_MMA(0, 0, At, B0); PG8_BAR; PG8_SCHED;
      PG8_LDB(B1, 0, 1); PG8_STAGE(PG8_SB(0, 0), b2, voffA);
      PG8_BAR; PG8_WAIT_L(0); PG8_MMA(0, 1, At, B1); PG8_BAR;
      PG8_LDA(At, 0, 1); PG8_STAGE(PG8_SA(0, 0), a2, voffA);
      PG8_BAR; PG8_WAIT_L(0); PG8_MMA(1, 0, At, B0); PG8_BAR; PG8_SCHED;
      PG8_STAGE(PG8_SB(0, 1), b2 + hstep, voffA);
      PG8_WAIT_V(6); PG8_BAR; PG8_MMA(1, 1, At, B1); PG8_BAR;
      PG8_LDB(B0, 1, 0); PG8_SCHED; PG8_LDA(At, 1, 0); PG8_STAGE(PG8_SA(0, 1), a2 + hstep, voffA);
      PG8_WAIT_L(8); PG8_BAR; PG8_WAIT_L(0); PG8_MMA(0, 0, At, B0); PG8_BAR; PG8_SCHED;
      PG8_LDB(B1, 1, 1); PG8_STAGE(PG8_SB(1, 0), b3, voffA);
      PG8_BAR; PG8_WAIT_L(0); PG8_MMA(0, 1, At, B1); PG8_BAR;
      PG8_LDA(At, 1, 1); PG8_STAGE(PG8_SA(1, 0), a3, voffA);
      PG8_BAR; PG8_WAIT_L(0); PG8_MMA(1, 0, At, B0); PG8_BAR; PG8_SCHED;
      PG8_STAGE(PG8_SB(1, 1), b3 + hstep, voffA);
      PG8_WAIT_V(6); PG8_BAR; PG8_MMA(1, 1, At, B1); PG8_BAR;
    }
    epi_apply(ph, c, acc, cur.pm, cur.pn, cur.at, wr, wc, fr, fq);
    if (!has_next) break;
#pragma unroll
    for (int a = 0; a < 2; ++a)
#pragma unroll
      for (int b = 0; b < 2; ++b)
#pragma unroll
        for (int m = 0; m < 4; ++m)
#pragma unroll
          for (int n = 0; n < 2; ++n) acc[a][b][m][n] = (f32x4){0.f, 0.f, 0.f, 0.f};
    cur = nxt; cA = nA; cB = nB; ++ui;
  }
  PG8_WAIT_V(0);
  if (wr == 0) PG8_BAR;
  PG8_BAR;
}

__device__ void phase_init(ldsp lds, const Ctx& c) {
  int tid = threadIdx.x; asm volatile("" : "+v"(tid)); const int wid = tid >> 6, lane = tid & 63;
  LAS float* sc = (LAS float*)lds;
  LAS float* red = (LAS float*)(lds + 20480);
  for (int i = tid; i < 5120; i += 512) { const int s = i >> 10, k = i & 1023; const float v = s < 4 ? c.c[s * 1024 + k] : c.c_ctx[k]; sc[i] = siluf(v); }
  __syncthreads();
  for (int item = blockIdx.x; item < 288; item += gridDim.x) {
    const int l = item / 144, j0 = (item % 144) * 64;
    const float* w = c.mod_w + (size_t)l * 1024 * 9216 + j0 + lane;
    float a0 = 0, a1 = 0, a2 = 0, a3 = 0, a4 = 0;
    for (int k = wid * 128; k < wid * 128 + 128; ++k) {
      const float wv = w[(size_t)k * 9216];
      a0 += sc[k] * wv; a1 += sc[1024 + k] * wv; a2 += sc[2048 + k] * wv; a3 += sc[3072 + k] * wv; a4 += sc[4096 + k] * wv;
    }
    red[(wid * 5 + 0) * 64 + lane] = a0; red[(wid * 5 + 1) * 64 + lane] = a1; red[(wid * 5 + 2) * 64 + lane] = a2; red[(wid * 5 + 3) * 64 + lane] = a3; red[(wid * 5 + 4) * 64 + lane] = a4;
    __syncthreads();
    if (tid < 320) { const int s = tid >> 6; float v = 0; for (int ww = 0; ww < 8; ++ww) v += red[(ww * 5 + s) * 64 + lane];
      c.modv[(size_t)(l * 5 + s) * 9216 + j0 + lane] = v + c.mod_b[l * 9216 + j0 + lane]; }
    __syncthreads();
  }
  const size_t gt = (size_t)blockIdx.x * 512 + tid, gs = (size_t)gridDim.x * 512;
  for (size_t i = gt; i < (size_t)8192 * 128; i += gs) {
    const int t = (int)(i >> 7), p = (int)(i & 127); const int f = p & 63; const int pos = p < 64 ? (t >> 6) : (t & 63);
    const double inv = (double)exp2f(-(float)f * 0.20762050593046015f);
    const double rev = (double)pos * inv * 0.15915494309189535; const float fr = (float)(rev - rint(rev));
    c.rope[i * 2] = __builtin_amdgcn_cosf(fr); c.rope[i * 2 + 1] = __builtin_amdgcn_sinf(fr);
  }
  const float4* cs = (const float4*)c.ctx; float4* xd = (float4*)c.xr;
  for (size_t i = gt; i < (size_t)(NT - NL) * 256; i += gs) xd[(size_t)NL * 256 + i] = cs[i];
}

struct TileD { const float* src; u16* dst; int ld, nvalid, sc0, K, n0, k0, perm; float scale; };
__device__ __forceinline__ void tile_desc(const Ctx& c, int kind, int l, int f, int it, TileD& d) {
  const float* src; u16* dst; int ld, nvalid, sc0, K, n0, k0, perm = 1; float scale = 1.f;
  if (kind == 0) {
    if (it < 1408) { const int nb = it >> 4, kb = it & 15; const int pn = nb >> 2, q = nb & 3;
      src = c.w13 + (size_t)(l * 2 + f) * 1024 * 5632; dst = c.wb; ld = 5632; nvalid = 5632; sc0 = (q < 2 ? 0 : 2816) + 128 * pn + (q & 1) * 64; K = 1024; n0 = nb * 64; k0 = kb * 64; }
    else { const int i2 = it - 1408; const int nb = i2 / 44, kb = i2 % 44;
      perm = 0; src = c.w2 + (size_t)(l * 2 + f) * 2816 * 1024; dst = c.wb + (size_t)5632 * 1024; ld = 1024; nvalid = 1024; sc0 = nb * 64; K = 2816; n0 = nb * 64; k0 = kb * 64; }
  } else if (kind == 1) {
    if (it < 832) { const int nb = it >> 4, kb = it & 15; src = c.m_w_in; dst = c.wb; ld = 3104; nvalid = 3104; sc0 = nb * 64; K = 1024; n0 = nb * 64; k0 = kb * 64; }
    else { const int i2 = it - 832; const int nb = i2 >> 4, kb = i2 & 15; perm = 0; src = c.m_w_out; dst = c.wb + (size_t)3328 * 1024; ld = 1024; nvalid = 1024; sc0 = nb * 64; K = 1024; n0 = nb * 64; k0 = kb * 64; }
  } else {
    if (it < 1536) { const int nb = it >> 4, kb = it & 15; const int n = nb * 64; int s0;
      if (n < 4096) { const int hp = n >> 11, r = n & 2047; if (r < 512) s0 = hp * 512 + r; else if (r < 1024) { s0 = 1024 + hp * 512 + (r - 512); scale = 0.0625f; } else s0 = 2048 + hp * 1024 + (r - 1024); }
      else s0 = n;
      src = c.r_w_in; dst = c.wb; ld = 6144; nvalid = 6144; sc0 = s0; K = 1024; n0 = n; k0 = kb * 64; }
    else { const int i2 = it - 1536; const int nb = i2 >> 5, kb = i2 & 31; perm = 0; src = c.r_w_out; dst = c.wb + (size_t)6144 * 1024; ld = 1024; nvalid = 1024; sc0 = nb * 64; K = 2048; n0 = nb * 64; k0 = kb * 64; }
  }
  d.src = src; d.dst = dst; d.ld = ld; d.nvalid = nvalid; d.sc0 = sc0; d.K = K; d.n0 = n0; d.k0 = k0; d.perm = perm; d.scale = scale;
}
__device__ __forceinline__ void tile_load(const TileD& d, int tid, float4& v0, float4& v1) {
  const int kk = tid >> 4, c4 = (tid & 15) * 4; const int col = d.sc0 + c4;
  v0 = make_float4(0.f, 0.f, 0.f, 0.f); v1 = v0;
  if (col < d.nvalid) { const float* p = d.src + (size_t)(d.k0 + kk) * d.ld + col; v0 = *(const float4*)p; v1 = *(const float4*)(p + (size_t)32 * d.ld); }
}

__device__ void phase_norm(ldsp lds, const Phase& ph, const Ctx& c) {
  int tid = threadIdx.x; asm volatile("" : "+v"(tid)); const int wid = tid >> 6, lane = tid & 63;
  const int l = ph.i0, j = ph.i1, kind = ph.pad;
  {
    const int ntile = kind == 0 ? 2112 : (kind == 1 ? 1088 : 2048);
    LAS float* tile = (LAS float*)lds;
    TileD d; float4 p0, p1; int it = blockIdx.x;
    if (it < ntile) { tile_desc(c, kind, l, ph.K, it, d); tile_load(d, tid, p0, p1); }
#pragma unroll 1
    for (; it < ntile; it += gridDim.x) {
      const float sc = d.scale; const int dperm = d.perm; u16* dptr = d.dst + (size_t)(d.n0 + (tid >> 3)) * d.K + d.k0 + (tid & 7) * 8;
      { const int kk = tid >> 4, c4 = (tid & 15) * 4;
        tile[kk * 65 + c4] = p0.x * sc; tile[kk * 65 + c4 + 1] = p0.y * sc; tile[kk * 65 + c4 + 2] = p0.z * sc; tile[kk * 65 + c4 + 3] = p0.w * sc;
        tile[(kk + 32) * 65 + c4] = p1.x * sc; tile[(kk + 32) * 65 + c4 + 1] = p1.y * sc; tile[(kk + 32) * 65 + c4 + 2] = p1.z * sc; tile[(kk + 32) * 65 + c4 + 3] = p1.w * sc; }
      if (it + (int)gridDim.x < ntile) { tile_desc(c, kind, l, ph.K, it + gridDim.x, d); tile_load(d, tid, p0, p1); }
      __syncthreads();
      { const int nd = tid >> 3, kc = (tid & 7) * 8; const int n = dperm ? (nd & 32) + perm32(nd & 31) : nd; u32x4 o;
        o.x = pack2(tile[(kc + 0) * 65 + n], tile[(kc + 1) * 65 + n]); o.y = pack2(tile[(kc + 2) * 65 + n], tile[(kc + 3) * 65 + n]);
        o.z = pack2(tile[(kc + 4) * 65 + n], tile[(kc + 5) * 65 + n]); o.w = pack2(tile[(kc + 6) * 65 + n], tile[(kc + 7) * 65 + n]);
        *(u32x4*)dptr = o; }
      __syncthreads();
    }
  }
  const float* g = c.norm_g + (size_t)(l * 3 + j) * 1024;
  const int nsplit = ph.N >> 8; const float* pbase = (ph.N & 2) ? c.part2 : c.part;
  const int rstride = gridDim.x * 8;
  float4 nv[4];
  { const int row = blockIdx.x * 8 + wid;
    if (row < ph.M) { const float4* xp = (const float4*)((((ph.N & 1) && row < NL) ? c.x : c.xr) + (size_t)row * 1024);
#pragma unroll
      for (int i = 0; i < 4; ++i) nv[i] = ldnt4(xp + lane + 64 * i); } }
  for (int row = blockIdx.x * 8 + wid; row < ph.M; row += rstride) {
    float4 v[4]; float ss = 0.f;
#pragma unroll
    for (int i = 0; i < 4; ++i) v[i] = nv[i];
    { const int nrow = row + rstride;
      if (nrow < ph.M) { const float4* xp = (const float4*)((((ph.N & 1) && nrow < NL) ? c.x : c.xr) + (size_t)nrow * 1024);
#pragma unroll
        for (int i = 0; i < 4; ++i) nv[i] = ldnt4(xp + lane + 64 * i); } }
    if (nsplit > 0 && row >= NL) {
      const float4* gp = (const float4*)((const float*)ph.X + (size_t)4 * 9216);
#pragma unroll
      for (int i = 0; i < 4; ++i) { float4 a = make_float4(0.f, 0.f, 0.f, 0.f);
        for (int ks = 0; ks < nsplit; ++ks) { const float4 pv = ((const float4*)(pbase + ((size_t)ks * 1024 + (row - NL)) * 1024))[lane + 64 * i]; a.x += pv.x; a.y += pv.y; a.z += pv.z; a.w += pv.w; }
        const float4 g4 = gp[lane + 64 * i]; const float f0 = ph.f0;
        v[i].x += f0 * g4.x * a.x; v[i].y += f0 * g4.y * a.y; v[i].z += f0 * g4.z * a.z; v[i].w += f0 * g4.w * a.w;
        ((float4*)(c.xr + (size_t)row * 1024))[lane + 64 * i] = v[i]; }
    }
#pragma unroll
    for (int i = 0; i < 4; ++i) ss += v[i].x * v[i].x + v[i].y * v[i].y + v[i].z * v[i].z + v[i].w * v[i].w;
#pragma unroll
    for (int o = 1; o < 64; o <<= 1) ss += shx(ss, o, lane);
    const float rstd = rsqrtf(ss * (1.f / 1024.f) + 1e-6f);
    const int set = row < NL ? (row >> 13) : 4;
    const float* sh = c.modv + (size_t)(l * 5 + set) * 9216 + (3 * j) * 1024; const float* sc = sh + 1024;
#pragma unroll
    for (int i = 0; i < 4; ++i) {
      const int q = lane + 64 * i; const float4 g4 = ((const float4*)g)[q], s4 = ((const float4*)sh)[q], c4 = ((const float4*)sc)[q];
      u32x2 o; o.x = pack2(v[i].x * rstd * g4.x * (1.f + c4.x) + s4.x, v[i].y * rstd * g4.y * (1.f + c4.y) + s4.y);
      o.y = pack2(v[i].z * rstd * g4.z * (1.f + c4.z) + s4.z, v[i].w * rstd * g4.w * (1.f + c4.w) + s4.w);
      *(u32x2*)(c.hb + (size_t)row * 1024 + q * 4) = o;
    }
  }
}

__device__ void phase_final(const Ctx& c) {
  int tid = threadIdx.x; asm volatile("" : "+v"(tid)); const int wid = tid >> 6, lane = tid & 63;
  for (int row = blockIdx.x * 8 + wid; row < NL; row += gridDim.x * 8) {
    const float4* xp = (const float4*)(c.xr + (size_t)row * 1024);
    float4 v[4]; float ss = 0.f;
#pragma unroll
    for (int i = 0; i < 4; ++i) { v[i] = ldnt4(xp + lane + 64 * i); ss += v[i].x * v[i].x + v[i].y * v[i].y + v[i].z * v[i].z + v[i].w * v[i].w; }
#pragma unroll
    for (int o = 1; o < 64; o <<= 1) ss += shx(ss, o, lane);
    const float rstd = rsqrtf(ss * (1.f / 1024.f) + 1e-6f);
#pragma unroll
    for (int i = 0; i < 4; ++i) { const int q = lane + 64 * i; const float4 g4 = ((const float4*)c.final_g)[q];
      float4 o; o.x = v[i].x * rstd * g4.x; o.y = v[i].y * rstd * g4.y; o.z = v[i].z * rstd * g4.z; o.w = v[i].w * rstd * g4.w;
      stnt4((float4*)(c.out + (size_t)row * 1024) + q, o); }
  }
}

#define MPRE_ELEMS ((size_t)NT * 3072)
__device__ __forceinline__ int m_chunk_row0(int b, int dir, int cs) {
  if (cs < 2) { const int j = dir ? 1 - cs : cs; return NL + b * 256 + j * 128; }
  const int j = dir ? 65 - cs : cs - 2; return b * 8192 + j * 128;
}

__device__ void phase_mconv(const Ctx& c) {
  const u16* pre = c.big; const float* cw = c.m_conv_w;
  int tid = threadIdx.x; asm volatile("" : "+v"(tid)); const size_t gt = (size_t)blockIdx.x * 512 + tid, gs = (size_t)gridDim.x * 512;
  for (size_t i = gt; i < (size_t)NT * 128; i += gs) {
    const int r = (int)(i >> 7), cg = (int)(i & 127) * 8;
    int pos, len; if (r < NL) { pos = r & 8191; len = 8192; } else { pos = (r - NL) & 255; len = 256; }
    float a[8];
#pragma unroll
    for (int q = 0; q < 8; ++q) a[q] = 0.f;
#pragma unroll
    for (int j = 0; j < 5; ++j) {
      const int pp = pos + j - 2;
      if (pp >= 0 && pp < len) {
        const u32x4 u = *(const u32x4*)(pre + (size_t)(r + j - 2) * 3072 + cg);
        const float4 w0 = *(const float4*)(cw + j * 1024 + cg), w1 = *(const float4*)(cw + j * 1024 + cg + 4);
        a[0] += w0.x * lo2f(u.x); a[1] += w0.y * hi2f(u.x); a[2] += w0.z * lo2f(u.y); a[3] += w0.w * hi2f(u.y);
        a[4] += w1.x * lo2f(u.z); a[5] += w1.y * hi2f(u.z); a[6] += w1.z * lo2f(u.w); a[7] += w1.w * hi2f(u.w);
      }
    }
    const float sc = cg >= 512 ? 0.125f : 1.f;
    u32x4 o; o.x = pack2(siluf(a[0]) * sc, siluf(a[1]) * sc); o.y = pack2(siluf(a[2]) * sc, siluf(a[3]) * sc);
    o.z = pack2(siluf(a[4]) * sc, siluf(a[5]) * sc); o.w = pack2(siluf(a[6]) * sc, siluf(a[7]) * sc);
    *(u32x4*)(c.hb + (size_t)r * 1024 + cg) = o;
  }
}

__device__ void phase_ma(ldsp lds, const Ctx& c) {
  int tid = threadIdx.x; asm volatile("" : "+v"(tid)); const int wid = tid >> 6, lane = tid & 63;
  ldsp sK = lds; ldsp sV = lds + 128 * 144; LAS float* sf = (LAS float*)(lds + 128 * 144 + 128 * 272);
  const u16* pre = c.big; u16* mc = c.big + MPRE_ELEMS;
  const int NIT = 2 * 4 * 8 * 65;
  u32x4 kreg[2], vreg[4]; float gq[4] = {0.f, 0.f, 0.f, 0.f};
#define MA_LOAD(IT) do { const int cs_ = (IT) % 65, sq_ = (IT) / 65; const int h_ = sq_ & 7, b_ = (sq_ >> 3) & 3, dir_ = sq_ >> 5; const int r0_ = m_chunk_row0(b_, dir_, cs_); \
    const u16* kp_ = c.hb + (size_t)(r0_ + (tid >> 2)) * 1024 + 512 + h_ * 64 + (tid & 3) * 16; const u16* vp_ = pre + (size_t)(r0_ + (tid >> 2)) * 3072 + 1024 + h_ * 128 + (tid & 3) * 32; \
    _Pragma("unroll") for (int q = 0; q < 2; ++q) kreg[q] = *(const u32x4*)(kp_ + q * 8); \
    _Pragma("unroll") for (int q = 0; q < 4; ++q) vreg[q] = *(const u32x4*)(vp_ + q * 8); \
    if (wid == 0) { const float* gp_ = c.gates + (size_t)(r0_ + 2 * lane) * 32 + dir_ * 16 + h_; gq[0] = gp_[0]; gq[1] = gp_[8]; gq[2] = gp_[32]; gq[3] = gp_[40]; } } while (0)
  int item = blockIdx.x;
  if (item < NIT) MA_LOAD(item);
#pragma unroll 1
  for (; item < NIT; item += gridDim.x) {
    const int cs = item % 65; const int sq = item / 65; const int dir = sq >> 5;
    if (wid == 0) {
      const float ig0 = gq[0], lf0 = logsig(gq[1]), ig1 = gq[2], lf1 = logsig(gq[3]);
      const float s2 = lf0 + lf1; float inc = s2;
#pragma unroll
      for (int d = 1; d < 64; d <<= 1) inc += shup(inc, d, lane, 0.f);
      const float total = lane63(inc); const float ex = inc - s2;
      const float g0 = (dir ? ex : total - ex - lf0) + ig0;
      const float g1 = (dir ? ex + lf0 : total - ex - lf0 - lf1) + ig1;
      float mx = fmaxf(g0, g1);
#pragma unroll
      for (int m = 1; m < 64; m <<= 1) mx = fmaxf(mx, shx(mx, m, lane));
      sf[256 + 2 * lane] = __expf(g0 - mx); sf[257 + 2 * lane] = __expf(g1 - mx);
      if (lane == 0) { c.mst_s[4224 + sq * 66 + cs] = total; c.mst_s[sq * 66 + cs] = mx; }
    }
    LDS_BAR();
    { const int row = tid >> 2, part = tid & 3; const float w = sf[256 + row];
#pragma unroll
      for (int q = 0; q < 2; ++q) { const u32x4 u = kreg[q]; u32x4 o;
        o.x = pack2(lo2f(u.x) * w, hi2f(u.x) * w); o.y = pack2(lo2f(u.y) * w, hi2f(u.y) * w); o.z = pack2(lo2f(u.z) * w, hi2f(u.z) * w); o.w = pack2(lo2f(u.w) * w, hi2f(u.w) * w);
        *(LAS u32x4*)(sK + row * 144 + part * 32 + q * 16) = o; }
#pragma unroll
      for (int q = 0; q < 4; ++q) *(LAS u32x4*)(sV + row * 272 + part * 64 + q * 16) = vreg[q];
    }
    if (item + (int)gridDim.x < NIT) MA_LOAD(item + gridDim.x);
    LDS_BAR();
    f32x4 acc[4];
#pragma unroll
    for (int n = 0; n < 4; ++n) acc[n] = (f32x4){0.f, 0.f, 0.f, 0.f};
#pragma unroll
    for (int k0 = 0; k0 < 128; k0 += 32) {
      const bf16x8 a = frag_tr(sV, 272, wid * 16, k0, lane);
#pragma unroll
      for (int n = 0; n < 4; ++n) { const bf16x8 bb = frag_tr(sK, 144, n * 16, k0, lane); acc[n] = MFMA16(a, bb, acc[n]); }
    }
    u16* dst = mc + (size_t)(sq * 66 + cs) * 8192;
#pragma unroll
    for (int n = 0; n < 4; ++n)
#pragma unroll
      for (int r = 0; r < 4; ++r) dst[(wid * 16 + 4 * (lane >> 4) + r) * 64 + n * 16 + (lane & 15)] = f2bf(acc[n][r]);
    { float s = 0.f;
#pragma unroll
      for (int p = 0; p < 16; ++p) s += bf2f(*(LAS u16*)(sK + (wid * 16 + p) * 144 + lane * 2));
      sf[384 + wid * 64 + lane] = s; }
    LDS_BAR();
    if (tid < 64) { float s = 0.f;
#pragma unroll
      for (int w8 = 0; w8 < 8; ++w8) s += sf[384 + w8 * 64 + tid];
      c.mst_n[(size_t)(sq * 66 + cs) * 64 + tid] = s; }
    LDS_BAR();
  }
#undef MA_LOAD
}

__device__ void phase_mb(const Ctx& c) {
  int tid = threadIdx.x; asm volatile("" : "+v"(tid));
  u16* mc = c.big + MPRE_ELEMS;
  for (int item = blockIdx.x; item < 64 * 8; item += gridDim.x) {
    const int sq = item >> 3, slab = item & 7;
    unsigned* p = (unsigned*)(mc + (size_t)sq * 66 * 8192 + slab * 1024 + tid * 2);
    const bool nth = (slab == 0 && tid < 64);
    float* np = c.mst_n + (size_t)sq * 66 * 64 + tid;
    float m = -1e30f, c0 = 0.f, c1 = 0.f, cn = 0.f;
#pragma unroll 1
    for (int cb = 0; cb < 66; cb += 11) {
      unsigned loc[11]; float nl[11], bl[11], ml[11];
#pragma unroll
      for (int q = 0; q < 11; ++q) { const int cs = cb + q; loc[q] = 0u; nl[q] = 0.f; bl[q] = 0.f; ml[q] = 0.f;
        if (cs < 65) { loc[q] = p[(size_t)cs * 4096]; bl[q] = c.mst_s[4224 + sq * 66 + cs]; ml[q] = c.mst_s[sq * 66 + cs]; if (nth) nl[q] = np[cs * 64]; } }
#pragma unroll
      for (int q = 0; q < 11; ++q) { const int cs = cb + q;
        p[(size_t)cs * 4096] = pack2(c0, c1);
        if (nth) np[cs * 64] = cn;
        if (slab == 0 && tid == 0) c.mst_s[8448 + sq * 66 + cs] = m;
        if (cs < 65) {
          const float mn = fmaxf(bl[q] + m, ml[q]); const float wp = __expf(bl[q] + m - mn), wl = __expf(ml[q] - mn);
          c0 = wp * c0 + wl * lo2f(loc[q]); c1 = wp * c1 + wl * hi2f(loc[q]); cn = wp * cn + wl * nl[q]; m = mn;
        } }
    }
  }
}

__device__ void phase_mc(ldsp lds, const Ctx& c) {
  int tid = threadIdx.x; asm volatile("" : "+v"(tid)); const int wid = tid >> 6, lane = tid & 63;
  ldsp sQ = lds, sK = lds + 18432, sV = lds + 36864, sP = lds + 71680, sC0 = lds + 106496, sC1 = lds + 124928;
  LAS float* sf = (LAS float*)(lds + 143360);
  const u16* pre = c.big; const u16* mc = c.big + MPRE_ELEMS;
  for (int item = blockIdx.x; item < 4 * 8 * 66; item += gridDim.x) {
    const int j = item % 66; const int bh = item / 66; const int h = bh & 7, b = bh >> 3;
    const int row0 = j < 2 ? NL + b * 256 + j * 128 : b * 8192 + (j - 2) * 128;
    const int csf = j, csb = j < 2 ? 1 - j : 67 - j;
    const int sqf = b * 8 + h, sqb = 32 + b * 8 + h;
    const int d2 = tid >> 7, po = tid & 127;
    if (wid < 2) {
      const int dd = wid;
      const float* gp = c.gates + (size_t)(row0 + 2 * lane) * 32 + dd * 16 + h;
      const float ig0 = gp[0], lf0 = logsig(gp[8]), ig1 = gp[32], lf1 = logsig(gp[40]);
      const float s2 = lf0 + lf1; float inc = s2;
#pragma unroll
      for (int d = 1; d < 64; d <<= 1) inc += shup(inc, d, lane, 0.f);
      const float total = lane63(inc); const float ex = inc - s2;
      const float bb0 = dd ? total - ex : ex + lf0;
      const float bb1 = dd ? total - ex - lf0 : ex + s2;
      const float e0 = ig0 - bb0, e1 = ig1 - bb1, e01 = fmaxf(e0, e1);
      const float mpre = c.mst_s[8448 + (dd ? sqb * 66 + csb : sqf * 66 + csf)];
      float pm0, pm1;
      if (!dd) { float P = e01;
#pragma unroll
        for (int d = 1; d < 64; d <<= 1) P = fmaxf(P, shup(P, d, lane, -3.0e38f));
        const float xp = shup(P, 1, lane, -3.0e38f); pm0 = fmaxf(xp, e0); pm1 = fmaxf(xp, e01); }
      else { float S = e01;
#pragma unroll
        for (int d = 1; d < 64; d <<= 1) S = fmaxf(S, shdn(S, d, lane, -3.0e38f));
        const float xs = shdn(S, 1, lane, -3.0e38f); pm1 = fmaxf(xs, e1); pm0 = fmaxf(xs, e01); }
      const float M0 = fmaxf(mpre, pm0), M1 = fmaxf(mpre, pm1);
      const int o = dd * 128 + 2 * lane;
      sf[768 + o] = bb0; sf[769 + o] = bb1; sf[256 + o] = e0; sf[257 + o] = e1; sf[512 + o] = M0; sf[513 + o] = M1;
      sf[1024 + o] = __expf(mpre - M0); sf[1025 + o] = __expf(mpre - M1);
    }
    if (tid >= 256 && tid < 384) { const int q = tid - 256; const int d3 = q >> 6, dd = q & 63; sf[1536 + q] = c.mst_n[(size_t)(d3 ? sqb * 66 + csb : sqf * 66 + csf) * 64 + dd]; }
    { const int row = tid >> 2, part = tid & 3;
      const u16* qp = c.hb + (size_t)(row0 + row) * 1024 + h * 64 + part * 16;
#pragma unroll
      for (int q = 0; q < 2; ++q) { *(LAS u32x4*)(sQ + row * 144 + part * 32 + q * 16) = *(const u32x4*)(qp + q * 8); *(LAS u32x4*)(sK + row * 144 + part * 32 + q * 16) = *(const u32x4*)(qp + 512 + q * 8); }
      const u16* vp = pre + (size_t)(row0 + row) * 3072 + 1024 + h * 128 + part * 32;
#pragma unroll
      for (int q = 0; q < 4; ++q) *(LAS u32x4*)(sV + row * 272 + part * 64 + q * 16) = *(const u32x4*)(vp + q * 8);
      const u16* cf = mc + (size_t)(sqf * 66 + csf) * 8192 + row * 64 + part * 16; const u16* cb = mc + (size_t)(sqb * 66 + csb) * 8192 + row * 64 + part * 16;
#pragma unroll
      for (int q = 0; q < 2; ++q) { *(LAS u32x4*)(sC0 + row * 144 + part * 32 + q * 16) = *(const u32x4*)(cf + q * 8); *(LAS u32x4*)(sC1 + row * 144 + part * 32 + q * 16) = *(const u32x4*)(cb + q * 8); }
    }
    __syncthreads();
    { const int row = tid >> 2, part = tid & 3; float qf = 0.f, qb = 0.f;
#pragma unroll
      for (int q = 0; q < 2; ++q) { const u32x4 u = *(const LAS u32x4*)(sQ + row * 144 + part * 32 + q * 16); const int d0 = part * 16 + q * 8;
        const float v0 = lo2f(u.x), v1 = hi2f(u.x), v2 = lo2f(u.y), v3 = hi2f(u.y), v4 = lo2f(u.z), v5 = hi2f(u.z), v6 = lo2f(u.w), v7 = hi2f(u.w);
        qf += v0 * sf[1536 + d0] + v1 * sf[1537 + d0] + v2 * sf[1538 + d0] + v3 * sf[1539 + d0] + v4 * sf[1540 + d0] + v5 * sf[1541 + d0] + v6 * sf[1542 + d0] + v7 * sf[1543 + d0];
        qb += v0 * sf[1600 + d0] + v1 * sf[1601 + d0] + v2 * sf[1602 + d0] + v3 * sf[1603 + d0] + v4 * sf[1604 + d0] + v5 * sf[1605 + d0] + v6 * sf[1606 + d0] + v7 * sf[1607 + d0]; }
      qf += shx(qf, 1, lane); qf += shx(qf, 2, lane); qb += shx(qb, 1, lane); qb += shx(qb, 2, lane);
      if (part == 0) { sf[1280 + row] = qf; sf[1408 + row] = qb; } }
    f32x4 accS[8];
#pragma unroll
    for (int n = 0; n < 8; ++n) accS[n] = (f32x4){0.f, 0.f, 0.f, 0.f};
#pragma unroll
    for (int k0 = 0; k0 < 64; k0 += 32) {
      const bf16x8 a = frag_row(sQ, 144, wid * 16, k0, lane);
#pragma unroll
      for (int n = 0; n < 8; ++n) { const bf16x8 bb = frag_row(sK, 144, n * 16, k0, lane); accS[n] = MFMA16(a, bb, accS[n]); }
    }
    __syncthreads();
    f32x4 hs[8];
#pragma unroll
    for (int n = 0; n < 8; ++n) hs[n] = (f32x4){0.f, 0.f, 0.f, 0.f};
    const int tb = wid * 16 + 4 * (lane >> 4), sl = lane & 15;
#pragma unroll 1
    for (int dir = 0; dir < 2; ++dir) {
      float rs[4] = {0.f, 0.f, 0.f, 0.f}; float Mt[4];
#pragma unroll
      for (int r = 0; r < 4; ++r) Mt[r] = sf[512 + dir * 128 + tb + r];
#pragma unroll
      for (int n = 0; n < 8; ++n) { const int s = n * 16 + sl; const float es = sf[256 + dir * 128 + s];
#pragma unroll
        for (int r = 0; r < 4; ++r) { const int t = tb + r; const bool in = dir ? (s >= t) : (s <= t);
          const float pv = in ? accS[n][r] * __expf(es - Mt[r]) : 0.f; rs[r] += pv; *(LAS u16*)(sP + t * 272 + s * 2) = f2bf(pv); } }
#pragma unroll
      for (int r = 0; r < 4; ++r) rs[r] = red16l(rs[r], lane);
      float wi4[4], inv4[4];
#pragma unroll
      for (int r = 0; r < 4; ++r) { const int t = tb + r; const float wi = sf[1024 + dir * 128 + t];
        const float den = wi * sf[1280 + dir * 128 + t] + rs[r]; const float mt = sf[768 + dir * 128 + t] + Mt[r];
        wi4[r] = wi; inv4[r] = 1.f / fmaxf(fabsf(den), __expf(-mt)); }
      ldsp sC = dir ? sC1 : sC0;
#pragma unroll
      for (int eh = 0; eh < 2; ++eh) {
        f32x4 a1[4], a2[4];
#pragma unroll
        for (int n = 0; n < 4; ++n) { a1[n] = (f32x4){0.f, 0.f, 0.f, 0.f}; a2[n] = (f32x4){0.f, 0.f, 0.f, 0.f}; }
#pragma unroll
        for (int k0 = 0; k0 < 128; k0 += 32) { const bf16x8 a = frag_row(sP, 272, wid * 16, k0, lane);
#pragma unroll

#define FR_(n) frag_tr(sV, 272, (eh * 4 + (n)) * 16, k0, lane)
          SWEEP(4, 4, FR_, a, a1);
#undef FR_
        }
#pragma unroll
        for (int k0 = 0; k0 < 64; k0 += 32) { const bf16x8 a = frag_row(sQ, 144, wid * 16, k0, lane);
#pragma unroll

#define FR_(n) frag_row(sC, 144, (eh * 4 + (n)) * 16, k0, lane)
          SWEEP(4, 4, FR_, a, a2);
#undef FR_
        }
#pragma unroll
        for (int r = 0; r < 4; ++r)
#pragma unroll
          for (int n = 0; n < 4; ++n) hs[eh * 4 + n][r] += (a1[n][r] + wi4[r] * a2[n][r]) * inv4[r];
      }
    }
#pragma unroll
    for (int r = 0; r < 4; ++r) {
      float s = 0.f;
#pragma unroll
      for (int n = 0; n < 8; ++n) s += hs[n][r];
      const float mu = red16l(s, lane) * (1.f / 128.f); float v = 0.f;
#pragma unroll
      for (int n = 0; n < 8; ++n) { const float d = hs[n][r] - mu; v += d * d; }
      const float rstd = rsqrtf(red16l(v, lane) * (1.f / 128.f) + 1e-6f);
      const size_t row = row0 + tb + r;
#pragma unroll
      for (int n = 0; n < 8; ++n) { const int e = h * 128 + n * 16 + sl;
        const float og = bf2f(pre[row * 3072 + 2048 + e]);
        c.y[row * 1024 + e] = f2bf((hs[n][r] - mu) * rstd * c.m_norm_g[e] * sigmf(og)); }
    }
    __syncthreads();
  }
}

#define RUQ_ELEMS ((size_t)NT * 2048)
__device__ __forceinline__ float ret_lg(const Ctx& c, int dir, int h) { return logsig(c.r_decay[dir * 4 + h]); }

__device__ void phase_ra(ldsp lds, const Phase& ph, const Ctx& c) {
  int tid = threadIdx.x; asm volatile("" : "+v"(tid)); const int wid = tid >> 6, lane = tid & 63;
  ldsp sV = lds; ldsp sK = lds + 64 * 272;
  const u16* uq = c.big; u16* rst = c.big + RUQ_ELEMS; const int hp = ph.i0;
  for (int item = blockIdx.x; item < 1024; item += gridDim.x) {
    const int eq = item & 3, J = (item >> 2) & 15, hl = (item >> 6) & 1, b = (item >> 7) & 3, dir = item >> 9;
    const int sq = (dir * 4 + b) * 2 + hl; const float lg = ret_lg(c, dir, hp * 2 + hl);
    int row0, L; if (J == 0) { row0 = NL + b * 256; L = 256; } else { L = 512; row0 = b * 8192 + (dir ? 16 - J : J - 1) * 512; }
    f32x4 acc[16];
#pragma unroll
    for (int n = 0; n < 16; ++n) acc[n] = (f32x4){0.f, 0.f, 0.f, 0.f};
    const u16* vp = uq + (size_t)(row0 + (tid >> 4)) * 2048 + 1024 + hl * 512 + eq * 128 + (tid & 15) * 8;
    const u16* kp = uq + (size_t)(row0 + (tid >> 5)) * 2048 + 512 + hl * 256 + (tid & 31) * 8;
    u32x4 pv[2], pk[4];
#pragma unroll
    for (int q = 0; q < 2; ++q) pv[q] = *(const u32x4*)(vp + (size_t)q * 32 * 2048);
#pragma unroll
    for (int q = 0; q < 4; ++q) pk[q] = *(const u32x4*)(kp + (size_t)q * 16 * 2048);
    LDS_BAR();
#pragma unroll 1
    for (int s0 = 0; s0 < L; s0 += 64) {
      {
#pragma unroll
        for (int q = 0; q < 2; ++q) *(LAS u32x4*)(sV + (q * 32 + (tid >> 4)) * 272 + (tid & 15) * 16) = pv[q];
#pragma unroll
        for (int q = 0; q < 4; ++q) { const int krow = q * 16 + (tid >> 5); const int o = s0 + krow; const float z = __expf(lg * (float)(dir ? o : L - 1 - o)); const u32x4 u = pk[q]; u32x4 w;
          w.x = pack2(lo2f(u.x) * z, hi2f(u.x) * z); w.y = pack2(lo2f(u.y) * z, hi2f(u.y) * z); w.z = pack2(lo2f(u.z) * z, hi2f(u.z) * z); w.w = pack2(lo2f(u.w) * z, hi2f(u.w) * z);
          *(LAS u32x4*)(sK + krow * 528 + (tid & 31) * 16) = w; }
      }
      if (s0 + 64 < L) {
        const size_t adv = (size_t)(s0 + 64) * 2048;
#pragma unroll
        for (int q = 0; q < 2; ++q) pv[q] = *(const u32x4*)(vp + adv + (size_t)q * 32 * 2048);
#pragma unroll
        for (int q = 0; q < 4; ++q) pk[q] = *(const u32x4*)(kp + adv + (size_t)q * 16 * 2048);
      }
      LDS_BAR();
#pragma unroll
      for (int k0 = 0; k0 < 64; k0 += 32) { const bf16x8 a0 = frag_tr(sV, 272, (wid >> 1) * 32, k0, lane), a1 = frag_tr(sV, 272, (wid >> 1) * 32 + 16, k0, lane);
        bf16x8 bq[4];
#pragma unroll
        for (int n = 0; n < 4; ++n) bq[n] = frag_tr(sK, 528, (wid & 1) * 128 + n * 16, k0, lane);
        __builtin_amdgcn_sched_barrier(0);
#pragma unroll
        for (int n = 0; n < 8; ++n) { const bf16x8 cur = bq[n & 3]; if (n + 4 < 8) bq[n & 3] = frag_tr(sK, 528, (wid & 1) * 128 + (n + 4) * 16, k0, lane);
          acc[n] = MFMA16(a0, cur, acc[n]); acc[8 + n] = MFMA16(a1, cur, acc[8 + n]); __builtin_amdgcn_sched_barrier(0); }
      }
      LDS_BAR();
    }
    u16* dst = rst + (size_t)(sq * 16 + J) * 131072 + (size_t)(eq * 128 + (wid >> 1) * 32 + 4 * (lane >> 4)) * 256 + (wid & 1) * 128 + (lane & 15);
#pragma unroll
    for (int mi = 0; mi < 2; ++mi)
#pragma unroll
      for (int n = 0; n < 8; ++n)
#pragma unroll
        for (int r = 0; r < 4; ++r) dst[(mi * 16 + r) * 256 + n * 16] = f2bf(acc[mi * 8 + n][r]);
  }
}

__device__ void phase_rb(const Phase& ph, const Ctx& c) {
  int tid = threadIdx.x; asm volatile("" : "+v"(tid)); u16* rst = c.big + RUQ_ELEMS; const int hp = ph.i0;
  for (int item = blockIdx.x; item < 16 * 32; item += gridDim.x) {
    const int sq = item >> 5, slab = item & 31; const int hl = sq & 1, dir = sq >> 3;
    const float g512 = __expf(512.f * ret_lg(c, dir, hp * 2 + hl));
    u32x4* p = (u32x4*)(rst + (size_t)sq * 16 * 131072 + slab * 4096 + tid * 8);
    float cr[8];
#pragma unroll
    for (int q = 0; q < 8; ++q) cr[q] = 0.f;
    u32x4 uu[16];
#pragma unroll
    for (int J = 0; J < 16; ++J) uu[J] = p[(size_t)J * 16384];
#pragma unroll
    for (int J = 0; J < 16; ++J) {
      const u32x4 u = uu[J];
      cr[0] = g512 * cr[0] + lo2f(u.x); cr[1] = g512 * cr[1] + hi2f(u.x); cr[2] = g512 * cr[2] + lo2f(u.y); cr[3] = g512 * cr[3] + hi2f(u.y);
      cr[4] = g512 * cr[4] + lo2f(u.z); cr[5] = g512 * cr[5] + hi2f(u.z); cr[6] = g512 * cr[6] + lo2f(u.w); cr[7] = g512 * cr[7] + hi2f(u.w);
      u32x4 o; o.x = pack2(cr[0], cr[1]); o.y = pack2(cr[2], cr[3]); o.z = pack2(cr[4], cr[5]); o.w = pack2(cr[6], cr[7]);
      p[(size_t)J * 16384] = o;
    }
  }
}

__device__ __forceinline__ bf16x8 scale_frag(bf16x8 a, float s) {
  bf16x8 r;
#pragma unroll
  for (int q = 0; q < 8; ++q) r[q] = (short)f2bf(bf2f((u16)a[q]) * s);
  return r;
}

__device__ void phase_rc(ldsp lds, const Phase& ph, const Ctx& c) {
  int tid = threadIdx.x; asm volatile("" : "+v"(tid)); const int wid = tid >> 6, lane = tid & 63;
  ldsp sQ = lds, sKP = lds + 67584, sV = lds + 102400;
  const u16* uq = c.big; const u16* rst = c.big + RUQ_ELEMS; const int hp = ph.i0;
  for (int item = blockIdx.x; item < 512; item += gridDim.x) {
    const int i = item & 3, Jo = (item >> 2) & 15, hl = (item >> 6) & 1, b = item >> 7;
    const int h = hp * 2 + hl; const float lgf = ret_lg(c, 0, h), lgb = ret_lg(c, 1, h);
    const int rowb = b * 8192 + Jo * 512;
    const unsigned kofs = (unsigned)((rowb + (tid >> 4)) * 2048 + 512 + hl * 256 + (tid & 15) * 8);
    const unsigned vofs = (unsigned)((rowb + (tid >> 6)) * 2048 + 1024 + hl * 512 + (tid & 63) * 8);
    const unsigned rofs = (unsigned)((tid >> 2) * 256 + (tid & 3) * 8);
    const u16* rs0 = rst + (size_t)(((0 * 4 + b) * 2 + hl) * 16 + Jo) * 131072;
    const u16* rs1 = rst + (size_t)(((1 * 4 + b) * 2 + hl) * 16 + (15 - Jo)) * 131072;
#define kbase (uq + kofs)
#define vbase (uq + vofs)
#define rbase0 (rs0 + rofs)
#define rbase1 (rs1 + rofs)
    const unsigned dK = (unsigned)((tid >> 4) * 272 + (tid & 15) * 16), dV = (unsigned)((tid >> 6) * 1040 + (tid & 63) * 16), dR = (unsigned)((tid >> 2) * 80 + (tid & 3) * 16);
    constexpr int KQ = 32 * 2048, VQ = 8 * 2048, RQ = 128 * 256, KD = 32 * 272, VD = 8 * 1040, RD = 128 * 80;
    u32x4 pf[4];
#pragma unroll
    for (int q = 0; q < 4; ++q) pf[q] = *(const u32x4*)(kbase + q * KQ);
    { const int row = tid >> 5, ch = tid & 31; const u16* qp = uq + (size_t)(rowb + i * 128 + row) * 2048 + hl * 256 + ch * 8;
#pragma unroll
      for (int q = 0; q < 8; ++q) *(LAS u32x4*)(sQ + (q * 16 + row) * 528 + ch * 16) = *(const u32x4*)(qp + (size_t)q * 16 * 2048); }
    f32x4 acc[32];
#pragma unroll
    for (int n = 0; n < 32; ++n) acc[n] = (f32x4){0.f, 0.f, 0.f, 0.f};
    const int tb = wid * 16 + 4 * (lane >> 4), sl = lane & 15;
#pragma unroll 1
    for (int j = 0; j < 4; ++j) {
      f32x4 accS[8];
#pragma unroll
      for (int n = 0; n < 8; ++n) accS[n] = (f32x4){0.f, 0.f, 0.f, 0.f};
#pragma unroll 1
      for (int dh = 0; dh < 2; ++dh) {
        LDS_BAR();
#pragma unroll
        for (int q = 0; q < 4; ++q) *(LAS u32x4*)(sKP + dK + q * KD) = pf[q];
        { const u16* src = dh == 0 ? kbase + (size_t)j * 128 * 2048 + 128 : vbase + (size_t)(j * 128) * 2048; const int qs = dh == 0 ? KQ : VQ;
#pragma unroll
          for (int q = 0; q < 4; ++q) pf[q] = *(const u32x4*)(src + q * qs); }
        LDS_BAR();
#pragma unroll
        for (int k0 = 0; k0 < 128; k0 += 32) { const bf16x8 a = frag_row(sQ, 528, wid * 16, dh * 128 + k0, lane);
#pragma unroll
          for (int n = 0; n < 8; ++n) { const bf16x8 bb = frag_row(sKP, 272, n * 16, k0, lane); accS[n] = MFMA16(a, bb, accS[n]); } }
      }
      LDS_BAR();
#pragma unroll
      for (int n = 0; n < 8; ++n) { const int os = j * 128 + n * 16 + sl;
#pragma unroll
        for (int r = 0; r < 4; ++r) { const int t = tb + r; const int df = i * 128 + t - os;
          float w = 0.f; if (df >= 0) w += __expf(lgf * (float)df); if (df <= 0) w += __expf(-lgb * (float)df);
          *(LAS u16*)(sKP + t * 272 + (n * 16 + sl) * 2) = f2bf(accS[n][r] * w); } }
#pragma unroll 1
      for (int s4 = 0; s4 < 4; ++s4) {
        LDS_BAR();
#pragma unroll
        for (int q = 0; q < 4; ++q) *(LAS u32x4*)(sV + dV + q * VD) = pf[q];
        { const u16* src = s4 < 3 ? vbase + (size_t)(j * 128 + (s4 + 1) * 32) * 2048 : (j < 3 ? kbase + (size_t)(j + 1) * 128 * 2048 : rbase0); const int qs = s4 < 3 ? VQ : (j < 3 ? KQ : RQ);
#pragma unroll
          for (int q = 0; q < 4; ++q) pf[q] = *(const u32x4*)(src + q * qs); }
        LDS_BAR();
        const bf16x8 a = frag_row(sKP, 272, wid * 16, s4 * 32, lane);
#pragma unroll

#define FR_(n) frag_tr(sV, 1040, (n) * 16, 0, lane)
        SWEEP(32, 6, FR_, a, acc);
#undef FR_
      }
    }
#pragma unroll 1
    for (int dir = 0; dir < 2; ++dir) {
      const int off = i * 128 + wid * 16 + sl;
      const float xi = dir ? __expf(lgb * (float)(512 - off)) : __expf(lgf * (float)(off + 1));
#pragma unroll 1
      for (int ds = 0; ds < 8; ++ds) {
        LDS_BAR();
#pragma unroll
        for (int q = 0; q < 4; ++q) *(LAS u32x4*)(sV + dR + q * RD) = pf[q];
        if (ds < 7 || dir == 0) { const u16* src = ds < 7 ? (dir ? rbase1 : rbase0) + (ds + 1) * 32 : rbase1;
#pragma unroll
          for (int q = 0; q < 4; ++q) pf[q] = *(const u32x4*)(src + q * RQ); }
        LDS_BAR();
        const bf16x8 a = scale_frag(frag_row(sQ, 528, wid * 16, ds * 32, lane), xi);
#pragma unroll

#define FR_(n) frag_row(sV, 80, (n) * 16, 0, lane)
        SWEEP(32, 6, FR_, a, acc);
#undef FR_
      }
    }
#undef kbase
#undef vbase
#undef rbase0
#undef rbase1
#pragma unroll
    for (int r = 0; r < 4; ++r) {
      float s = 0.f;
#pragma unroll
      for (int n = 0; n < 32; ++n) s += acc[n][r];
      const float mu = red16l(s, lane) * (1.f / 512.f); float v = 0.f;
#pragma unroll
      for (int n = 0; n < 32; ++n) { const float d = acc[n][r] - mu; v += d * d; }
      const float rstd = rsqrtf(red16l(v, lane) * (1.f / 512.f) + 1e-6f);
      const size_t row = rowb + i * 128 + tb + r;
#pragma unroll
      for (int n = 0; n < 32; ++n) { const int e = h * 512 + n * 16 + sl; c.y[row * 2048 + e] = f2bf((acc[n][r] - mu) * rstd * c.r_norm_g[e]); }
    }
    LDS_BAR();
  }
}

#define XB_TMO      128
#define XB_XCNT(j)  (256  + 64 * (j))
#define XB_XSUB(j)  (1280 + 64 * (j))
#define XB_XGEN(j)  (2304 + 64 * (j))
#define XB_TOP      3328
#define XB_TOPGEN   3392
#define XCD_BAR_WORDS 3456
#define XB_SPIN_CAP (1u << 18)
__device__ __forceinline__ unsigned xb_ld(unsigned* p)              { return __hip_atomic_load(p, __ATOMIC_RELAXED, __HIP_MEMORY_SCOPE_AGENT); }
__device__ __forceinline__ unsigned xb_add(unsigned* p, unsigned v) { return __hip_atomic_fetch_add(p, v, __ATOMIC_RELAXED, __HIP_MEMORY_SCOPE_AGENT); }
__device__ __forceinline__ unsigned xb_xcc_id() { return (unsigned)__builtin_amdgcn_s_getreg((3 << 11) | 20) & 0xFu; }
#define XB_SPIN(cond, bar) do { unsigned _sp = 0; while (cond) { __builtin_amdgcn_s_sleep(1); \
    if ((++_sp & 255u) == 0u) { if (xb_ld(&(bar)[XB_TMO])) break; if (_sp > XB_SPIN_CAP) { atomicAdd(&(bar)[XB_TMO], 1u); break; } } } } while (0)
struct XcdBarrier { unsigned* bar; unsigned x; volatile LAS unsigned* st; };
__device__ __forceinline__ XcdBarrier xcd_barrier_post(unsigned* bar, volatile LAS unsigned* st) {
    XcdBarrier b; b.bar = bar; b.x = xb_xcc_id(); b.st = st;
    if (threadIdx.x == 0) (void)xb_add(&bar[XB_XCNT(b.x)], 1u);
    return b;
}
__device__ __forceinline__ void xcd_barrier_complete(unsigned* bar, unsigned x, unsigned& nloc, unsigned& nx) {
    const unsigned G = gridDim.x * gridDim.y * gridDim.z;
    unsigned sum, cnt, mine, sp = 0u;
    for (;;) {
        sum = 0u; cnt = 0u; mine = 0u;
#pragma unroll
        for (unsigned j = 0; j < 16; ++j) { const unsigned c = xb_ld(&bar[XB_XCNT(j)]); sum += c; cnt += (c > 0u) ? 1u : 0u; mine = (j == x) ? c : mine; }
        if (sum == G) break;
        __builtin_amdgcn_s_sleep(1);
        if ((++sp & 255u) == 0u) { if (xb_ld(&bar[XB_TMO])) break; if (sp > XB_SPIN_CAP) { atomicAdd(&bar[XB_TMO], 1u); break; } }
    }
    nloc = mine > 0u ? mine : 1u; nx = cnt > 0u ? cnt : 1u;
}
__device__ __forceinline__ void xcd_barrier(const XcdBarrier& b) {
    asm volatile("s_waitcnt vmcnt(0)" ::: "memory");
    __syncthreads();
    if (threadIdx.x == 0) {
        unsigned* bar = b.bar;
        __builtin_amdgcn_s_waitcnt(0);
        unsigned nloc = b.st[0], nx = b.st[1];
        if (nloc == 0u) { xcd_barrier_complete(bar, b.x, nloc, nx); b.st[0] = nloc; b.st[1] = nx; }
        const unsigned old = xb_add(&bar[XB_XSUB(b.x)], 1u);
        const unsigned gen = old / nloc;
        if (old + 1u == (gen + 1u) * nloc) {
            __builtin_amdgcn_fence(__ATOMIC_RELEASE, "agent");
            asm volatile("s_waitcnt vmcnt(0)" ::: "memory");
            const unsigned og = xb_add(&bar[XB_TOP], 1u);
            const unsigned tg = og / nx;
            if (og + 1u == (tg + 1u) * nx) xb_add(&bar[XB_TOPGEN], 1u);
            else XB_SPIN(xb_ld(&bar[XB_TOPGEN]) == tg, bar);
            __builtin_amdgcn_fence(__ATOMIC_ACQUIRE, "agent");
            xb_add(&bar[XB_XGEN(b.x)], 1u);
            asm volatile("s_waitcnt vmcnt(0)" ::: "memory");
        } else {
            XB_SPIN(xb_ld(&bar[XB_XGEN(b.x)]) == gen, bar);
            __builtin_amdgcn_fence(__ATOMIC_ACQUIRE, "agent");
            asm volatile("s_waitcnt vmcnt(0)" ::: "memory");
        }
    }
    __syncthreads();
}

__global__ void __launch_bounds__(512) fwd_megakernel(Params p) {
  extern __shared__ __attribute__((aligned(16))) unsigned char shm[];
  ldsp lds = (ldsp)shm;
  cg::grid_group grid = cg::this_grid();
  volatile LAS unsigned* xst = (volatile LAS unsigned*)(lds + LDS_BYTES - 16);
  if (threadIdx.x == 0) { xst[0] = 0u; xst[1] = 0u; }
  __syncthreads();
  const XcdBarrier xb = xcd_barrier_post(p.c.bar, xst);
#pragma unroll 1
  for (int pi = 0; pi < p.nph; ++pi) {
    const Phase& ph = p.ph[pi];
    switch (ph.type) {
      case PH_INIT:
#ifndef NO_INIT
      phase_init(lds, p.c);
#endif
      break;
      case PH_NORM:
#ifndef NO_NORM
      phase_norm(lds, ph, p.c);
#endif
      break;
      case PH_GEMM:
#ifndef NO_GEMM
      gemm_phase(lds, ph, p.c);
#endif
      break;
      case PH_MCONV:
#ifndef NO_MCONV
      phase_mconv(p.c);
#endif
      break;
      case PH_MA:
#ifndef NO_MA
      phase_ma(lds, p.c);
#endif
      break;
      case PH_MB:
#ifndef NO_MB
      phase_mb(p.c);
#endif
      break;
      case PH_MC:
#ifndef NO_MC
      phase_mc(lds, p.c);
#endif
      break;
      case PH_RA:
#ifndef NO_RA
      phase_ra(lds, ph, p.c);
#endif
      break;
      case PH_RB:
#ifndef NO_RB
      phase_rb(ph, p.c);
#endif
      break;
      case PH_RC:
#ifndef NO_RC
      phase_rc(lds, ph, p.c);
#endif
      break;
      case PH_FINAL: phase_final(p.c); break;
      default: break;
    }
    if (pi == 0) grid.sync(); else xcd_barrier(xb);
  }
}

static void add_phase(Params& P, int type, int M, int N, int K, int i0, int i1, float f0, int pad, const void* A, const void* B, void* O, const void* X) {
  const int reps = (((DUP_TYPES >> type) & 1u) && (type != PH_GEMM || ((DUP_EPIS >> i0) & 1u))) ? 2 : 1;
  for (int rep = 0; rep < reps; ++rep) {
  Phase& ph = P.ph[P.nph++]; ph.type = type; ph.M = M; ph.N = N; ph.K = K; ph.i0 = i0; ph.i1 = i1; ph.f0 = f0; ph.pad = pad; ph.A = A; ph.B = B; ph.O = O; ph.X = X;
  }
}

extern "C" void kernel_launch(void* const* d_in, const int* in_sizes, int n_in, void* d_out, int out_size, void* d_ws, size_t ws_size, hipStream_t stream) {
  static int grid_blocks = 0;
  if (!grid_blocks) {
    int dev = 0, cus = 0, per_cu = 0;
    hipGetDevice(&dev);
    hipDeviceGetAttribute(&cus, hipDeviceAttributeMultiprocessorCount, dev);
    hipFuncSetAttribute((const void*)fwd_megakernel, hipFuncAttributeMaxDynamicSharedMemorySize, LDS_BYTES);
    hipOccupancyMaxActiveBlocksPerMultiprocessor(&per_cu, (const void*)fwd_megakernel, 512, LDS_BYTES);
    if (per_cu < 1) per_cu = 1;
    grid_blocks = cus * per_cu;
  }
  Params P; memset(&P, 0, sizeof(P));
  Ctx& c = P.c;
  c.x = (const float*)d_in[0]; c.c = (const float*)d_in[1]; c.ctx = (const float*)d_in[2]; c.c_ctx = (const float*)d_in[3];
  c.mod_w = (const float*)d_in[4]; c.mod_b = (const float*)d_in[5]; c.norm_g = (const float*)d_in[6]; c.w13 = (const float*)d_in[7]; c.w2 = (const float*)d_in[8];
  c.m_w_in = (const float*)d_in[9]; c.m_gate_b = (const float*)d_in[10]; c.m_conv_w = (const float*)d_in[11]; c.m_norm_g = (const float*)d_in[12]; c.m_w_out = (const float*)d_in[13];
  c.r_w_in = (const float*)d_in[14]; c.r_decay = (const float*)d_in[15]; c.r_norm_g = (const float*)d_in[16]; c.r_w_out = (const float*)d_in[17]; c.final_g = (const float*)d_in[18];
  c.out = (float*)d_out; c.y = (u16*)d_out;
  char* w = (char*)d_ws; size_t off = 0;
  auto take = [&](size_t bytes) { char* r = w + off; off += (bytes + 255) & ~(size_t)255; return r; };
  c.bar = (unsigned*)take((size_t)XCD_BAR_WORDS * 4);
  c.modv = (float*)take((size_t)2 * 5 * 9216 * 4);
  c.rope = (float*)take((size_t)8192 * 128 * 8);
  c.gates = (float*)take((size_t)NT * 32 * 4);
  c.mst_n = (float*)take((size_t)64 * 66 * 64 * 4);
  c.mst_s = (float*)take((size_t)3 * 4224 * 4);
  c.xr = (float*)take((size_t)NT * 1024 * 4);
  c.hb = (u16*)take((size_t)NT * 1024 * 2);
  c.wb = (u16*)take((size_t)(5632 + 2816) * 1024 * 2);
  c.big = (u16*)take((size_t)NT * 3072 * 2 + (size_t)64 * 66 * 8192 * 2);
  c.part = (float*)((char*)c.big + (size_t)NT * 2816 * 2);
  c.part2 = (float*)take((size_t)4 * 1024 * 1024 * 4);
  if (off > ws_size) { fprintf(stderr, "workspace too small: need %zu have %zu\n", off, ws_size); return; }
  u16* hid = c.big;
  for (int l = 0; l < 2; ++l) {
    if (l == 0) add_phase(P, PH_INIT, 0, 0, 0, 0, 0, 0.f, 0, nullptr, nullptr, nullptr, nullptr);
    const float* modl = c.modv + (size_t)l * 5 * 9216;
    add_phase(P, PH_NORM, NT, l == 0 ? 1 : (NSPL << 8), 0, l, 0, 0.5f, 0, nullptr, nullptr, nullptr, c.modv + 8 * 1024);
    add_phase(P, PH_GEMM, NT, 5632, 1024, EPI_SWIGLU, 0, 0.f, 0, c.hb, c.wb, hid, nullptr);
    add_phase(P, PH_GEMM, NT, 1024, 2816, EPI_RESID, SPLITF | (l == 0 ? 2 : 0), 0.5f, 0, hid, c.wb + (size_t)5632 * 1024, c.xr, modl + 2 * 1024);
    if (l == 0) {
      add_phase(P, PH_NORM, NT, NSPL << 8, 0, l, 1, 0.5f, 1, nullptr, nullptr, nullptr, modl + 2 * 1024);
      add_phase(P, PH_GEMM, NT, 3328, 1024, EPI_MLSTM_U, 0, 0.f, 0, c.hb, c.wb, c.big, nullptr);
      add_phase(P, PH_MCONV, 0, 0, 0, 0, 0, 0.f, 0, nullptr, nullptr, nullptr, nullptr);
      add_phase(P, PH_MA, 0, 0, 0, 0, 0, 0.f, 0, nullptr, nullptr, nullptr, nullptr);
      add_phase(P, PH_MB, 0, 0, 0, 0, 0, 0.f, 0, nullptr, nullptr, nullptr, nullptr);
      add_phase(P, PH_MC, 0, 0, 0, 0, 0, 0.f, 0, nullptr, nullptr, nullptr, nullptr);
      add_phase(P, PH_GEMM, NT, 1024, 1024, EPI_RESID, 1 | 4, 1.0f, 0, c.y, c.wb + (size_t)3328 * 1024, c.xr, modl + 5 * 1024);
    } else {
      add_phase(P, PH_NORM, NT, NSPL << 8, 0, l, 1, 0.5f, 2, nullptr, nullptr, nullptr, modl + 2 * 1024);
      for (int hp = 0; hp < 2; ++hp) {
        add_phase(P, PH_GEMM, NT, 2048, 1024, EPI_RET_U, 0, 0.f, 0, c.hb, c.wb + (size_t)hp * 2048 * 1024, c.big, nullptr);
        add_phase(P, PH_RA, 0, 0, 0, hp, 0, 0.f, 0, nullptr, nullptr, nullptr, nullptr);
        add_phase(P, PH_RB, 0, 0, 0, hp, 0, 0.f, 0, nullptr, nullptr, nullptr, nullptr);
        add_phase(P, PH_RC, 0, 0, 0, hp, 0, 0.f, 0, nullptr, nullptr, nullptr, nullptr);
      }
      add_phase(P, PH_GEMM, NL, 2048, 1024, EPI_GATE, 0, 0.f, 0, c.hb, c.wb + (size_t)4096 * 1024, c.y, nullptr);
      add_phase(P, PH_GEMM, NL, 1024, 2048, EPI_RESID, 0, 1.0f, 0, c.y, c.wb + (size_t)6144 * 1024, c.xr, modl + 5 * 1024);
    }
    const int M2 = l == 1 ? NL : NT;
    add_phase(P, PH_NORM, M2, l == 0 ? ((4 << 8) | 2) : 0, 1, l, 2, 1.0f, 0, nullptr, nullptr, nullptr, modl + 5 * 1024);
    add_phase(P, PH_GEMM, M2, 5632, 1024, EPI_SWIGLU, 0, 0.f, 0, c.hb, c.wb, hid, nullptr);
    add_phase(P, PH_GEMM, M2, 1024, 2816, EPI_RESID, l == 0 ? SPLITF : 0, 0.5f, 0, hid, c.wb + (size_t)5632 * 1024, c.xr, modl + 8 * 1024);
  }
#ifdef EXTRA_NOPS
  for (int q = 0; q < EXTRA_NOPS; ++q) add_phase(P, PH_NOP, 0, 0, 0, 0, 0, 0.f, 0, nullptr, nullptr, nullptr, nullptr);
#endif
  add_phase(P, PH_FINAL, 0, 0, 0, 0, 0, 0.f, 0, nullptr, nullptr, nullptr, nullptr);
  hipMemsetAsync(c.bar, 0, (size_t)XCD_BAR_WORDS * 4, stream);
  void* args[] = {&P};
  hipError_t e = hipLaunchCooperativeKernel((const void*)fwd_megakernel, dim3(grid_blocks), dim3(512), args, LDS_BYTES, stream);
  if (e != hipSuccess) fprintf(stderr, "cooperative launch failed: %s (grid %d)\n", hipGetErrorString(e), grid_blocks);
}
```

```cpp
#include <hip/hip_runtime.h>
#include <hip/hip_cooperative_groups.h>
#include <cstdio>
#include <cstring>
namespace cg = cooperative_groups;

typedef unsigned short u16;
typedef short bf16x8 __attribute__((ext_vector_type(8)));
typedef short s16x4 __attribute__((ext_vector_type(4)));
typedef float f32x4 __attribute__((ext_vector_type(4)));
typedef unsigned u32x4 __attribute__((ext_vector_type(4)));
typedef unsigned u32x2 __attribute__((ext_vector_type(2)));
#define LAS __attribute__((address_space(3)))
typedef LAS unsigned char* ldsp;

#define NT 33792
#define NL 32768
#define LDS_BYTES 155648

enum { PH_INIT = 0, PH_NORM, PH_GEMM, PH_MCONV, PH_MA, PH_MB, PH_MC, PH_RA, PH_RB, PH_RC, PH_FINAL, PH_NOP };
enum { EPI_SWIGLU = 0, EPI_RESID, EPI_MLSTM_U, EPI_RET_U, EPI_GATE };

struct Phase { int type, M, N, K; int i0, i1; float f0; int pad; const void* A; const void* B; void* O; const void* X; };
#define MAXPH 56
#ifndef SPLITF
#define SPLITF 1
#endif
#define NSPL (SPLITF ? 11 : 0)
#ifndef DUP_TYPES
#define DUP_TYPES 0u
#endif
#ifndef DUP_EPIS
#define DUP_EPIS 0u
#endif
struct Ctx {
  const float *x, *c, *ctx, *c_ctx, *mod_w, *mod_b, *norm_g, *w13, *w2, *m_w_in, *m_gate_b, *m_conv_w, *m_norm_g, *m_w_out, *r_w_in, *r_decay, *r_norm_g, *r_w_out, *final_g;
  float* out; float* modv; float* rope; float* gates; float* mst_n; float* mst_s; float* xr;
  u16* hb; u16* wb; u16* big; u16* y; unsigned* bar; float* part; float* part2;
};
struct Params { Ctx c; int nph; int pad; Phase ph[MAXPH]; };

typedef __bf16 bf16x2_t __attribute__((ext_vector_type(2)));
__device__ __forceinline__ u16 f2bf(float f) { return __builtin_bit_cast(u16, (__bf16)f); }
__device__ __forceinline__ float bf2f(u16 b) { return __uint_as_float(((unsigned)b) << 16); }
__device__ __forceinline__ unsigned pack2(float a, float b) { bf16x2_t v; v[0] = (__bf16)a; v[1] = (__bf16)b; return __builtin_bit_cast(unsigned, v); }
__device__ __forceinline__ float lo2f(unsigned w) { return __uint_as_float(w << 16); }
__device__ __forceinline__ float hi2f(unsigned w) { return __uint_as_float(w & 0xffff0000u); }
__device__ __forceinline__ float4 ldnt4(const float4* p) { const f32x4 v = __builtin_nontemporal_load((const f32x4*)p); return make_float4(v[0], v[1], v[2], v[3]); }
__device__ __forceinline__ void stnt4(float4* p, float4 v) { f32x4 t; t[0] = v.x; t[1] = v.y; t[2] = v.z; t[3] = v.w; __builtin_nontemporal_store(t, (f32x4*)p); }
__device__ __forceinline__ float siluf(float a) { return a * __builtin_amdgcn_rcpf(1.f + __expf(-a)); }
__device__ __forceinline__ float sigmf(float a) { return __builtin_amdgcn_rcpf(1.f + __expf(-a)); }
__device__ __forceinline__ float logsig(float a) { return fminf(a, 0.f) - log1pf(expf(-fabsf(a))); }

__device__ __forceinline__ bf16x8 frag_row(ldsp base, int pitch, int idx0, int k0, int lane) {
  return *(const LAS bf16x8*)(base + (idx0 + (lane & 15)) * pitch + (k0 + 8 * (lane >> 4)) * 2);
}
__device__ __forceinline__ bf16x8 frag_tr(ldsp base, int pitch, int idx0, int k0, int lane) {
  const int g = lane >> 4, li = lane & 15, q = li >> 2, p = li & 3;
  ldsp a = base + (k0 + 8 * g + q) * pitch + (idx0 + 4 * p) * 2;
  s16x4 lo = __builtin_amdgcn_ds_read_tr16_b64_v4i16((LAS s16x4*)a);
  s16x4 hi = __builtin_amdgcn_ds_read_tr16_b64_v4i16((LAS s16x4*)(a + 4 * pitch));
  bf16x8 r; r[0] = lo[0]; r[1] = lo[1]; r[2] = lo[2]; r[3] = lo[3]; r[4] = hi[0]; r[5] = hi[1]; r[6] = hi[2]; r[7] = hi[3]; return r;
}
#define LDS_BAR() do { asm volatile("s_waitcnt lgkmcnt(0)" ::: "memory"); __builtin_amdgcn_s_barrier(); asm volatile("" ::: "memory"); } while (0)
#define SWEEP(NT, DEPTH, FRAG, A, ACC) do { bf16x8 bq_[DEPTH]; \
    _Pragma("unroll") for (int n_ = 0; n_ < DEPTH; ++n_) bq_[n_] = FRAG(n_); __builtin_amdgcn_sched_barrier(0); \
    _Pragma("unroll") for (int n_ = 0; n_ < NT; ++n_) { const bf16x8 cur_ = bq_[n_ % DEPTH]; if (n_ + DEPTH < NT) bq_[n_ % DEPTH] = FRAG(n_ + DEPTH); ACC[n_] = MFMA16(A, cur_, ACC[n_]); __builtin_amdgcn_sched_barrier(0); } } while (0)
#define MFMA16(a, b, c) __builtin_amdgcn_mfma_f32_16x16x32_bf16((a), (b), (c), 0, 0, 0)
__device__ __forceinline__ float shx(float v, int m, int lane) { return __int_as_float(__builtin_amdgcn_ds_bpermute((lane ^ m) << 2, __float_as_int(v))); }
__device__ __forceinline__ float shup(float v, int d, int lane, float ident) { const int src = lane - d; const float r = __int_as_float(__builtin_amdgcn_ds_bpermute(src << 2, __float_as_int(v))); return src >= 0 ? r : ident; }
__device__ __forceinline__ float shdn(float v, int d, int lane, float ident) { const int src = lane + d; const float r = __int_as_float(__builtin_amdgcn_ds_bpermute(src << 2, __float_as_int(v))); return src < 64 ? r : ident; }
__device__ __forceinline__ float lane63(float v) { return __int_as_float(__builtin_amdgcn_readlane(__float_as_int(v), 63)); }
__device__ __forceinline__ float red16l(float v, int lane) { v += shx(v, 1, lane); v += shx(v, 2, lane); v += shx(v, 4, lane); v += shx(v, 8, lane); return v; }

namespace pg8 {
constexpr int BM = 256, BK = 64, HALF = 128, HTB = HALF * BK * 2, NXCD = 8, WGM = 8;
__device__ __forceinline__ int lds_byte(int r, int c) { const int st = (r >> 4) * 2 + (c >> 5), rr = r & 15, cc = c & 31, ob = rr * 64 + cc * 2; return st * 1024 + (ob ^ (((ob >> 9) & 1) << 5)); }
__device__ __forceinline__ void stage_rc(int b, int& R, int& C) { const int st = b / 1024, sb = b % 1024, swz = sb ^ (((sb >> 9) & 1) << 5); R = (st >> 1) * 16 + swz / 64; C = (st & 1) * 32 + (swz % 64) / 2; }
struct Unit { int pm, pn, k0, nt, at; };
struct StaticOrder {
  int nM, nN, nwg, G, c, nsplit, nsu, ntf;
  __device__ void init(int M, int N, int K, int split, int G_, int c_) { nM = M / BM; nN = N / BM; nsplit = 0; nsu = 0; ntf = K / BK;
    if (split) { nM = NL / BM; nsplit = K / 256; nsu = (M / BM - nM) * nN * nsplit; }
    nwg = nM * nN; G = G_; c = c_; }
  __device__ bool next(int i, Unit& u) const {
    const long L = (long)i * G + c;
    int pm = 0, pn = 0, k0 = 0, nt = ntf, at = 0; bool ok = true;
    if (L >= nwg) {
      const long s = L - nwg;
      if (s >= nsu) ok = false;
      else { const int ks = (int)(s % nsplit), r = (int)(s / nsplit); pn = r % nN; pm = nM + r / nN; k0 = ks * 256; nt = 4; at = ks + 1; }
    } else {
      int wgid = (int)L; { const int q = nwg / NXCD, r = nwg % NXCD, xcd = wgid % NXCD, off = wgid / NXCD; wgid = (xcd < r ? xcd * (q + 1) : r * (q + 1) + (xcd - r) * q) + off; }
      const int nig = WGM * nN, gid = wgid / nig, fm = gid * WGM, gsz = (nM - fm) < WGM ? (nM - fm) : WGM;
      pm = fm + ((wgid % nig) % gsz); pn = (wgid % nig) / gsz;
    }
    u.pm = pm; u.pn = pn; u.k0 = k0; u.nt = nt; u.at = at; return ok;
  }
};
}

__device__ __forceinline__ int perm32(int rho) { const int n = rho >> 4, i = rho & 15; return 8 * (i >> 2) + 4 * n + (i & 3); }
__device__ __forceinline__ void epi_apply(const Phase& ph, const Ctx& c, const f32x4 (&acc)[2][2][4][2], int pm, int pn, int at, int wr, int wc, int fr, int fq) {
  const int row0 = pm * 256 + wr * 64 + fr;
  const int epi = ph.i0;
  if (epi == EPI_SWIGLU) {
    u16* O = (u16*)ph.O;
    const int hc = pn * 128 + wc * 32 + fq * 8;
#pragma unroll
    for (int ai = 0; ai < 2; ++ai)
#pragma unroll
      for (int m = 0; m < 4; ++m) {
        const size_t row = row0 + ai * 128 + m * 16;
        const f32x4 a0 = acc[ai][0][m][0], b0 = acc[ai][1][m][0], a1 = acc[ai][0][m][1], b1 = acc[ai][1][m][1];
        u32x4 o; o.x = pack2(siluf(a0[0]) * b0[0], siluf(a0[1]) * b0[1]); o.y = pack2(siluf(a0[2]) * b0[2], siluf(a0[3]) * b0[3]);
        o.z = pack2(siluf(a1[0]) * b1[0], siluf(a1[1]) * b1[1]); o.w = pack2(siluf(a1[2]) * b1[2], siluf(a1[3]) * b1[3]);
        *(u32x4*)(O + ((size_t)(pm * 44 + (hc >> 6)) * 256 + (row & 255)) * 64 + (hc & 63)) = o;
      }
  } else if (epi == EPI_RESID) {
    float* X = (float*)ph.O; const float* gate = (const float*)ph.X; const float f0 = ph.f0;
    const int r256 = pm * 256; const int set = r256 < NL ? (r256 >> 13) : 4;
    const float* Xs = ((ph.i1 & 2) && r256 < NL) ? c.x : (const float*)X;
    gate += (size_t)set * 9216;
    if (at) {
      float* P = ((ph.i1 & 4) ? c.part2 : c.part) + ((size_t)(at - 1) * 1024 - NL) * 1024;
#pragma unroll
      for (int bj = 0; bj < 2; ++bj)
#pragma unroll
        for (int n = 0; n < 2; ++n) {
          const int col = pn * 256 + bj * 128 + wc * 32 + n * 16 + fq * 4;
#pragma unroll
          for (int ai = 0; ai < 2; ++ai)
#pragma unroll
            for (int m = 0; m < 4; ++m) { const size_t row = row0 + ai * 128 + m * 16; *(f32x4*)(P + row * 1024 + col) = acc[ai][bj][m][n]; }
        }
    } else {
#pragma unroll
      for (int bj = 0; bj < 2; ++bj)
#pragma unroll
        for (int n = 0; n < 2; ++n) {
          const int col = pn * 256 + bj * 128 + wc * 32 + n * 16 + fq * 4;
          const f32x4 g = *(const f32x4*)(gate + col);
#pragma unroll
          for (int ai = 0; ai < 2; ++ai)
#pragma unroll
            for (int m = 0; m < 4; ++m) {
              const size_t row = row0 + ai * 128 + m * 16;
              f32x4 xv = *(const f32x4*)(Xs + row * 1024 + col); const f32x4 a = acc[ai][bj][m][n];
              xv[0] += f0 * g[0] * a[0]; xv[1] += f0 * g[1] * a[1]; xv[2] += f0 * g[2] * a[2]; xv[3] += f0 * g[3] * a[3];
              *(f32x4*)(X + row * 1024 + col) = xv;
            }
        }
    }
  } else if (epi == EPI_MLSTM_U) {
    if (pn < 12) {
      u16* O = (u16*)ph.O;
#pragma unroll
      for (int ai = 0; ai < 2; ++ai)
#pragma unroll
        for (int m = 0; m < 4; ++m) {
          const size_t row = row0 + ai * 128 + m * 16;
#pragma unroll
          for (int bj = 0; bj < 2; ++bj) {
            const int col = pn * 256 + bj * 128 + wc * 32 + fq * 8; const f32x4 a0 = acc[ai][bj][m][0], a1 = acc[ai][bj][m][1];
            u32x4 o; o.x = pack2(a0[0], a0[1]); o.y = pack2(a0[2], a0[3]); o.z = pack2(a1[0], a1[1]); o.w = pack2(a1[2], a1[3]);
            *(u32x4*)(O + row * 3072 + col) = o;
          }
        }
    } else if (wc == 0) {
      float* G = c.gates; const float* gb = c.m_gate_b;
#pragma unroll
      for (int n = 0; n < 2; ++n) {
        const int col = fq * 8 + n * 4; const f32x4 b = *(const f32x4*)(gb + col);
#pragma unroll
        for (int ai = 0; ai < 2; ++ai)
#pragma unroll
          for (int m = 0; m < 4; ++m) {
            const size_t row = row0 + ai * 128 + m * 16; const f32x4 a = acc[ai][0][m][n];
            f32x4 o; o[0] = a[0] + b[0]; o[1] = a[1] + b[1]; o[2] = a[2] + b[2]; o[3] = a[3] + b[3];
            *(f32x4*)(G + row * 32 + col) = o;
          }
      }
    }
  } else if (epi == EPI_RET_U) {
    u16* O = (u16*)ph.O; const float* rope = c.rope;
    const bool dorope = (pn < 4) && (pm * 256 < NL);
#pragma unroll
    for (int ai = 0; ai < 2; ++ai)
#pragma unroll
      for (int m = 0; m < 4; ++m) {
        const size_t row = row0 + ai * 128 + m * 16; const int t = (int)(row & 8191);
#pragma unroll
        for (int bj = 0; bj < 2; ++bj) {
          const int col = pn * 256 + bj * 128 + wc * 32 + fq * 8; f32x4 a0 = acc[ai][bj][m][0], a1 = acc[ai][bj][m][1];
          if (dorope) {
            const int p0 = (col & 255) >> 1;
            const f32x4 c0 = *(const f32x4*)(rope + ((size_t)t * 128 + p0) * 2), c1 = *(const f32x4*)(rope + ((size_t)t * 128 + p0) * 2 + 4);
            const float e0 = a0[0] * c0[0] - a0[1] * c0[1], o0 = a0[0] * c0[1] + a0[1] * c0[0];
            const float e1 = a0[2] * c0[2] - a0[3] * c0[3], o1 = a0[2] * c0[3] + a0[3] * c0[2];
            const float e2 = a1[0] * c1[0] - a1[1] * c1[1], o2 = a1[0] * c1[1] + a1[1] * c1[0];
            const float e3 = a1[2] * c1[2] - a1[3] * c1[3], o3 = a1[2] * c1[3] + a1[3] * c1[2];
            a0[0] = e0; a0[1] = o0; a0[2] = e1; a0[3] = o1; a1[0] = e2; a1[1] = o2; a1[2] = e3; a1[3] = o3;
          }
          u32x4 o; o.x = pack2(a0[0], a0[1]); o.y = pack2(a0[2], a0[3]); o.z = pack2(a1[0], a1[1]); o.w = pack2(a1[2], a1[3]);
          *(u32x4*)(O + row * 2048 + col) = o;
        }
      }
  } else {
    u16* O = (u16*)ph.O;
#pragma unroll
    for (int ai = 0; ai < 2; ++ai)
#pragma unroll
      for (int m = 0; m < 4; ++m) {
        const size_t row = row0 + ai * 128 + m * 16;
#pragma unroll
        for (int bj = 0; bj < 2; ++bj) {
          const int col = pn * 256 + bj * 128 + wc * 32 + fq * 8; const f32x4 a0 = acc[ai][bj][m][0], a1 = acc[ai][bj][m][1];
          u32x4* yp = (u32x4*)(O + row * 2048 + col); u32x4 yv = *yp;
          yv.x = pack2(lo2f(yv.x) * siluf(a0[0]), hi2f(yv.x) * siluf(a0[1])); yv.y = pack2(lo2f(yv.y) * siluf(a0[2]), hi2f(yv.y) * siluf(a0[3]));
          yv.z = pack2(lo2f(yv.z) * siluf(a1[0]), hi2f(yv.z) * siluf(a1[1])); yv.w = pack2(lo2f(yv.w) * siluf(a1[2]), hi2f(yv.w) * siluf(a1[3]));
          *yp = yv;
        }
      }
  }
}

__device__ __forceinline__ void gemm_phase(int wv, ldsp lds, const Phase& ph, const Ctx& c) {
  using namespace pg8;
  int wvo = wv; asm volatile("" : "+s"(wvo)); int lno; asm volatile("v_mbcnt_lo_u32_b32 %0, -1, 0\n\tv_mbcnt_hi_u32_b32 %0, -1, %0" : "=v"(lno)); int tid = (wvo << 6) | lno; const int wid = __builtin_amdgcn_readfirstlane(tid >> 6), lane = tid & 63, wr = wid >> 2, wc = wid & 3, fr = lane & 15, fq = lane >> 4;
  const int K = ph.K;
  StaticOrder S; S.init(ph.M, ph.N, ph.K, ph.i1 & 1, gridDim.x, blockIdx.x);
  const bool ablk = (ph.i1 & 8) != 0;
  unsigned voffA[2], voffB[2];
#pragma unroll
  for (int i = 0; i < 2; ++i) { int R, C; stage_rc(tid * 16 + i * 8192, R, C); voffB[i] = (unsigned)(R * K + C) * 2u; voffA[i] = ablk ? (unsigned)(R * 64 + C) * 2u : voffB[i]; }
  const size_t kstepB = (size_t)(BK * 2), hstepB = (size_t)HALF * K * 2, tstepB = 2 * hstepB;
  const size_t kstepA = ablk ? (size_t)32768 : kstepB, hstepA = ablk ? (size_t)16384 : hstepB, tstepA = ablk ? (size_t)(K / 64) * 32768 : tstepB;
  const size_t k0mulA = ablk ? (size_t)512 : (size_t)2;
  const unsigned ldsw = (unsigned)wid * 1024u;
  const int aoff = lds_byte(wr * 64 + fr, fq * 8), boff = lds_byte(wc * 32 + fr, fq * 8);
#define PG8_SA(b, h) (((b) * 2 + (h)) * HTB)
#define PG8_SB(b, h) ((4 + (b) * 2 + (h)) * HTB)
#define PG8_STAGE(bufoff, gbase, voff) do { _Pragma("unroll") for (int _i = 0; _i < 2; ++_i) \
    __builtin_amdgcn_global_load_lds((const unsigned*)((const char*)(gbase) + (voff)[_i]), (LAS unsigned*)(lds + (bufoff) + ldsw + _i * 8192), 16, 0, 0); } while (0)
#define PG8_LDA(dst, b, h) do { _Pragma("unroll") for (int m = 0; m < 4; ++m) _Pragma("unroll") for (int k = 0; k < 2; ++k) dst[m][k] = *(const LAS bf16x8*)(lds + PG8_SA(b, h) + aoff + m * 2048 + k * 1024); } while (0)
#define PG8_LDB(dst, b, h) do { _Pragma("unroll") for (int n = 0; n < 2; ++n) _Pragma("unroll") for (int k = 0; k < 2; ++k) dst[n][k] = *(const LAS bf16x8*)(lds + PG8_SB(b, h) + boff + n * 2048 + k * 1024); } while (0)
#define PG8_MMA(ai, bj, At, Bt) do { __builtin_amdgcn_s_setprio(1); _Pragma("unroll") for (int m = 0; m < 4; ++m) _Pragma("unroll") for (int n = 0; n < 2; ++n) _Pragma("unroll") for (int k = 0; k < 2; ++k) \
    acc[ai][bj][m][n] = __builtin_amdgcn_mfma_f32_16x16x32_bf16(Bt[n][k], At[m][k], acc[ai][bj][m][n], 0, 0, 0); __builtin_amdgcn_s_setprio(0); } while (0)
#define PG8_WAIT_V(n) asm volatile("s_waitcnt vmcnt(" #n ")" ::: "memory")
#define PG8_WAIT_L(n) asm volatile("s_waitcnt lgkmcnt(" #n ")" ::: "memory")
#define PG8_BAR __builtin_amdgcn_s_barrier()
#define PG8_SCHED __builtin_amdgcn_sched_barrier(0)
  Unit cur, nxt; int ui = 0;
  if (!S.next(0, cur)) return;
  f32x4 acc[2][2][4][2];
#pragma unroll
  for (int a = 0; a < 2; ++a)
#pragma unroll
    for (int b = 0; b < 2; ++b)
#pragma unroll
      for (int m = 0; m < 4; ++m)
#pragma unroll
        for (int n = 0; n < 2; ++n) acc[a][b][m][n] = (f32x4){0.f, 0.f, 0.f, 0.f};
  bf16x8 At[4][2], B0[2][2], B1[2][2];
  const char* cA = (const char*)ph.A + (size_t)cur.pm * tstepA + (size_t)cur.k0 * k0mulA; const char* cB = (const char*)ph.B + (size_t)cur.pn * tstepB + (size_t)cur.k0 * 2;
  PG8_STAGE(PG8_SB(0, 0), cB, voffB); PG8_STAGE(PG8_SA(0, 0), cA, voffA); PG8_STAGE(PG8_SB(0, 1), cB + hstepB, voffB); PG8_STAGE(PG8_SA(0, 1), cA + hstepA, voffA);
  if (wr == 1) PG8_BAR;
  PG8_WAIT_V(4); PG8_BAR;
  PG8_STAGE(PG8_SB(1, 0), cB + kstepB, voffB); PG8_STAGE(PG8_SA(1, 0), cA + kstepA, voffA); PG8_STAGE(PG8_SB(1, 1), cB + hstepB + kstepB, voffB);
  PG8_WAIT_V(6); PG8_BAR;
  for (;;) {
    const bool has_next = S.next(ui + 1, nxt);
    const char* nA = has_next ? (const char*)ph.A + (size_t)nxt.pm * tstepA + (size_t)nxt.k0 * k0mulA : cA; const char* nB = has_next ? (const char*)ph.B + (size_t)nxt.pn * tstepB + (size_t)nxt.k0 * 2 : cB;
    const int nt = cur.nt;
    for (int t = 0; t < nt; t += 2) {
      const bool last = (t == nt - 2);
      const char* a1 = cA + (size_t)(t + 1) * kstepA;
      const char* a2 = last ? nA : cA + (size_t)(t + 2) * kstepA; const char* b2 = last ? nB : cB + (size_t)(t + 2) * kstepB;
      const char* a3 = a2 + kstepA; const char* b3 = b2 + kstepB;
      PG8_LDB(B0, 0, 0); PG8_SCHED; PG8_LDA(At, 0, 0); PG8_STAGE(PG8_SA(1, 1), a1 + hstepA, voffA);
      PG8_WAIT_L(8); PG8_BAR; PG8_WAIT_L(0); PG8_MMA(0, 0, At, B0); PG8_BAR; PG8_SCHED;
      PG8_LDB(B1, 0, 1); PG8_STAGE(PG8_SB(0, 0), b2, voffB);
      PG8_BAR; PG8_WAIT_L(0); PG8_MMA(0, 1, At, B1); PG8_BAR;
      PG8_LDA(At, 0, 1); PG8_STAGE(PG8_SA(0, 0), a2, voffA);
      PG8_BAR; PG8_WAIT_L(0); PG8_MMA(1, 0, At, B0); PG8_BAR; PG8_SCHED;
      PG8_STAGE(PG8_SB(0, 1), b2 + hstepB, voffB);
      PG8_WAIT_V(6); PG8_BAR; PG8_MMA(1, 1, At, B1); PG8_BAR;
      PG8_LDB(B0, 1, 0); PG8_SCHED; PG8_LDA(At, 1, 0); PG8_STAGE(PG8_SA(0, 1), a2 + hstepA, voffA);
      PG8_WAIT_L(8); PG8_BAR; PG8_WAIT_L(0); PG8_MMA(0, 0, At, B0); PG8_BAR; PG8_SCHED;
      PG8_LDB(B1, 1, 1); PG8_STAGE(PG8_SB(1, 0), b3, voffB);
      PG8_BAR; PG8_WAIT_L(0); PG8_MMA(0, 1, At, B1); PG8_BAR;
      PG8_LDA(At, 1, 1); PG8_STAGE(PG8_SA(1, 0), a3, voffA);
      PG8_BAR; PG8_WAIT_L(0); PG8_MMA(1, 0, At, B0); PG8_BAR; PG8_SCHED;
      PG8_STAGE(PG8_SB(1, 1), b3 + hstepB, voffB);
      PG8_WAIT_V(6); PG8_BAR; PG8_MMA(1, 1, At, B1); PG8_BAR;
    }
    epi_apply(ph, c, acc, cur.pm, cur.pn, cur.at, wr, wc, fr, fq);
    if (!has_next) break;
#pragma unroll
    for (int a = 0; a < 2; ++a)
#pragma unroll
      for (int b = 0; b < 2; ++b)
#pragma unroll
        for (int m = 0; m < 4; ++m)
#pragma unroll
          for (int n = 0; n < 2; ++n) acc[a][b][m][n] = (f32x4){0.f, 0.f, 0.f, 0.f};
    cur = nxt; cA = nA; cB = nB; ++ui;
  }
  PG8_WAIT_V(0);
  if (wr == 0) PG8_BAR;
  PG8_BAR;
}

__device__ void phase_init(int wv, ldsp lds, const Ctx& c) {
  int wvo = wv; asm volatile("" : "+s"(wvo)); int lno; asm volatile("v_mbcnt_lo_u32_b32 %0, -1, 0\n\tv_mbcnt_hi_u32_b32 %0, -1, %0" : "=v"(lno)); int tid = (wvo << 6) | lno; const int wid = tid >> 6, lane = tid & 63;
  LAS float* sc = (LAS float*)lds;
  LAS float* red = (LAS float*)(lds + 20480);
  for (int i = tid; i < 5120; i += 512) { const int s = i >> 10, k = i & 1023; const float v = s < 4 ? c.c[s * 1024 + k] : c.c_ctx[k]; sc[i] = siluf(v); }
  __syncthreads();
  for (int item = blockIdx.x; item < 288; item += gridDim.x) {
    const int l = item / 144, j0 = (item % 144) * 64;
    const float* w = c.mod_w + (size_t)l * 1024 * 9216 + j0 + lane;
    float a0 = 0, a1 = 0, a2 = 0, a3 = 0, a4 = 0;
    for (int k = wid * 128; k < wid * 128 + 128; ++k) {
      const float wv = w[(size_t)k * 9216];
      a0 += sc[k] * wv; a1 += sc[1024 + k] * wv; a2 += sc[2048 + k] * wv; a3 += sc[3072 + k] * wv; a4 += sc[4096 + k] * wv;
    }
    red[(wid * 5 + 0) * 64 + lane] = a0; red[(wid * 5 + 1) * 64 + lane] = a1; red[(wid * 5 + 2) * 64 + lane] = a2; red[(wid * 5 + 3) * 64 + lane] = a3; red[(wid * 5 + 4) * 64 + lane] = a4;
    __syncthreads();
    if (tid < 320) { const int s = tid >> 6; float v = 0; for (int ww = 0; ww < 8; ++ww) v += red[(ww * 5 + s) * 64 + lane];
      c.modv[(size_t)(l * 5 + s) * 9216 + j0 + lane] = v + c.mod_b[l * 9216 + j0 + lane]; }
    __syncthreads();
  }
  const size_t gt = (size_t)blockIdx.x * 512 + tid, gs = (size_t)gridDim.x * 512;
  for (size_t i = gt; i < (size_t)8192 * 128; i += gs) {
    const int t = (int)(i >> 7), p = (int)(i & 127); const int f = p & 63; const int pos = p < 64 ? (t >> 6) : (t & 63);
    const double inv = (double)exp2f(-(float)f * 0.20762050593046015f);
    const double rev = (double)pos * inv * 0.15915494309189535; const float fr = (float)(rev - rint(rev));
    c.rope[i * 2] = __builtin_amdgcn_cosf(fr); c.rope[i * 2 + 1] = __builtin_amdgcn_sinf(fr);
  }
  const float4* cs = (const float4*)c.ctx; float4* xd = (float4*)c.xr;
  for (size_t i = gt; i < (size_t)(NT - NL) * 256; i += gs) xd[(size_t)NL * 256 + i] = cs[i];
}

struct TileD { const float* src; u16* dst; int ld, nvalid, sc0, K, n0, k0, perm; float scale; };
__device__ __forceinline__ void tile_desc(const Ctx& c, int kind, int l, int f, int it, TileD& d) {
  const float* src; u16* dst; int ld, nvalid, sc0, K, n0, k0, perm = 1; float scale = 1.f;
  if (kind == 0) {
    if (it < 1408) { const int nb = it >> 4, kb = it & 15; const int pn = nb >> 2, q = nb & 3;
      src = c.w13 + (size_t)(l * 2 + f) * 1024 * 5632; dst = c.wb; ld = 5632; nvalid = 5632; sc0 = (q < 2 ? 0 : 2816) + 128 * pn + (q & 1) * 64; K = 1024; n0 = nb * 64; k0 = kb * 64; }
    else { const int i2 = it - 1408; const int nb = i2 / 44, kb = i2 % 44;
      perm = 0; src = c.w2 + (size_t)(l * 2 + f) * 2816 * 1024; dst = c.wb + (size_t)5632 * 1024; ld = 1024; nvalid = 1024; sc0 = nb * 64; K = 2816; n0 = nb * 64; k0 = kb * 64; }
  } else if (kind == 1) {
    if (it < 832) { const int nb = it >> 4, kb = it & 15; src = c.m_w_in; dst = c.wb; ld = 3104; nvalid = 3104; sc0 = nb * 64; K = 1024; n0 = nb * 64; k0 = kb * 64; }
    else { const int i2 = it - 832; const int nb = i2 >> 4, kb = i2 & 15; perm = 0; src = c.m_w_out; dst = c.wb + (size_t)3328 * 1024; ld = 1024; nvalid = 1024; sc0 = nb * 64; K = 1024; n0 = nb * 64; k0 = kb * 64; }
  } else {
    if (it < 1536) { const int nb = it >> 4, kb = it & 15; const int n = nb * 64; int s0;
      if (n < 4096) { const int hp = n >> 11, r = n & 2047; if (r < 512) s0 = hp * 512 + r; else if (r < 1024) { s0 = 1024 + hp * 512 + (r - 512); scale = 0.0625f; } else s0 = 2048 + hp * 1024 + (r - 1024); }
      else s0 = n;
      src = c.r_w_in; dst = c.wb; ld = 6144; nvalid = 6144; sc0 = s0; K = 1024; n0 = n; k0 = kb * 64; }
    else { const int i2 = it - 1536; const int nb = i2 >> 5, kb = i2 & 31; perm = 0; src = c.r_w_out; dst = c.wb + (size_t)6144 * 1024; ld = 1024; nvalid = 1024; sc0 = nb * 64; K = 2048; n0 = nb * 64; k0 = kb * 64; }
  }
  d.src = src; d.dst = dst; d.ld = ld; d.nvalid = nvalid; d.sc0 = sc0; d.K = K; d.n0 = n0; d.k0 = k0; d.perm = perm; d.scale = scale;
}
__device__ __forceinline__ void tile_load(const TileD& d, int tid, float4& v0, float4& v1) {
  const int kk = tid >> 4, c4 = (tid & 15) * 4; const int col = d.sc0 + c4;
  v0 = make_float4(0.f, 0.f, 0.f, 0.f); v1 = v0;
  if (col < d.nvalid) { const float* p = d.src + (size_t)(d.k0 + kk) * d.ld + col; v0 = *(const float4*)p; v1 = *(const float4*)(p + (size_t)32 * d.ld); }
}

__device__ void phase_norm(int wv, ldsp lds, const Phase& ph, const Ctx& c) {
  int wvo = wv; asm volatile("" : "+s"(wvo)); int lno; asm volatile("v_mbcnt_lo_u32_b32 %0, -1, 0\n\tv_mbcnt_hi_u32_b32 %0, -1, %0" : "=v"(lno)); int tid = (wvo << 6) | lno; const int wid = tid >> 6, lane = tid & 63;
  const int l = ph.i0, j = ph.i1, kind = ph.pad;
  {
    const int ntile = kind == 0 ? 2112 : (kind == 1 ? 1088 : 2048);
    LAS float* tile = (LAS float*)lds;
    TileD d; float4 p0, p1; int it = blockIdx.x; asm volatile("" : "+s"(it));
    if (it < ntile) { tile_desc(c, kind, l, ph.K, it, d); tile_load(d, tid, p0, p1); }
#pragma unroll 1
    for (; it < ntile; it += gridDim.x) {
      const float sc = d.scale; const int dperm = d.perm; u16* dptr = d.dst + (size_t)(d.n0 + (tid >> 3)) * d.K + d.k0 + (tid & 7) * 8;
      { const int kk = tid >> 4, c4 = (tid & 15) * 4;
        tile[kk * 65 + c4] = p0.x * sc; tile[kk * 65 + c4 + 1] = p0.y * sc; tile[kk * 65 + c4 + 2] = p0.z * sc; tile[kk * 65 + c4 + 3] = p0.w * sc;
        tile[(kk + 32) * 65 + c4] = p1.x * sc; tile[(kk + 32) * 65 + c4 + 1] = p1.y * sc; tile[(kk + 32) * 65 + c4 + 2] = p1.z * sc; tile[(kk + 32) * 65 + c4 + 3] = p1.w * sc; }
      if (it + (int)gridDim.x < ntile) { tile_desc(c, kind, l, ph.K, it + gridDim.x, d); tile_load(d, tid, p0, p1); }
      __syncthreads();
      { const int nd = tid >> 3, kc = (tid & 7) * 8; const int n = dperm ? (nd & 32) + perm32(nd & 31) : nd; u32x4 o;
        o.x = pack2(tile[(kc + 0) * 65 + n], tile[(kc + 1) * 65 + n]); o.y = pack2(tile[(kc + 2) * 65 + n], tile[(kc + 3) * 65 + n]);
        o.z = pack2(tile[(kc + 4) * 65 + n], tile[(kc + 5) * 65 + n]); o.w = pack2(tile[(kc + 6) * 65 + n], tile[(kc + 7) * 65 + n]);
        *(u32x4*)dptr = o; }
      __syncthreads();
    }
  }
  const float* g = c.norm_g + (size_t)(l * 3 + j) * 1024;
  const int nsplit = ph.N >> 8; const float* pbase = (ph.N & 2) ? c.part2 : c.part;
  const int rstride = gridDim.x * 8;
  float4 nv[4];
  { const int row = blockIdx.x * 8 + wid;
    if (row < ph.M) { const float4* xp = (const float4*)((((ph.N & 1) && row < NL) ? c.x : c.xr) + (size_t)row * 1024);
#pragma unroll
      for (int i = 0; i < 4; ++i) nv[i] = ldnt4(xp + lane + 64 * i); } }
  for (int row = blockIdx.x * 8 + wid; row < ph.M; row += rstride) {
    float4 v[4]; float ss = 0.f;
#pragma unroll
    for (int i = 0; i < 4; ++i) v[i] = nv[i];
    { const int nrow = row + rstride;
      if (nrow < ph.M) { const float4* xp = (const float4*)((((ph.N & 1) && nrow < NL) ? c.x : c.xr) + (size_t)nrow * 1024);
#pragma unroll
        for (int i = 0; i < 4; ++i) nv[i] = ldnt4(xp + lane + 64 * i); } }
    if (nsplit > 0 && row >= NL) {
      const float4* gp = (const float4*)((const float*)ph.X + (size_t)4 * 9216);
#pragma unroll
      for (int i = 0; i < 4; ++i) { float4 a = make_float4(0.f, 0.f, 0.f, 0.f);
        for (int ks = 0; ks < nsplit; ++ks) { const float4 pv = ((const float4*)(pbase + ((size_t)ks * 1024 + (row - NL)) * 1024))[lane + 64 * i]; a.x += pv.x; a.y += pv.y; a.z += pv.z; a.w += pv.w; }
        const float4 g4 = gp[lane + 64 * i]; const float f0 = ph.f0;
        v[i].x += f0 * g4.x * a.x; v[i].y += f0 * g4.y * a.y; v[i].z += f0 * g4.z * a.z; v[i].w += f0 * g4.w * a.w;
        ((float4*)(c.xr + (size_t)row * 1024))[lane + 64 * i] = v[i]; }
    }
#pragma unroll
    for (int i = 0; i < 4; ++i) ss += v[i].x * v[i].x + v[i].y * v[i].y + v[i].z * v[i].z + v[i].w * v[i].w;
#pragma unroll
    for (int o = 1; o < 64; o <<= 1) ss += shx(ss, o, lane);
    const float rstd = rsqrtf(ss * (1.f / 1024.f) + 1e-6f);
    const int set = row < NL ? (row >> 13) : 4;
    const float* sh = c.modv + (size_t)(l * 5 + set) * 9216 + (3 * j) * 1024; const float* sc = sh + 1024;
#pragma unroll
    for (int i = 0; i < 4; ++i) {
      const int q = lane + 64 * i; const float4 g4 = ((const float4*)g)[q], s4 = ((const float4*)sh)[q], c4 = ((const float4*)sc)[q];
      u32x2 o; o.x = pack2(v[i].x * rstd * g4.x * (1.f + c4.x) + s4.x, v[i].y * rstd * g4.y * (1.f + c4.y) + s4.y);
      o.y = pack2(v[i].z * rstd * g4.z * (1.f + c4.z) + s4.z, v[i].w * rstd * g4.w * (1.f + c4.w) + s4.w);
      *(u32x2*)(c.hb + (size_t)row * 1024 + q * 4) = o;
    }
  }
}

__device__ void phase_final(int wv, const Ctx& c) {
  int wvo = wv; asm volatile("" : "+s"(wvo)); int lno; asm volatile("v_mbcnt_lo_u32_b32 %0, -1, 0\n\tv_mbcnt_hi_u32_b32 %0, -1, %0" : "=v"(lno)); int tid = (wvo << 6) | lno; const int wid = tid >> 6, lane = tid & 63;
  for (int row = blockIdx.x * 8 + wid; row < NL; row += gridDim.x * 8) {
    const float4* xp = (const float4*)(c.xr + (size_t)row * 1024);
    float4 v[4]; float ss = 0.f;
#pragma unroll
    for (int i = 0; i < 4; ++i) { v[i] = ldnt4(xp + lane + 64 * i); ss += v[i].x * v[i].x + v[i].y * v[i].y + v[i].z * v[i].z + v[i].w * v[i].w; }
#pragma unroll
    for (int o = 1; o < 64; o <<= 1) ss += shx(ss, o, lane);
    const float rstd = rsqrtf(ss * (1.f / 1024.f) + 1e-6f);
#pragma unroll
    for (int i = 0; i < 4; ++i) { const int q = lane + 64 * i; const float4 g4 = ((const float4*)c.final_g)[q];
      float4 o; o.x = v[i].x * rstd * g4.x; o.y = v[i].y * rstd * g4.y; o.z = v[i].z * rstd * g4.z; o.w = v[i].w * rstd * g4.w;
      stnt4((float4*)(c.out + (size_t)row * 1024) + q, o); }
  }
}

#define MPRE_ELEMS ((size_t)NT * 3072)
__device__ __forceinline__ int m_chunk_row0(int b, int dir, int cs) {
  if (cs < 2) { const int j = dir ? 1 - cs : cs; return NL + b * 256 + j * 128; }
  const int j = dir ? 65 - cs : cs - 2; return b * 8192 + j * 128;
}

__device__ void phase_mconv(int wv, const Ctx& c) {
  const u16* pre = c.big; const float* cw = c.m_conv_w;
  int wvo = wv; asm volatile("" : "+s"(wvo)); int lno; asm volatile("v_mbcnt_lo_u32_b32 %0, -1, 0\n\tv_mbcnt_hi_u32_b32 %0, -1, %0" : "=v"(lno)); int tid = (wvo << 6) | lno; const size_t gt = (size_t)blockIdx.x * 512 + tid, gs = (size_t)gridDim.x * 512;
  for (size_t i = gt; i < (size_t)NT * 128; i += gs) {
    const int r = (int)(i >> 7), cg = (int)(i & 127) * 8;
    int pos, len; if (r < NL) { pos = r & 8191; len = 8192; } else { pos = (r - NL) & 255; len = 256; }
    float a[8];
#pragma unroll
    for (int q = 0; q < 8; ++q) a[q] = 0.f;
#pragma unroll
    for (int j = 0; j < 5; ++j) {
      const int pp = pos + j - 2;
      if (pp >= 0 && pp < len) {
        const u32x4 u = *(const u32x4*)(pre + (size_t)(r + j - 2) * 3072 + cg);
        const float4 w0 = *(const float4*)(cw + j * 1024 + cg), w1 = *(const float4*)(cw + j * 1024 + cg + 4);
        a[0] += w0.x * lo2f(u.x); a[1] += w0.y * hi2f(u.x); a[2] += w0.z * lo2f(u.y); a[3] += w0.w * hi2f(u.y);
        a[4] += w1.x * lo2f(u.z); a[5] += w1.y * hi2f(u.z); a[6] += w1.z * lo2f(u.w); a[7] += w1.w * hi2f(u.w);
      }
    }
    const float sc = cg >= 512 ? 0.125f : 1.f;
    u32x4 o; o.x = pack2(siluf(a[0]) * sc, siluf(a[1]) * sc); o.y = pack2(siluf(a[2]) * sc, siluf(a[3]) * sc);
    o.z = pack2(siluf(a[4]) * sc, siluf(a[5]) * sc); o.w = pack2(siluf(a[6]) * sc, siluf(a[7]) * sc);
    *(u32x4*)(c.hb + (size_t)r * 1024 + cg) = o;
  }
}

__device__ void phase_ma(int wv, ldsp lds, const Ctx& c) {
  int wvo = wv; asm volatile("" : "+s"(wvo)); int lno; asm volatile("v_mbcnt_lo_u32_b32 %0, -1, 0\n\tv_mbcnt_hi_u32_b32 %0, -1, %0" : "=v"(lno)); int tid = (wvo << 6) | lno; const int wid = tid >> 6, lane = tid & 63;
  ldsp sK = lds; ldsp sV = lds + 128 * 144; LAS float* sf = (LAS float*)(lds + 128 * 144 + 128 * 272);
  const u16* pre = c.big; u16* mc = c.big + MPRE_ELEMS;
  for (int item = blockIdx.x; item < 2 * 4 * 8 * 65; item += gridDim.x) {
    const int cs = item % 65; const int sq = item / 65; const int h = sq & 7, b = (sq >> 3) & 3, dir = sq >> 5;
    const int row0 = m_chunk_row0(b, dir, cs);
    if (wid == 0) {
      const float* gp = c.gates + (size_t)(row0 + 2 * lane) * 32 + dir * 16 + h;
      const float ig0 = gp[0], lf0 = logsig(gp[8]), ig1 = gp[32], lf1 = logsig(gp[40]);
      const float s2 = lf0 + lf1; float inc = s2;
#pragma unroll
      for (int d = 1; d < 64; d <<= 1) inc += shup(inc, d, lane, 0.f);
      const float total = lane63(inc); const float ex = inc - s2;
      const float g0 = (dir ? ex : total - ex - lf0) + ig0;
      const float g1 = (dir ? ex + lf0 : total - ex - lf0 - lf1) + ig1;
      float mx = fmaxf(g0, g1);
#pragma unroll
      for (int m = 1; m < 64; m <<= 1) mx = fmaxf(mx, shx(mx, m, lane));
      sf[256 + 2 * lane] = __expf(g0 - mx); sf[257 + 2 * lane] = __expf(g1 - mx);
      if (lane == 0) { c.mst_s[4224 + sq * 66 + cs] = total; c.mst_s[sq * 66 + cs] = mx; }
    }
    __syncthreads();
    { const int row = tid >> 2, part = tid & 3; const float w = sf[256 + row];
      const u16* kp = c.hb + (size_t)(row0 + row) * 1024 + 512 + h * 64 + part * 16;
#pragma unroll
      for (int q = 0; q < 2; ++q) { const u32x4 u = *(const u32x4*)(kp + q * 8); u32x4 o;
        o.x = pack2(lo2f(u.x) * w, hi2f(u.x) * w); o.y = pack2(lo2f(u.y) * w, hi2f(u.y) * w); o.z = pack2(lo2f(u.z) * w, hi2f(u.z) * w); o.w = pack2(lo2f(u.w) * w, hi2f(u.w) * w);
        *(LAS u32x4*)(sK + row * 144 + part * 32 + q * 16) = o; }
      const u16* vp = pre + (size_t)(row0 + row) * 3072 + 1024 + h * 128 + part * 32;
#pragma unroll
      for (int q = 0; q < 4; ++q) *(LAS u32x4*)(sV + row * 272 + part * 64 + q * 16) = *(const u32x4*)(vp + q * 8);
    }
    __syncthreads();
    f32x4 acc[4];
#pragma unroll
    for (int n = 0; n < 4; ++n) acc[n] = (f32x4){0.f, 0.f, 0.f, 0.f};
#pragma unroll
    for (int k0 = 0; k0 < 128; k0 += 32) {
      const bf16x8 a = frag_tr(sV, 272, wid * 16, k0, lane);
#pragma unroll
      for (int n = 0; n < 4; ++n) { const bf16x8 bb = frag_tr(sK, 144, n * 16, k0, lane); acc[n] = MFMA16(a, bb, acc[n]); }
    }
    u16* dst = mc + (size_t)(sq * 66 + cs) * 8192;
#pragma unroll
    for (int n = 0; n < 4; ++n)
#pragma unroll
      for (int r = 0; r < 4; ++r) dst[(wid * 16 + 4 * (lane >> 4) + r) * 64 + n * 16 + (lane & 15)] = f2bf(acc[n][r]);
    { float s = 0.f;
#pragma unroll
      for (int p = 0; p < 16; ++p) s += bf2f(*(LAS u16*)(sK + (wid * 16 + p) * 144 + lane * 2));
      sf[384 + wid * 64 + lane] = s; }
    __syncthreads();
    if (tid < 64) { float s = 0.f;
#pragma unroll
      for (int w8 = 0; w8 < 8; ++w8) s += sf[384 + w8 * 64 + tid];
      c.mst_n[(size_t)(sq * 66 + cs) * 64 + tid] = s; }
    __syncthreads();
  }
}

__device__ void phase_mb(int wv, const Ctx& c) {
  int wvo = wv; asm volatile("" : "+s"(wvo)); int lno; asm volatile("v_mbcnt_lo_u32_b32 %0, -1, 0\n\tv_mbcnt_hi_u32_b32 %0, -1, %0" : "=v"(lno)); int tid = (wvo << 6) | lno;
  u16* mc = c.big + MPRE_ELEMS;
  for (int item = blockIdx.x; item < 64 * 8; item += gridDim.x) {
    const int sq = item >> 3, slab = item & 7;
    unsigned* p = (unsigned*)(mc + (size_t)sq * 66 * 8192 + slab * 1024 + tid * 2);
    const bool nth = (slab == 0 && tid < 64);
    float* np = c.mst_n + (size_t)sq * 66 * 64 + tid;
    float m = -1e30f, c0 = 0.f, c1 = 0.f, cn = 0.f;
#pragma unroll 1
    for (int cb = 0; cb < 66; cb += 11) {
      unsigned loc[11]; float nl[11], bl[11], ml[11];
#pragma unroll
      for (int q = 0; q < 11; ++q) { const int cs = cb + q; loc[q] = 0u; nl[q] = 0.f; bl[q] = 0.f; ml[q] = 0.f;
        if (cs < 65) { loc[q] = p[(size_t)cs * 4096]; bl[q] = c.mst_s[4224 + sq * 66 + cs]; ml[q] = c.mst_s[sq * 66 + cs]; if (nth) nl[q] = np[cs * 64]; } }
#pragma unroll
      for (int q = 0; q < 11; ++q) { const int cs = cb + q;
        p[(size_t)cs * 4096] = pack2(c0, c1);
        if (nth) np[cs * 64] = cn;
        if (slab == 0 && tid == 0) c.mst_s[8448 + sq * 66 + cs] = m;
        if (cs < 65) {
          const float mn = fmaxf(bl[q] + m, ml[q]); const float wp = __expf(bl[q] + m - mn), wl = __expf(ml[q] - mn);
          c0 = wp * c0 + wl * lo2f(loc[q]); c1 = wp * c1 + wl * hi2f(loc[q]); cn = wp * cn + wl * nl[q]; m = mn;
        } }
    }
  }
}

__device__ void phase_mc(int wv, ldsp lds, const Ctx& c) {
  int wvo = wv; asm volatile("" : "+s"(wvo)); int lno; asm volatile("v_mbcnt_lo_u32_b32 %0, -1, 0\n\tv_mbcnt_hi_u32_b32 %0, -1, %0" : "=v"(lno)); int tid = (wvo << 6) | lno; const int wid = tid >> 6, lane = tid & 63;
  ldsp sQ = lds, sK = lds + 18432, sV = lds + 36864, sP = lds + 71680, sC0 = lds + 106496, sC1 = lds + 124928;
  LAS float* sf = (LAS float*)(lds + 143360);
  const u16* pre = c.big; const u16* mc = c.big + MPRE_ELEMS;
  for (int item = blockIdx.x; item < 4 * 8 * 66; item += gridDim.x) {
    const int j = item % 66; const int bh = item / 66; const int h = bh & 7, b = bh >> 3;
    const int row0 = j < 2 ? NL + b * 256 + j * 128 : b * 8192 + (j - 2) * 128;
    const int csf = j, csb = j < 2 ? 1 - j : 67 - j;
    const int sqf = b * 8 + h, sqb = 32 + b * 8 + h;
    const int d2 = tid >> 7, po = tid & 127;
    if (wid < 2) {
      const int dd = wid;
      const float* gp = c.gates + (size_t)(row0 + 2 * lane) * 32 + dd * 16 + h;
      const float ig0 = gp[0], lf0 = logsig(gp[8]), ig1 = gp[32], lf1 = logsig(gp[40]);
      const float s2 = lf0 + lf1; float inc = s2;
#pragma unroll
      for (int d = 1; d < 64; d <<= 1) inc += shup(inc, d, lane, 0.f);
      const float total = lane63(inc); const float ex = inc - s2;
      const float bb0 = dd ? total - ex : ex + lf0;
      const float bb1 = dd ? total - ex - lf0 : ex + s2;
      const float e0 = ig0 - bb0, e1 = ig1 - bb1, e01 = fmaxf(e0, e1);
      const float mpre = c.mst_s[8448 + (dd ? sqb * 66 + csb : sqf * 66 + csf)];
      float pm0, pm1;
      if (!dd) { float P = e01;
#pragma unroll
        for (int d = 1; d < 64; d <<= 1) P = fmaxf(P, shup(P, d, lane, -3.0e38f));
        const float xp = shup(P, 1, lane, -3.0e38f); pm0 = fmaxf(xp, e0); pm1 = fmaxf(xp, e01); }
      else { float S = e01;
#pragma unroll
        for (int d = 1; d < 64; d <<= 1) S = fmaxf(S, shdn(S, d, lane, -3.0e38f));
        const float xs = shdn(S, 1, lane, -3.0e38f); pm1 = fmaxf(xs, e1); pm0 = fmaxf(xs, e01); }
      const float M0 = fmaxf(mpre, pm0), M1 = fmaxf(mpre, pm1);
      const int o = dd * 128 + 2 * lane;
      sf[768 + o] = bb0; sf[769 + o] = bb1; sf[256 + o] = e0; sf[257 + o] = e1; sf[512 + o] = M0; sf[513 + o] = M1;
      sf[1024 + o] = __expf(mpre - M0); sf[1025 + o] = __expf(mpre - M1);
    }
    if (tid >= 256 && tid < 384) { const int q = tid - 256; const int d3 = q >> 6, dd = q & 63; sf[1536 + q] = c.mst_n[(size_t)(d3 ? sqb * 66 + csb : sqf * 66 + csf) * 64 + dd]; }
    { const int row = tid >> 2, part = tid & 3;
      const u16* qp = c.hb + (size_t)(row0 + row) * 1024 + h * 64 + part * 16;
#pragma unroll
      for (int q = 0; q < 2; ++q) { *(LAS u32x4*)(sQ + row * 144 + part * 32 + q * 16) = *(const u32x4*)(qp + q * 8); *(LAS u32x4*)(sK + row * 144 + part * 32 + q * 16) = *(const u32x4*)(qp + 512 + q * 8); }
      const u16* vp = pre + (size_t)(row0 + row) * 3072 + 1024 + h * 128 + part * 32;
#pragma unroll
      for (int q = 0; q < 4; ++q) *(LAS u32x4*)(sV + row * 272 + part * 64 + q * 16) = *(const u32x4*)(vp + q * 8);
      const u16* cf = mc + (size_t)(sqf * 66 + csf) * 8192 + row * 64 + part * 16; const u16* cb = mc + (size_t)(sqb * 66 + csb) * 8192 + row * 64 + part * 16;
#pragma unroll
      for (int q = 0; q < 2; ++q) { *(LAS u32x4*)(sC0 + row * 144 + part * 32 + q * 16) = *(const u32x4*)(cf + q * 8); *(LAS u32x4*)(sC1 + row * 144 + part * 32 + q * 16) = *(const u32x4*)(cb + q * 8); }
    }
    __syncthreads();
    { const int row = tid >> 2, part = tid & 3; float qf = 0.f, qb = 0.f;
#pragma unroll
      for (int q = 0; q < 2; ++q) { const u32x4 u = *(const LAS u32x4*)(sQ + row * 144 + part * 32 + q * 16); const int d0 = part * 16 + q * 8;
        const float v0 = lo2f(u.x), v1 = hi2f(u.x), v2 = lo2f(u.y), v3 = hi2f(u.y), v4 = lo2f(u.z), v5 = hi2f(u.z), v6 = lo2f(u.w), v7 = hi2f(u.w);
        qf += v0 * sf[1536 + d0] + v1 * sf[1537 + d0] + v2 * sf[1538 + d0] + v3 * sf[1539 + d0] + v4 * sf[1540 + d0] + v5 * sf[1541 + d0] + v6 * sf[1542 + d0] + v7 * sf[1543 + d0];
        qb += v0 * sf[1600 + d0] + v1 * sf[1601 + d0] + v2 * sf[1602 + d0] + v3 * sf[1603 + d0] + v4 * sf[1604 + d0] + v5 * sf[1605 + d0] + v6 * sf[1606 + d0] + v7 * sf[1607 + d0]; }
      qf += shx(qf, 1, lane); qf += shx(qf, 2, lane); qb += shx(qb, 1, lane); qb += shx(qb, 2, lane);
      if (part == 0) { sf[1280 + row] = qf; sf[1408 + row] = qb; } }
    f32x4 accS[8];
#pragma unroll
    for (int n = 0; n < 8; ++n) accS[n] = (f32x4){0.f, 0.f, 0.f, 0.f};
#pragma unroll
    for (int k0 = 0; k0 < 64; k0 += 32) {
      const bf16x8 a = frag_row(sQ, 144, wid * 16, k0, lane);
#pragma unroll
      for (int n = 0; n < 8; ++n) { const bf16x8 bb = frag_row(sK, 144, n * 16, k0, lane); accS[n] = MFMA16(a, bb, accS[n]); }
    }
    __syncthreads();
    f32x4 hs[8];
#pragma unroll
    for (int n = 0; n < 8; ++n) hs[n] = (f32x4){0.f, 0.f, 0.f, 0.f};
    const int tb = wid * 16 + 4 * (lane >> 4), sl = lane & 15;
#pragma unroll 1
    for (int dir = 0; dir < 2; ++dir) {
      float rs[4] = {0.f, 0.f, 0.f, 0.f}; float Mt[4];
#pragma unroll
      for (int r = 0; r < 4; ++r) Mt[r] = sf[512 + dir * 128 + tb + r];
#pragma unroll
      for (int n = 0; n < 8; ++n) { const int s = n * 16 + sl; const float es = sf[256 + dir * 128 + s];
#pragma unroll
        for (int r = 0; r < 4; ++r) { const int t = tb + r; const bool in = dir ? (s >= t) : (s <= t);
          const float pv = in ? accS[n][r] * __expf(es - Mt[r]) : 0.f; rs[r] += pv; *(LAS u16*)(sP + t * 272 + s * 2) = f2bf(pv); } }
#pragma unroll
      for (int r = 0; r < 4; ++r) rs[r] = red16l(rs[r], lane);
      float wi4[4], inv4[4];
#pragma unroll
      for (int r = 0; r < 4; ++r) { const int t = tb + r; const float wi = sf[1024 + dir * 128 + t];
        const float den = wi * sf[1280 + dir * 128 + t] + rs[r]; const float mt = sf[768 + dir * 128 + t] + Mt[r];
        wi4[r] = wi; inv4[r] = 1.f / fmaxf(fabsf(den), __expf(-mt)); }
      ldsp sC = dir ? sC1 : sC0;
#pragma unroll
      for (int eh = 0; eh < 2; ++eh) {
        f32x4 a1[4], a2[4];
#pragma unroll
        for (int n = 0; n < 4; ++n) { a1[n] = (f32x4){0.f, 0.f, 0.f, 0.f}; a2[n] = (f32x4){0.f, 0.f, 0.f, 0.f}; }
#pragma unroll
        for (int k0 = 0; k0 < 128; k0 += 32) { const bf16x8 a = frag_row(sP, 272, wid * 16, k0, lane);
#pragma unroll

#define FR_(n) frag_tr(sV, 272, (eh * 4 + (n)) * 16, k0, lane)
          SWEEP(4, 4, FR_, a, a1);
#undef FR_
        }
#pragma unroll
        for (int k0 = 0; k0 < 64; k0 += 32) { const bf16x8 a = frag_row(sQ, 144, wid * 16, k0, lane);
#pragma unroll

#define FR_(n) frag_row(sC, 144, (eh * 4 + (n)) * 16, k0, lane)
          SWEEP(4, 4, FR_, a, a2);
#undef FR_
        }
#pragma unroll
        for (int r = 0; r < 4; ++r)
#pragma unroll
          for (int n = 0; n < 4; ++n) hs[eh * 4 + n][r] += (a1[n][r] + wi4[r] * a2[n][r]) * inv4[r];
      }
    }
#pragma unroll
    for (int r = 0; r < 4; ++r) {
      float s = 0.f;
#pragma unroll
      for (int n = 0; n < 8; ++n) s += hs[n][r];
      const float mu = red16l(s, lane) * (1.f / 128.f); float v = 0.f;
#pragma unroll
      for (int n = 0; n < 8; ++n) { const float d = hs[n][r] - mu; v += d * d; }
      const float rstd = rsqrtf(red16l(v, lane) * (1.f / 128.f) + 1e-6f);
      const size_t row = row0 + tb + r;
#pragma unroll
      for (int n = 0; n < 8; ++n) { const int e = h * 128 + n * 16 + sl;
        const float og = bf2f(pre[row * 3072 + 2048 + e]);
        c.y[row * 1024 + e] = f2bf((hs[n][r] - mu) * rstd * c.m_norm_g[e] * sigmf(og)); }
    }
    __syncthreads();
  }
}

#define RUQ_ELEMS ((size_t)NT * 2048)
__device__ __forceinline__ float ret_lg(const Ctx& c, int dir, int h) { return logsig(c.r_decay[dir * 4 + h]); }

__device__ void phase_ra(int wv, ldsp lds, const Phase& ph, const Ctx& c) {
  int wvo = wv; asm volatile("" : "+s"(wvo)); int lno; asm volatile("v_mbcnt_lo_u32_b32 %0, -1, 0\n\tv_mbcnt_hi_u32_b32 %0, -1, %0" : "=v"(lno)); int tid = (wvo << 6) | lno; const int wid = tid >> 6, lane = tid & 63;
  ldsp sV = lds; ldsp sK = lds + 64 * 272;
  const u16* uq = c.big; u16* rst = c.big + RUQ_ELEMS; const int hp = ph.i0;
  for (int item = blockIdx.x; item < 1024; item += gridDim.x) {
    const int eq = item & 3, J = (item >> 2) & 15, hl = (item >> 6) & 1, b = (item >> 7) & 3, dir = item >> 9;
    const int sq = (dir * 4 + b) * 2 + hl; const float lg = ret_lg(c, dir, hp * 2 + hl);
    int row0, L; if (J == 0) { row0 = NL + b * 256; L = 256; } else { L = 512; row0 = b * 8192 + (dir ? 16 - J : J - 1) * 512; }
    f32x4 acc[16];
#pragma unroll
    for (int n = 0; n < 16; ++n) acc[n] = (f32x4){0.f, 0.f, 0.f, 0.f};
    const u16* vp = uq + (size_t)(row0 + (tid >> 4)) * 2048 + 1024 + hl * 512 + eq * 128 + (tid & 15) * 8;
    const u16* kp = uq + (size_t)(row0 + (tid >> 5)) * 2048 + 512 + hl * 256 + (tid & 31) * 8;
    u32x4 pv[2], pk[4];
#pragma unroll
    for (int q = 0; q < 2; ++q) pv[q] = *(const u32x4*)(vp + (size_t)q * 32 * 2048);
#pragma unroll
    for (int q = 0; q < 4; ++q) pk[q] = *(const u32x4*)(kp + (size_t)q * 16 * 2048);
    LDS_BAR();
#pragma unroll 1
    for (int s0 = 0; s0 < L; s0 += 64) {
      {
#pragma unroll
        for (int q = 0; q < 2; ++q) *(LAS u32x4*)(sV + (q * 32 + (tid >> 4)) * 272 + (tid & 15) * 16) = pv[q];
#pragma unroll
        for (int q = 0; q < 4; ++q) { const int krow = q * 16 + (tid >> 5); const int o = s0 + krow; const float z = __expf(lg * (float)(dir ? o : L - 1 - o)); const u32x4 u = pk[q]; u32x4 w;
          w.x = pack2(lo2f(u.x) * z, hi2f(u.x) * z); w.y = pack2(lo2f(u.y) * z, hi2f(u.y) * z); w.z = pack2(lo2f(u.z) * z, hi2f(u.z) * z); w.w = pack2(lo2f(u.w) * z, hi2f(u.w) * z);
          *(LAS u32x4*)(sK + krow * 528 + (tid & 31) * 16) = w; }
      }
      if (s0 + 64 < L) {
        const size_t adv = (size_t)(s0 + 64) * 2048;
#pragma unroll
        for (int q = 0; q < 2; ++q) pv[q] = *(const u32x4*)(vp + adv + (size_t)q * 32 * 2048);
#pragma unroll
        for (int q = 0; q < 4; ++q) pk[q] = *(const u32x4*)(kp + adv + (size_t)q * 16 * 2048);
      }
      LDS_BAR();
#pragma unroll
      for (int k0 = 0; k0 < 64; k0 += 32) { const bf16x8 a0 = frag_tr(sV, 272, (wid >> 1) * 32, k0, lane), a1 = frag_tr(sV, 272, (wid >> 1) * 32 + 16, k0, lane);
        bf16x8 bq[4];
#pragma unroll
        for (int n = 0; n < 4; ++n) bq[n] = frag_tr(sK, 528, (wid & 1) * 128 + n * 16, k0, lane);
        __builtin_amdgcn_sched_barrier(0);
#pragma unroll
        for (int n = 0; n < 8; ++n) { const bf16x8 cur = bq[n & 3]; if (n + 4 < 8) bq[n & 3] = frag_tr(sK, 528, (wid & 1) * 128 + (n + 4) * 16, k0, lane);
          acc[n] = MFMA16(a0, cur, acc[n]); acc[8 + n] = MFMA16(a1, cur, acc[8 + n]); __builtin_amdgcn_sched_barrier(0); }
      }
      LDS_BAR();
    }
    u16* dst = rst + (size_t)(sq * 16 + J) * 131072 + (size_t)(eq * 128 + (wid >> 1) * 32 + 4 * (lane >> 4)) * 256 + (wid & 1) * 128 + (lane & 15);
#pragma unroll
    for (int mi = 0; mi < 2; ++mi)
#pragma unroll
      for (int n = 0; n < 8; ++n)
#pragma unroll
        for (int r = 0; r < 4; ++r) dst[(mi * 16 + r) * 256 + n * 16] = f2bf(acc[mi * 8 + n][r]);
  }
}

__device__ void phase_rb(int wv, const Phase& ph, const Ctx& c) {
  int wvo = wv; asm volatile("" : "+s"(wvo)); int lno; asm volatile("v_mbcnt_lo_u32_b32 %0, -1, 0\n\tv_mbcnt_hi_u32_b32 %0, -1, %0" : "=v"(lno)); int tid = (wvo << 6) | lno; u16* rst = c.big + RUQ_ELEMS; const int hp = ph.i0;
  for (int item = blockIdx.x; item < 16 * 32; item += gridDim.x) {
    const int sq = item >> 5, slab = item & 31; const int hl = sq & 1, dir = sq >> 3;
    const float g512 = __expf(512.f * ret_lg(c, dir, hp * 2 + hl));
    u32x4* p = (u32x4*)(rst + (size_t)sq * 16 * 131072 + slab * 4096 + tid * 8);
    float cr[8];
#pragma unroll
    for (int q = 0; q < 8; ++q) cr[q] = 0.f;
    u32x4 uu[16];
#pragma unroll
    for (int J = 0; J < 16; ++J) uu[J] = p[(size_t)J * 16384];
#pragma unroll
    for (int J = 0; J < 16; ++J) {
      const u32x4 u = uu[J];
      cr[0] = g512 * cr[0] + lo2f(u.x); cr[1] = g512 * cr[1] + hi2f(u.x); cr[2] = g512 * cr[2] + lo2f(u.y); cr[3] = g512 * cr[3] + hi2f(u.y);
      cr[4] = g512 * cr[4] + lo2f(u.z); cr[5] = g512 * cr[5] + hi2f(u.z); cr[6] = g512 * cr[6] + lo2f(u.w); cr[7] = g512 * cr[7] + hi2f(u.w);
      u32x4 o; o.x = pack2(cr[0], cr[1]); o.y = pack2(cr[2], cr[3]); o.z = pack2(cr[4], cr[5]); o.w = pack2(cr[6], cr[7]);
      p[(size_t)J * 16384] = o;
    }
  }
}

__device__ __forceinline__ bf16x8 scale_frag(bf16x8 a, float s) {
  bf16x8 r;
#pragma unroll
  for (int q = 0; q < 8; ++q) r[q] = (short)f2bf(bf2f((u16)a[q]) * s);
  return r;
}

#define SWEEP2(NT, DEPTH, FRAG, A0, A1, ACC, OFF1) do { bf16x8 bq_[DEPTH]; \
    _Pragma("unroll") for (int n_ = 0; n_ < DEPTH; ++n_) bq_[n_] = FRAG(n_); __builtin_amdgcn_sched_barrier(0); \
    _Pragma("unroll") for (int n_ = 0; n_ < NT; ++n_) { const bf16x8 cur_ = bq_[n_ % DEPTH]; if (n_ + DEPTH < NT) bq_[n_ % DEPTH] = FRAG(n_ + DEPTH); \
      ACC[n_] = MFMA16(A0, cur_, ACC[n_]); ACC[OFF1 + n_] = MFMA16(A1, cur_, ACC[OFF1 + n_]); __builtin_amdgcn_sched_barrier(0); } } while (0)
__device__ void phase_rc(int wv, ldsp lds, const Phase& ph, const Ctx& c) {
  ldsp sQ = lds, sKP = lds + 67584, sV = lds + 102400;
  const u16* uq = c.big; const u16* rst = c.big + RUQ_ELEMS; const int hp = ph.i0;
  for (int item = blockIdx.x; item < 512; item += gridDim.x) {
    int wvo = wv; asm volatile("" : "+s"(wvo)); int lno; asm volatile("v_mbcnt_lo_u32_b32 %0, -1, 0\n\tv_mbcnt_hi_u32_b32 %0, -1, %0" : "=v"(lno)); int tid = (wvo << 6) | lno; const int wid = tid >> 6, lane = tid & 63;
    const int i = item & 3, Jo = (item >> 2) & 15, hl = (item >> 6) & 1, b = item >> 7;
    const int h = hp * 2 + hl; const float lgf = ret_lg(c, 0, h), lgb = ret_lg(c, 1, h);
    const int rowb = b * 8192 + Jo * 512;
    const unsigned kofs = (unsigned)((rowb + (tid >> 4)) * 2048 + 512 + hl * 256 + (tid & 15) * 8);
    const unsigned vofs = (unsigned)((rowb + (tid >> 6)) * 2048 + 1024 + hl * 512 + (tid & 63) * 8);
    const unsigned rofs = (unsigned)((tid >> 2) * 256 + (tid & 3) * 8);
    const u16* rs0 = rst + (size_t)(((0 * 4 + b) * 2 + hl) * 16 + Jo) * 131072;
    const u16* rs1 = rst + (size_t)(((1 * 4 + b) * 2 + hl) * 16 + (15 - Jo)) * 131072;
#define kbase (uq + kofs)
#define vbase (uq + vofs)
#define rbase0 (rs0 + rofs)
#define rbase1 (rs1 + rofs)
    const unsigned dK = (unsigned)((tid >> 4) * 272 + (tid & 15) * 16), dV = (unsigned)((tid >> 6) * 1040 + (tid & 63) * 16), dR = (unsigned)((tid >> 2) * 80 + (tid & 3) * 16);
    constexpr int KQ = 32 * 2048, VQ = 8 * 2048, RQ = 128 * 256, KD = 32 * 272, VD = 8 * 1040, RD = 128 * 80;
    u32x4 pf[4];
#pragma unroll
    for (int q = 0; q < 4; ++q) pf[q] = *(const u32x4*)(kbase + q * KQ);
    { const int row = tid >> 5, ch = tid & 31; const u16* qp = uq + (size_t)(rowb + i * 128 + row) * 2048 + hl * 256 + ch * 8;
#pragma unroll
      for (int q = 0; q < 8; ++q) *(LAS u32x4*)(sQ + (q * 16 + row) * 528 + ch * 16) = *(const u32x4*)(qp + (size_t)q * 16 * 2048); }
    f32x4 acc[32];
#pragma unroll
    for (int n = 0; n < 32; ++n) acc[n] = (f32x4){0.f, 0.f, 0.f, 0.f};
    const int mg = wid >> 1, ng = wid & 1, lq = lane >> 4, sl = lane & 15;
#pragma unroll 1
    for (int j = 0; j < 4; ++j) {
      f32x4 accS[8];
#pragma unroll
      for (int n = 0; n < 8; ++n) accS[n] = (f32x4){0.f, 0.f, 0.f, 0.f};
#pragma unroll 1
      for (int dh = 0; dh < 2; ++dh) {
        LDS_BAR();
#pragma unroll
        for (int q = 0; q < 4; ++q) *(LAS u32x4*)(sKP + dK + q * KD) = pf[q];
        { const u16* src = dh == 0 ? kbase + (size_t)j * 128 * 2048 + 128 : vbase + (size_t)(j * 128) * 2048; const int qs = dh == 0 ? KQ : VQ;
#pragma unroll
          for (int q = 0; q < 4; ++q) pf[q] = *(const u32x4*)(src + q * qs); }
        LDS_BAR();
#pragma unroll
        for (int k0 = 0; k0 < 128; k0 += 32) { const bf16x8 a0 = frag_row(sQ, 528, mg * 32, dh * 128 + k0, lane), a1 = frag_row(sQ, 528, mg * 32 + 16, dh * 128 + k0, lane);
#define FR_(n) frag_row(sKP, 272, ng * 64 + (n) * 16, k0, lane)
          SWEEP2(4, 2, FR_, a0, a1, accS, 4);
#undef FR_
        }
      }
      LDS_BAR();
#pragma unroll
      for (int mi = 0; mi < 2; ++mi)
#pragma unroll
        for (int n = 0; n < 4; ++n) { const int sc = ng * 64 + n * 16 + sl; const int os = j * 128 + sc;
#pragma unroll
          for (int r = 0; r < 4; ++r) { const int t = mg * 32 + mi * 16 + 4 * lq + r; const int df = i * 128 + t - os;
            float w = 0.f; if (df >= 0) w += __expf(lgf * (float)df); if (df <= 0) w += __expf(-lgb * (float)df);
            *(LAS u16*)(sKP + t * 272 + sc * 2) = f2bf(accS[mi * 4 + n][r] * w); } }
#pragma unroll 1
      for (int s4 = 0; s4 < 4; ++s4) {
        LDS_BAR();
#pragma unroll
        for (int q = 0; q < 4; ++q) *(LAS u32x4*)(sV + dV + q * VD) = pf[q];
        { const u16* src = s4 < 3 ? vbase + (size_t)(j * 128 + (s4 + 1) * 32) * 2048 : (j < 3 ? kbase + (size_t)(j + 1) * 128 * 2048 : rbase0); const int qs = s4 < 3 ? VQ : (j < 3 ? KQ : RQ);
#pragma unroll
          for (int q = 0; q < 4; ++q) pf[q] = *(const u32x4*)(src + q * qs); }
        LDS_BAR();
        const bf16x8 a0 = frag_row(sKP, 272, mg * 32, s4 * 32, lane), a1 = frag_row(sKP, 272, mg * 32 + 16, s4 * 32, lane);
#define FR_(n) frag_tr(sV, 1040, ng * 256 + (n) * 16, 0, lane)
        SWEEP2(16, 2, FR_, a0, a1, acc, 16);
#undef FR_
      }
    }
#pragma unroll 1
    for (int dir = 0; dir < 2; ++dir) {
      const int off = i * 128 + mg * 32 + sl;
      const float xi0 = dir ? __expf(lgb * (float)(512 - off)) : __expf(lgf * (float)(off + 1));
      const float xi1 = dir ? __expf(lgb * (float)(496 - off)) : __expf(lgf * (float)(off + 17));
#pragma unroll 1
      for (int ds = 0; ds < 8; ++ds) {
        LDS_BAR();
#pragma unroll
        for (int q = 0; q < 4; ++q) *(LAS u32x4*)(sV + dR + q * RD) = pf[q];
        if (ds < 7 || dir == 0) { const u16* src = ds < 7 ? (dir ? rbase1 : rbase0) + (ds + 1) * 32 : rbase1;
#pragma unroll
          for (int q = 0; q < 4; ++q) pf[q] = *(const u32x4*)(src + q * RQ); }
        LDS_BAR();
        const bf16x8 a0 = scale_frag(frag_row(sQ, 528, mg * 32, ds * 32, lane), xi0), a1 = scale_frag(frag_row(sQ, 528, mg * 32 + 16, ds * 32, lane), xi1);
#define FR_(n) frag_row(sV, 80, ng * 256 + (n) * 16, 0, lane)
        SWEEP2(16, 2, FR_, a0, a1, acc, 16);
#undef FR_
      }
    }
#undef kbase
#undef vbase
#undef rbase0
#undef rbase1
    LDS_BAR();
    LAS float* sst = (LAS float*)sKP;
#pragma unroll
    for (int mi = 0; mi < 2; ++mi)
#pragma unroll
      for (int r = 0; r < 4; ++r) { float sm = 0.f;
#pragma unroll
        for (int n = 0; n < 16; ++n) sm += acc[mi * 16 + n][r];
        sm = red16l(sm, lane);
        if (sl == 0) sst[ng * 128 + mg * 32 + mi * 16 + 4 * lq + r] = sm; }
    LDS_BAR();
#pragma unroll
    for (int mi = 0; mi < 2; ++mi)
#pragma unroll
      for (int r = 0; r < 4; ++r) { const int t = mg * 32 + mi * 16 + 4 * lq + r; const float mu = (sst[t] + sst[128 + t]) * (1.f / 512.f); float v = 0.f;
#pragma unroll
        for (int n = 0; n < 16; ++n) { const float d = acc[mi * 16 + n][r] - mu; v += d * d; }
        v = red16l(v, lane);
        if (sl == 0) sst[256 + ng * 128 + t] = v; }
    LDS_BAR();
#pragma unroll
    for (int mi = 0; mi < 2; ++mi)
#pragma unroll
      for (int r = 0; r < 4; ++r) { const int t = mg * 32 + mi * 16 + 4 * lq + r; const float mu = (sst[t] + sst[128 + t]) * (1.f / 512.f);
        const float rstd = rsqrtf((sst[256 + t] + sst[384 + t]) * (1.f / 512.f) + 1e-6f);
        const size_t row = rowb + i * 128 + t;
#pragma unroll
        for (int n = 0; n < 16; ++n) { const int e = h * 512 + ng * 256 + n * 16 + sl; c.y[row * 2048 + e] = f2bf((acc[mi * 16 + n][r] - mu) * rstd * c.r_norm_g[e]); } }
    LDS_BAR();
  }
}

#define XB_TMO      128
#define XB_XCNT(j)  (256  + 64 * (j))
#define XB_XSUB(j)  (1280 + 64 * (j))
#define XB_XGEN(j)  (2304 + 64 * (j))
#define XB_TOP      3328
#define XB_TOPGEN   3392
#define XCD_BAR_WORDS 3456
#define XB_SPIN_CAP (1u << 18)
__device__ __forceinline__ unsigned xb_ld(unsigned* p)              { return __hip_atomic_load(p, __ATOMIC_RELAXED, __HIP_MEMORY_SCOPE_AGENT); }
__device__ __forceinline__ unsigned xb_add(unsigned* p, unsigned v) { return __hip_atomic_fetch_add(p, v, __ATOMIC_RELAXED, __HIP_MEMORY_SCOPE_AGENT); }
__device__ __forceinline__ unsigned xb_xcc_id() { return (unsigned)__builtin_amdgcn_s_getreg((3 << 11) | 20) & 0xFu; }
#define XB_SPIN(cond, bar) do { unsigned _sp = 0; while (cond) { __builtin_amdgcn_s_sleep(1); \
    if ((++_sp & 255u) == 0u) { if (xb_ld(&(bar)[XB_TMO])) break; if (_sp > XB_SPIN_CAP) { atomicAdd(&(bar)[XB_TMO], 1u); break; } } } } while (0)
struct XcdBarrier { unsigned* bar; unsigned x; volatile LAS unsigned* st; };
__device__ __forceinline__ XcdBarrier xcd_barrier_post(unsigned* bar, volatile LAS unsigned* st) {
    XcdBarrier b; b.bar = bar; b.x = xb_xcc_id(); b.st = st;
    if (threadIdx.x == 0) (void)xb_add(&bar[XB_XCNT(b.x)], 1u);
    return b;
}
__device__ __forceinline__ void xcd_barrier_complete(unsigned* bar, unsigned x, unsigned& nloc, unsigned& nx) {
    const unsigned G = gridDim.x * gridDim.y * gridDim.z;
    unsigned sum, cnt, mine, sp = 0u;
    for (;;) {
        sum = 0u; cnt = 0u; mine = 0u;
#pragma unroll
        for (unsigned j = 0; j < 16; ++j) { const unsigned c = xb_ld(&bar[XB_XCNT(j)]); sum += c; cnt += (c > 0u) ? 1u : 0u; mine = (j == x) ? c : mine; }
        if (sum == G) break;
        __builtin_amdgcn_s_sleep(1);
        if ((++sp & 255u) == 0u) { if (xb_ld(&bar[XB_TMO])) break; if (sp > XB_SPIN_CAP) { atomicAdd(&bar[XB_TMO], 1u); break; } }
    }
    nloc = mine > 0u ? mine : 1u; nx = cnt > 0u ? cnt : 1u;
}
__device__ __forceinline__ void xcd_barrier(const XcdBarrier& b, int wv) {
    asm volatile("s_waitcnt vmcnt(0)" ::: "memory");
    __syncthreads();
    int lno; asm volatile("v_mbcnt_lo_u32_b32 %0, -1, 0\n\tv_mbcnt_hi_u32_b32 %0, -1, %0" : "=v"(lno));
    if (wv == 0 && lno == 0) {
        unsigned* bar = b.bar;
        __builtin_amdgcn_s_waitcnt(0);
        unsigned nloc = b.st[0], nx = b.st[1];
        if (nloc == 0u) { xcd_barrier_complete(bar, b.x, nloc, nx); b.st[0] = nloc; b.st[1] = nx; }
        const unsigned old = xb_add(&bar[XB_XSUB(b.x)], 1u);
        const unsigned gen = old / nloc;
        if (old + 1u == (gen + 1u) * nloc) {
            __builtin_amdgcn_fence(__ATOMIC_RELEASE, "agent");
            asm volatile("s_waitcnt vmcnt(0)" ::: "memory");
            const unsigned og = xb_add(&bar[XB_TOP], 1u);
            const unsigned tg = og / nx;
            if (og + 1u == (tg + 1u) * nx) xb_add(&bar[XB_TOPGEN], 1u);
            else XB_SPIN(xb_ld(&bar[XB_TOPGEN]) == tg, bar);
            __builtin_amdgcn_fence(__ATOMIC_ACQUIRE, "agent");
            xb_add(&bar[XB_XGEN(b.x)], 1u);
            asm volatile("s_waitcnt vmcnt(0)" ::: "memory");
        } else {
            XB_SPIN(xb_ld(&bar[XB_XGEN(b.x)]) == gen, bar);
            __builtin_amdgcn_fence(__ATOMIC_ACQUIRE, "agent");
            asm volatile("s_waitcnt vmcnt(0)" ::: "memory");
        }
    }
    __syncthreads();
}

__global__ void __launch_bounds__(512) fwd_megakernel(Params p) {
  extern __shared__ __attribute__((aligned(16))) unsigned char shm[];
  ldsp lds = (ldsp)shm;
  cg::grid_group grid = cg::this_grid();
  const int wv = __builtin_amdgcn_readfirstlane((int)(threadIdx.x >> 6));
  volatile LAS unsigned* xst = (volatile LAS unsigned*)(lds + LDS_BYTES - 16);
  if (threadIdx.x == 0) { xst[0] = 0u; xst[1] = 0u; }
  __syncthreads();
  const XcdBarrier xb = xcd_barrier_post(p.c.bar, xst);
#pragma unroll 1
  for (int pi = 0; pi < p.nph; ++pi) {
    const Phase& ph = p.ph[pi];
    switch (ph.type) {
      case PH_INIT:
#ifndef NO_INIT
      phase_init(wv, lds, p.c);
#endif
      break;
      case PH_NORM:
#ifndef NO_NORM
      phase_norm(wv, lds, ph, p.c);
#endif
      break;
      case PH_GEMM:
#ifndef NO_GEMM
      gemm_phase(wv, lds, ph, p.c);
#endif
      break;
      case PH_MCONV:
#ifndef NO_MCONV
      phase_mconv(wv, p.c);
#endif
      break;
      case PH_MA:
#ifndef NO_MA
      phase_ma(wv, lds, p.c);
#endif
      break;
      case PH_MB:
#ifndef NO_MB
      phase_mb(wv, p.c);
#endif
      break;
      case PH_MC:
#ifndef NO_MC
      phase_mc(wv, lds, p.c);
#endif
      break;
      case PH_RA:
#ifndef NO_RA
      phase_ra(wv, lds, ph, p.c);
#endif
      break;
      case PH_RB:
#ifndef NO_RB
      phase_rb(wv, ph, p.c);
#endif
      break;
      case PH_RC:
#ifndef NO_RC
      phase_rc(wv, lds, ph, p.c);
#endif
      break;
      case PH_FINAL: phase_final(wv, p.c); break;
      default: break;
    }
    if (pi == 0) grid.sync(); else xcd_barrier(xb, wv);
  }
}

static void add_phase(Params& P, int type, int M, int N, int K, int i0, int i1, float f0, int pad, const void* A, const void* B, void* O, const void* X) {
  const int reps = (((DUP_TYPES >> type) & 1u) && (type != PH_GEMM || ((DUP_EPIS >> i0) & 1u))) ? 2 : 1;
  for (int rep = 0; rep < reps; ++rep) {
  Phase& ph = P.ph[P.nph++]; ph.type = type; ph.M = M; ph.N = N; ph.K = K; ph.i0 = i0; ph.i1 = i1; ph.f0 = f0; ph.pad = pad; ph.A = A; ph.B = B; ph.O = O; ph.X = X;
  }
}

extern "C" void kernel_launch(void* const* d_in, const int* in_sizes, int n_in, void* d_out, int out_size, void* d_ws, size_t ws_size, hipStream_t stream) {
  static int grid_blocks = 0;
  if (!grid_blocks) {
    int dev = 0, cus = 0, per_cu = 0;
    hipGetDevice(&dev);
    hipDeviceGetAttribute(&cus, hipDeviceAttributeMultiprocessorCount, dev);
    hipFuncSetAttribute((const void*)fwd_megakernel, hipFuncAttributeMaxDynamicSharedMemorySize, LDS_BYTES);
    hipOccupancyMaxActiveBlocksPerMultiprocessor(&per_cu, (const void*)fwd_megakernel, 512, LDS_BYTES);
    if (per_cu < 1) per_cu = 1;
    grid_blocks = cus * per_cu;
  }
  Params P; memset(&P, 0, sizeof(P));
  Ctx& c = P.c;
  c.x = (const float*)d_in[0]; c.c = (const float*)d_in[1]; c.ctx = (const float*)d_in[2]; c.c_ctx = (const float*)d_in[3];
  c.mod_w = (const float*)d_in[4]; c.mod_b = (const float*)d_in[5]; c.norm_g = (const float*)d_in[6]; c.w13 = (const float*)d_in[7]; c.w2 = (const float*)d_in[8];
  c.m_w_in = (const float*)d_in[9]; c.m_gate_b = (const float*)d_in[10]; c.m_conv_w = (const float*)d_in[11]; c.m_norm_g = (const float*)d_in[12]; c.m_w_out = (const float*)d_in[13];
  c.r_w_in = (const float*)d_in[14]; c.r_decay = (const float*)d_in[15]; c.r_norm_g = (const float*)d_in[16]; c.r_w_out = (const float*)d_in[17]; c.final_g = (const float*)d_in[18];
  c.out = (float*)d_out; c.y = (u16*)d_out;
  char* w = (char*)d_ws; size_t off = 0;
  auto take = [&](size_t bytes) { char* r = w + off; off += (bytes + 255) & ~(size_t)255; return r; };
  c.bar = (unsigned*)take((size_t)XCD_BAR_WORDS * 4);
  c.modv = (float*)take((size_t)2 * 5 * 9216 * 4);
  c.rope = (float*)take((size_t)8192 * 128 * 8);
  c.gates = (float*)take((size_t)NT * 32 * 4);
  c.mst_n = (float*)take((size_t)64 * 66 * 64 * 4);
  c.mst_s = (float*)take((size_t)3 * 4224 * 4);
  c.xr = (float*)take((size_t)NT * 1024 * 4);
  c.hb = (u16*)take((size_t)NT * 1024 * 2);
  c.wb = (u16*)take((size_t)(5632 + 2816) * 1024 * 2);
  c.big = (u16*)take((size_t)NT * 3072 * 2 + (size_t)64 * 66 * 8192 * 2);
  c.part = (float*)((char*)c.big + (size_t)NT * 2816 * 2);
  c.part2 = (float*)take((size_t)4 * 1024 * 1024 * 4);
  if (off > ws_size) { fprintf(stderr, "workspace too small: need %zu have %zu\n", off, ws_size); return; }
  u16* hid = c.big;
  for (int l = 0; l < 2; ++l) {
    if (l == 0) add_phase(P, PH_INIT, 0, 0, 0, 0, 0, 0.f, 0, nullptr, nullptr, nullptr, nullptr);
    const float* modl = c.modv + (size_t)l * 5 * 9216;
    add_phase(P, PH_NORM, NT, l == 0 ? 1 : (NSPL << 8), 0, l, 0, 0.5f, 0, nullptr, nullptr, nullptr, c.modv + 8 * 1024);
    add_phase(P, PH_GEMM, NT, 5632, 1024, EPI_SWIGLU, 0, 0.f, 0, c.hb, c.wb, hid, nullptr);
    add_phase(P, PH_GEMM, NT, 1024, 2816, EPI_RESID, 8 | SPLITF | (l == 0 ? 2 : 0), 0.5f, 0, hid, c.wb + (size_t)5632 * 1024, c.xr, modl + 2 * 1024);
    if (l == 0) {
      add_phase(P, PH_NORM, NT, NSPL << 8, 0, l, 1, 0.5f, 1, nullptr, nullptr, nullptr, modl + 2 * 1024);
      add_phase(P, PH_GEMM, NT, 3328, 1024, EPI_MLSTM_U, 0, 0.f, 0, c.hb, c.wb, c.big, nullptr);
      add_phase(P, PH_MCONV, 0, 0, 0, 0, 0, 0.f, 0, nullptr, nullptr, nullptr, nullptr);
      add_phase(P, PH_MA, 0, 0, 0, 0, 0, 0.f, 0, nullptr, nullptr, nullptr, nullptr);
      add_phase(P, PH_MB, 0, 0, 0, 0, 0, 0.f, 0, nullptr, nullptr, nullptr, nullptr);
      add_phase(P, PH_MC, 0, 0, 0, 0, 0, 0.f, 0, nullptr, nullptr, nullptr, nullptr);
      add_phase(P, PH_GEMM, NT, 1024, 1024, EPI_RESID, 1 | 4, 1.0f, 0, c.y, c.wb + (size_t)3328 * 1024, c.xr, modl + 5 * 1024);
    } else {
      add_phase(P, PH_NORM, NT, NSPL << 8, 0, l, 1, 0.5f, 2, nullptr, nullptr, nullptr, modl + 2 * 1024);
      for (int hp = 0; hp < 2; ++hp) {
        add_phase(P, PH_GEMM, NT, 2048, 1024, EPI_RET_U, 0, 0.f, 0, c.hb, c.wb + (size_t)hp * 2048 * 1024, c.big, nullptr);
        add_phase(P, PH_RA, 0, 0, 0, hp, 0, 0.f, 0, nullptr, nullptr, nullptr, nullptr);
        add_phase(P, PH_RB, 0, 0, 0, hp, 0, 0.f, 0, nullptr, nullptr, nullptr, nullptr);
        add_phase(P, PH_RC, 0, 0, 0, hp, 0, 0.f, 0, nullptr, nullptr, nullptr, nullptr);
      }
      add_phase(P, PH_GEMM, NL, 2048, 1024, EPI_GATE, 0, 0.f, 0, c.hb, c.wb + (size_t)4096 * 1024, c.y, nullptr);
      add_phase(P, PH_GEMM, NL, 1024, 2048, EPI_RESID, 0, 1.0f, 0, c.y, c.wb + (size_t)6144 * 1024, c.xr, modl + 5 * 1024);
    }
    const int M2 = l == 1 ? NL : NT;
    add_phase(P, PH_NORM, M2, l == 0 ? ((4 << 8) | 2) : 0, 1, l, 2, 1.0f, 0, nullptr, nullptr, nullptr, modl + 5 * 1024);
    add_phase(P, PH_GEMM, M2, 5632, 1024, EPI_SWIGLU, 0, 0.f, 0, c.hb, c.wb, hid, nullptr);
    add_phase(P, PH_GEMM, M2, 1024, 2816, EPI_RESID, 8 | (l == 0 ? SPLITF : 0), 0.5f, 0, hid, c.wb + (size_t)5632 * 1024, c.xr, modl + 8 * 1024);
  }
#ifdef EXTRA_NOPS
  for (int q = 0; q < EXTRA_NOPS; ++q) add_phase(P, PH_NOP, 0, 0, 0, 0, 0, 0.f, 0, nullptr, nullptr, nullptr, nullptr);
#endif
  add_phase(P, PH_FINAL, 0, 0, 0, 0, 0, 0.f, 0, nullptr, nullptr, nullptr, nullptr);
  hipMemsetAsync(c.bar, 0, (size_t)XCD_BAR_WORDS * 4, stream);
  void* args[] = {&P};
  hipError_t e = hipLaunchCooperativeKernel((const void*)fwd_megakernel, dim3(grid_blocks), dim3(512), args, LDS_BYTES, stream);
  if (e != hipSuccess) fprintf(stderr, "cooperative launch failed: %s (grid %d)\n", hipGetErrorString(e), grid_blocks);
}
```

```cpp
#include <hip/hip_runtime.h>
#include <hip/hip_cooperative_groups.h>
#include <cstdio>
#include <cstring>
namespace cg = cooperative_groups;

typedef unsigned short u16;
typedef short bf16x8 __attribute__((ext_vector_type(8)));
typedef short s16x4 __attribute__((ext_vector_type(4)));
typedef float f32x4 __attribute__((ext_vector_type(4)));
typedef unsigned u32x4 __attribute__((ext_vector_type(4)));
typedef unsigned u32x2 __attribute__((ext_vector_type(2)));
#define LAS __attribute__((address_space(3)))
typedef LAS unsigned char* ldsp;

#define NT 33792
#define NL 32768
#define LDS_BYTES 155648

enum { PH_INIT = 0, PH_NORM, PH_GEMM, PH_MCONV, PH_MA, PH_MB, PH_MC, PH_RA, PH_RB, PH_RC, PH_FINAL, PH_NOP };
enum { EPI_SWIGLU = 0, EPI_RESID, EPI_MLSTM_U, EPI_RET_U, EPI_GATE };

struct Phase { int type, M, N, K; int i0, i1; float f0; int pad; const void* A; const void* B; void* O; const void* X; };
#define MAXPH 56
#ifndef SPLITF
#define SPLITF 1
#endif
#define NSPL (SPLITF ? 11 : 0)
#ifndef DUP_TYPES
#define DUP_TYPES 0u
#endif
#ifndef DUP_EPIS
#define DUP_EPIS 0u
#endif
struct Ctx {
  const float *x, *c, *ctx, *c_ctx, *mod_w, *mod_b, *norm_g, *w13, *w2, *m_w_in, *m_gate_b, *m_conv_w, *m_norm_g, *m_w_out, *r_w_in, *r_decay, *r_norm_g, *r_w_out, *final_g;
  float* out; float* modv; float* rope; float* gates; float* mst_n; float* mst_s; float* xr;
  u16* hb; u16* wb; u16* big; u16* y; unsigned* bar; float* part; float* part2;
};
struct Params { Ctx c; int nph; int pad; Phase ph[MAXPH]; };

typedef __bf16 bf16x2_t __attribute__((ext_vector_type(2)));
__device__ __forceinline__ u16 f2bf(float f) { return __builtin_bit_cast(u16, (__bf16)f); }
__device__ __forceinline__ float bf2f(u16 b) { return __uint_as_float(((unsigned)b) << 16); }
__device__ __forceinline__ unsigned pack2(float a, float b) { bf16x2_t v; v[0] = (__bf16)a; v[1] = (__bf16)b; return __builtin_bit_cast(unsigned, v); }
__device__ __forceinline__ float lo2f(unsigned w) { return __uint_as_float(w << 16); }
__device__ __forceinline__ float hi2f(unsigned w) { return __uint_as_float(w & 0xffff0000u); }
__device__ __forceinline__ float4 ldnt4(const float4* p) { const f32x4 v = __builtin_nontemporal_load((const f32x4*)p); return make_float4(v[0], v[1], v[2], v[3]); }
__device__ __forceinline__ void stnt4(float4* p, float4 v) { f32x4 t; t[0] = v.x; t[1] = v.y; t[2] = v.z; t[3] = v.w; __builtin_nontemporal_store(t, (f32x4*)p); }
__device__ __forceinline__ float siluf(float a) { return a * __builtin_amdgcn_rcpf(1.f + __expf(-a)); }
__device__ __forceinline__ float sigmf(float a) { return __builtin_amdgcn_rcpf(1.f + __expf(-a)); }
__device__ __forceinline__ float logsig(float a) { return fminf(a, 0.f) - log1pf(expf(-fabsf(a))); }

__device__ __forceinline__ bf16x8 frag_row(ldsp base, int pitch, int idx0, int k0, int lane) {
  return *(const LAS bf16x8*)(base + (idx0 + (lane & 15)) * pitch + (k0 + 8 * (lane >> 4)) * 2);
}
__device__ __forceinline__ bf16x8 frag_tr(ldsp base, int pitch, int idx0, int k0, int lane) {
  const int g = lane >> 4, li = lane & 15, q = li >> 2, p = li & 3;
  ldsp a = base + (k0 + 8 * g + q) * pitch + (idx0 + 4 * p) * 2;
  s16x4 lo = __builtin_amdgcn_ds_read_tr16_b64_v4i16((LAS s16x4*)a);
  s16x4 hi = __builtin_amdgcn_ds_read_tr16_b64_v4i16((LAS s16x4*)(a + 4 * pitch));
  bf16x8 r; r[0] = lo[0]; r[1] = lo[1]; r[2] = lo[2]; r[3] = lo[3]; r[4] = hi[0]; r[5] = hi[1]; r[6] = hi[2]; r[7] = hi[3]; return r;
}
#define LDS_BAR() do { asm volatile("s_waitcnt lgkmcnt(0)" ::: "memory"); __builtin_amdgcn_s_barrier(); asm volatile("" ::: "memory"); } while (0)
#define SWEEP(NT, DEPTH, FRAG, A, ACC) do { bf16x8 bq_[DEPTH]; \
    _Pragma("unroll") for (int n_ = 0; n_ < DEPTH; ++n_) bq_[n_] = FRAG(n_); __builtin_amdgcn_sched_barrier(0); \
    _Pragma("unroll") for (int n_ = 0; n_ < NT; ++n_) { const bf16x8 cur_ = bq_[n_ % DEPTH]; if (n_ + DEPTH < NT) bq_[n_ % DEPTH] = FRAG(n_ + DEPTH); ACC[n_] = MFMA16(A, cur_, ACC[n_]); __builtin_amdgcn_sched_barrier(0); } } while (0)
#define MFMA16(a, b, c) __builtin_amdgcn_mfma_f32_16x16x32_bf16((a), (b), (c), 0, 0, 0)
__device__ __forceinline__ float shx(float v, int m, int lane) { return __int_as_float(__builtin_amdgcn_ds_bpermute((lane ^ m) << 2, __float_as_int(v))); }
__device__ __forceinline__ float shup(float v, int d, int lane, float ident) { const int src = lane - d; const float r = __int_as_float(__builtin_amdgcn_ds_bpermute(src << 2, __float_as_int(v))); return src >= 0 ? r : ident; }
__device__ __forceinline__ float shdn(float v, int d, int lane, float ident) { const int src = lane + d; const float r = __int_as_float(__builtin_amdgcn_ds_bpermute(src << 2, __float_as_int(v))); return src < 64 ? r : ident; }
__device__ __forceinline__ float lane63(float v) { return __int_as_float(__builtin_amdgcn_readlane(__float_as_int(v), 63)); }
__device__ __forceinline__ float red16l(float v, int lane) { v += shx(v, 1, lane); v += shx(v, 2, lane); v += shx(v, 4, lane); v += shx(v, 8, lane); return v; }

namespace pg8 {
constexpr int BM = 256, BK = 64, HALF = 128, HTB = HALF * BK * 2, NXCD = 8, WGM = 8;
__device__ __forceinline__ int lds_byte(int r, int c) { const int st = (r >> 4) * 2 + (c >> 5), rr = r & 15, cc = c & 31, ob = rr * 64 + cc * 2; return st * 1024 + (ob ^ (((ob >> 9) & 1) << 5)); }
__device__ __forceinline__ void stage_rc(int b, int& R, int& C) { const int st = b / 1024, sb = b % 1024, swz = sb ^ (((sb >> 9) & 1) << 5); R = (st >> 1) * 16 + swz / 64; C = (st & 1) * 32 + (swz % 64) / 2; }
struct Unit { int pm, pn, k0, nt, at; };
struct StaticOrder {
  int nM, nN, nwg, G, c, nsplit, nsu, ntf;
  __device__ void init(int M, int N, int K, int split, int G_, int c_) { nM = M / BM; nN = N / BM; nsplit = 0; nsu = 0; ntf = K / BK;
    if (split) { nM = NL / BM; nsplit = K / 256; nsu = (M / BM - nM) * nN * nsplit; }
    nwg = nM * nN; G = G_; c = c_; }
  __device__ bool next(int i, Unit& u) const {
    const long L = (long)i * G + c;
    int pm = 0, pn = 0, k0 = 0, nt = ntf, at = 0; bool ok = true;
    if (L >= nwg) {
      const long s = L - nwg;
      if (s >= nsu) ok = false;
      else { const int ks = (int)(s % nsplit), r = (int)(s / nsplit); pn = r % nN; pm = nM + r / nN; k0 = ks * 256; nt = 4; at = ks + 1; }
    } else {
      int wgid = (int)L; { const int q = nwg / NXCD, r = nwg % NXCD, xcd = wgid % NXCD, off = wgid / NXCD; wgid = (xcd < r ? xcd * (q + 1) : r * (q + 1) + (xcd - r) * q) + off; }
      const int nig = WGM * nN, gid = wgid / nig, fm = gid * WGM, gsz = (nM - fm) < WGM ? (nM - fm) : WGM;
      pm = fm + ((wgid % nig) % gsz); pn = (wgid % nig) / gsz;
    }
    u.pm = pm; u.pn = pn; u.k0 = k0; u.nt = nt; u.at = at; return ok;
  }
};
}

__device__ __forceinline__ int perm32(int rho) { const int n = rho >> 4, i = rho & 15; return 8 * (i >> 2) + 4 * n + (i & 3); }
__device__ __forceinline__ void epi_apply(const Phase& ph, const Ctx& c, const f32x4 (&acc)[2][2][4][2], int pm, int pn, int at, int wr, int wc, int fr, int fq) {
  const int row0 = pm * 256 + wr * 64 + fr;
  const int epi = ph.i0;
  if (epi == EPI_SWIGLU) {
    u16* O = (u16*)ph.O;
    const int hc = pn * 128 + wc * 32 + fq * 8;
#pragma unroll
    for (int ai = 0; ai < 2; ++ai)
#pragma unroll
      for (int m = 0; m < 4; ++m) {
        const size_t row = row0 + ai * 128 + m * 16;
        const f32x4 a0 = acc[ai][0][m][0], b0 = acc[ai][1][m][0], a1 = acc[ai][0][m][1], b1 = acc[ai][1][m][1];
        u32x4 o; o.x = pack2(siluf(a0[0]) * b0[0], siluf(a0[1]) * b0[1]); o.y = pack2(siluf(a0[2]) * b0[2], siluf(a0[3]) * b0[3]);
        o.z = pack2(siluf(a1[0]) * b1[0], siluf(a1[1]) * b1[1]); o.w = pack2(siluf(a1[2]) * b1[2], siluf(a1[3]) * b1[3]);
        *(u32x4*)(O + row * 2816 + hc) = o;
      }
  } else if (epi == EPI_RESID) {
    float* X = (float*)ph.O; const float* gate = (const float*)ph.X; const float f0 = ph.f0;
    const int r256 = pm * 256; const int set = r256 < NL ? (r256 >> 13) : 4;
    const float* Xs = ((ph.i1 & 2) && r256 < NL) ? c.x : (const float*)X;
    gate += (size_t)set * 9216;
    if (at) {
      float* P = ((ph.i1 & 4) ? c.part2 : c.part) + ((size_t)(at - 1) * 1024 - NL) * 1024;
#pragma unroll
      for (int bj = 0; bj < 2; ++bj)
#pragma unroll
        for (int n = 0; n < 2; ++n) {
          const int col = pn * 256 + bj * 128 + wc * 32 + n * 16 + fq * 4;
#pragma unroll
          for (int ai = 0; ai < 2; ++ai)
#pragma unroll
            for (int m = 0; m < 4; ++m) { const size_t row = row0 + ai * 128 + m * 16; *(f32x4*)(P + row * 1024 + col) = acc[ai][bj][m][n]; }
        }
    } else {
#pragma unroll
      for (int bj = 0; bj < 2; ++bj)
#pragma unroll
        for (int n = 0; n < 2; ++n) {
          const int col = pn * 256 + bj * 128 + wc * 32 + n * 16 + fq * 4;
          const f32x4 g = *(const f32x4*)(gate + col);
#pragma unroll
          for (int ai = 0; ai < 2; ++ai)
#pragma unroll
            for (int m = 0; m < 4; ++m) {
              const size_t row = row0 + ai * 128 + m * 16;
              f32x4 xv = *(const f32x4*)(Xs + row * 1024 + col); const f32x4 a = acc[ai][bj][m][n];
              xv[0] += f0 * g[0] * a[0]; xv[1] += f0 * g[1] * a[1]; xv[2] += f0 * g[2] * a[2]; xv[3] += f0 * g[3] * a[3];
              *(f32x4*)(X + row * 1024 + col) = xv;
            }
        }
    }
  } else if (epi == EPI_MLSTM_U) {
    if (pn < 12) {
      u16* O = (u16*)ph.O;
#pragma unroll
      for (int ai = 0; ai < 2; ++ai)
#pragma unroll
        for (int m = 0; m < 4; ++m) {
          const size_t row = row0 + ai * 128 + m * 16;
#pragma unroll
          for (int bj = 0; bj < 2; ++bj) {
            const int col = pn * 256 + bj * 128 + wc * 32 + fq * 8; const f32x4 a0 = acc[ai][bj][m][0], a1 = acc[ai][bj][m][1];
            u32x4 o; o.x = pack2(a0[0], a0[1]); o.y = pack2(a0[2], a0[3]); o.z = pack2(a1[0], a1[1]); o.w = pack2(a1[2], a1[3]);
            *(u32x4*)(O + row * 3072 + col) = o;
          }
        }
    } else if (wc == 0) {
      float* G = c.gates; const float* gb = c.m_gate_b;
#pragma unroll
      for (int n = 0; n < 2; ++n) {
        const int col = fq * 8 + n * 4; const f32x4 b = *(const f32x4*)(gb + col);
#pragma unroll
        for (int ai = 0; ai < 2; ++ai)
#pragma unroll
          for (int m = 0; m < 4; ++m) {
            const size_t row = row0 + ai * 128 + m * 16; const f32x4 a = acc[ai][0][m][n];
            f32x4 o; o[0] = a[0] + b[0]; o[1] = a[1] + b[1]; o[2] = a[2] + b[2]; o[3] = a[3] + b[3];
            *(f32x4*)(G + row * 32 + col) = o;
          }
      }
    }
  } else if (epi == EPI_RET_U) {
    u16* O = (u16*)ph.O; const float* rope = c.rope;
    const bool dorope = (pn < 4) && (pm * 256 < NL);
#pragma unroll
    for (int ai = 0; ai < 2; ++ai)
#pragma unroll
      for (int m = 0; m < 4; ++m) {
        const size_t row = row0 + ai * 128 + m * 16; const int t = (int)(row & 8191);
#pragma unroll
        for (int bj = 0; bj < 2; ++bj) {
          const int col = pn * 256 + bj * 128 + wc * 32 + fq * 8; f32x4 a0 = acc[ai][bj][m][0], a1 = acc[ai][bj][m][1];
          if (dorope) {
            const int p0 = (col & 255) >> 1;
            const f32x4 c0 = *(const f32x4*)(rope + ((size_t)t * 128 + p0) * 2), c1 = *(const f32x4*)(rope + ((size_t)t * 128 + p0) * 2 + 4);
            const float e0 = a0[0] * c0[0] - a0[1] * c0[1], o0 = a0[0] * c0[1] + a0[1] * c0[0];
            const float e1 = a0[2] * c0[2] - a0[3] * c0[3], o1 = a0[2] * c0[3] + a0[3] * c0[2];
            const float e2 = a1[0] * c1[0] - a1[1] * c1[1], o2 = a1[0] * c1[1] + a1[1] * c1[0];
            const float e3 = a1[2] * c1[2] - a1[3] * c1[3], o3 = a1[2] * c1[3] + a1[3] * c1[2];
            a0[0] = e0; a0[1] = o0; a0[2] = e1; a0[3] = o1; a1[0] = e2; a1[1] = o2; a1[2] = e3; a1[3] = o3;
          }
          u32x4 o; o.x = pack2(a0[0], a0[1]); o.y = pack2(a0[2], a0[3]); o.z = pack2(a1[0], a1[1]); o.w = pack2(a1[2], a1[3]);
          *(u32x4*)(O + row * 2048 + col) = o;
        }
      }
  } else {
    u16* O = (u16*)ph.O;
#pragma unroll
    for (int ai = 0; ai < 2; ++ai)
#pragma unroll
      for (int m = 0; m < 4; ++m) {
        const size_t row = row0 + ai * 128 + m * 16;
#pragma unroll
        for (int bj = 0; bj < 2; ++bj) {
          const int col = pn * 256 + bj * 128 + wc * 32 + fq * 8; const f32x4 a0 = acc[ai][bj][m][0], a1 = acc[ai][bj][m][1];
          u32x4* yp = (u32x4*)(O + row * 2048 + col); u32x4 yv = *yp;
          yv.x = pack2(lo2f(yv.x) * siluf(a0[0]), hi2f(yv.x) * siluf(a0[1])); yv.y = pack2(lo2f(yv.y) * siluf(a0[2]), hi2f(yv.y) * siluf(a0[3]));
          yv.z = pack2(lo2f(yv.z) * siluf(a1[0]), hi2f(yv.z) * siluf(a1[1])); yv.w = pack2(lo2f(yv.w) * siluf(a1[2]), hi2f(yv.w) * siluf(a1[3]));
          *yp = yv;
        }
      }
  }
}

__device__ __forceinline__ void gemm_phase(int wv, ldsp lds, const Phase& ph, const Ctx& c) {
  using namespace pg8;
  int wvo = wv; asm volatile("" : "+s"(wvo)); int lno; asm volatile("v_mbcnt_lo_u32_b32 %0, -1, 0\n\tv_mbcnt_hi_u32_b32 %0, -1, %0" : "=v"(lno)); int tid = (wvo << 6) | lno; const int wid = __builtin_amdgcn_readfirstlane(tid >> 6), lane = tid & 63, wr = wid >> 2, wc = wid & 3, fr = lane & 15, fq = lane >> 4;
  const int K = ph.K;
  StaticOrder S; S.init(ph.M, ph.N, ph.K, ph.i1 & 1, gridDim.x, blockIdx.x);
  unsigned voffA[2];
#pragma unroll
  for (int i = 0; i < 2; ++i) { int R, C; stage_rc(tid * 16 + i * 8192, R, C); voffA[i] = (unsigned)(R * K + C) * 2u; }
  const size_t kstep = (size_t)(BK * 2);
  const size_t hstep = (size_t)HALF * K * 2;
  const size_t tstep = 2 * hstep;
  const unsigned ldsw = (unsigned)wid * 1024u;
  const int aoff = lds_byte(wr * 64 + fr, fq * 8), boff = lds_byte(wc * 32 + fr, fq * 8);
#define PG8_SA(b, h) (((b) * 2 + (h)) * HTB)
#define PG8_SB(b, h) ((4 + (b) * 2 + (h)) * HTB)
#define PG8_STAGE(bufoff, gbase, voff) do { _Pragma("unroll") for (int _i = 0; _i < 2; ++_i) \
    __builtin_amdgcn_global_load_lds((const unsigned*)((const char*)(gbase) + (voff)[_i]), (LAS unsigned*)(lds + (bufoff) + ldsw + _i * 8192), 16, 0, 0); } while (0)
#define PG8_LDA(dst, b, h) do { _Pragma("unroll") for (int m = 0; m < 4; ++m) _Pragma("unroll") for (int k = 0; k < 2; ++k) dst[m][k] = *(const LAS bf16x8*)(lds + PG8_SA(b, h) + aoff + m * 2048 + k * 1024); } while (0)
#define PG8_LDB(dst, b, h) do { _Pragma("unroll") for (int n = 0; n < 2; ++n) _Pragma("unroll") for (int k = 0; k < 2; ++k) dst[n][k] = *(const LAS bf16x8*)(lds + PG8_SB(b, h) + boff + n * 2048 + k * 1024); } while (0)
#define PG8_MMA(ai, bj, At, Bt) do { __builtin_amdgcn_s_setprio(1); _Pragma("unroll") for (int m = 0; m < 4; ++m) _Pragma("unroll") for (int n = 0; n < 2; ++n) _Pragma("unroll") for (int k = 0; k < 2; ++k) \
    acc[ai][bj][m][n] = __builtin_amdgcn_mfma_f32_16x16x32_bf16(Bt[n][k], At[m][k], acc[ai][bj][m][n], 0, 0, 0); __builtin_amdgcn_s_setprio(0); } while (0)
#define PG8_WAIT_V(n) asm volatile("s_waitcnt vmcnt(" #n ")" ::: "memory")
#define PG8_WAIT_L(n) asm volatile("s_waitcnt lgkmcnt(" #n ")" ::: "memory")
#define PG8_BAR __builtin_amdgcn_s_barrier()
#define PG8_SCHED __builtin_amdgcn_sched_barrier(0)
  Unit cur, nxt; int ui = 0;
  if (!S.next(0, cur)) return;
  f32x4 acc[2][2][4][2];
#pragma unroll
  for (int a = 0; a < 2; ++a)
#pragma unroll
    for (int b = 0; b < 2; ++b)
#pragma unroll
      for (int m = 0; m < 4; ++m)
#pragma unroll
        for (int n = 0; n < 2; ++n) acc[a][b][m][n] = (f32x4){0.f, 0.f, 0.f, 0.f};
  bf16x8 At[4][2], B0[2][2], B1[2][2];
  const char* cA = (const char*)ph.A + (size_t)cur.pm * tstep + (size_t)cur.k0 * 2; const char* cB = (const char*)ph.B + (size_t)cur.pn * tstep + (size_t)cur.k0 * 2;
  PG8_STAGE(PG8_SB(0, 0), cB, voffA); PG8_STAGE(PG8_SA(0, 0), cA, voffA); PG8_STAGE(PG8_SB(0, 1), cB + hstep, voffA); PG8_STAGE(PG8_SA(0, 1), cA + hstep, voffA);
  if (wr == 1) PG8_BAR;
  PG8_WAIT_V(4); PG8_BAR;
  PG8_STAGE(PG8_SB(1, 0), cB + kstep, voffA); PG8_STAGE(PG8_SA(1, 0), cA + kstep, voffA); PG8_STAGE(PG8_SB(1, 1), cB + hstep + kstep, voffA);
  PG8_WAIT_V(6); PG8_BAR;
  for (;;) {
    const bool has_next = S.next(ui + 1, nxt);
    const char* nA = has_next ? (const char*)ph.A + (size_t)nxt.pm * tstep + (size_t)nxt.k0 * 2 : cA; const char* nB = has_next ? (const char*)ph.B + (size_t)nxt.pn * tstep + (size_t)nxt.k0 * 2 : cB;
    const int nt = cur.nt;
    for (int t = 0; t < nt; t += 2) {
      const bool last = (t == nt - 2);
      const char* a1 = cA + (size_t)(t + 1) * kstep;
      const char* a2 = last ? nA : cA + (size_t)(t + 2) * kstep; const char* b2 = last ? nB : cB + (size_t)(t + 2) * kstep;
      const char* a3 = a2 + kstep; const char* b3 = b2 + kstep;
      PG8_LDB(B0, 0, 0); PG8_SCHED; PG8_LDA(At, 0, 0); PG8_STAGE(PG8_SA(1, 1), a1 + hstep, voffA);
      PG8_WAIT_L(8); PG8_BAR; PG8_WAIT_L(0); PG8_MMA(0, 0, At, B0); PG8_BAR; PG8_SCHED;
      PG8_LDB(B1, 0, 1); PG8_STAGE(PG8_SB(0, 0), b2, voffA);
      PG8_BAR; PG8_WAIT_L(0); PG8_MMA(0, 1, At, B1); PG8_BAR;
      PG8_LDA(At, 0, 1); PG8_STAGE(PG8_SA(0, 0), a2, voffA);
      PG8_BAR; PG8_WAIT_L(0); PG8_MMA(1, 0, At, B0); PG8_BAR; PG8_SCHED;
      PG8_STAGE(PG8_SB(0, 1), b2 + hstep, voffA);
      PG8_WAIT_V(6); PG8_BAR; PG8_MMA(1, 1, At, B1); PG8_BAR;
      PG8_LDB(B0, 1, 0); PG8_SCHED; PG8_LDA(At, 1, 0); PG8_STAGE(PG8_SA(0, 1), a2 + hstep, voffA);
      PG8_WAIT_L(8); PG8_BAR; PG8_WAIT_L(0); PG8_MMA(0, 0, At, B0); PG8_BAR; PG8_SCHED;
      PG8_LDB(B1, 1, 1); PG8_STAGE(PG8_SB(1, 0), b3, voffA);
      PG8_BAR; PG8_WAIT_L(0); PG8_MMA(0, 1, At, B1); PG8_BAR;
      PG8_LDA(At, 1, 1); PG8_STAGE(PG8_SA(1, 0), a3, voffA);
      PG8_BAR; PG8_WAIT_L(0); PG8_MMA(1, 0, At, B0); PG8_BAR; PG8_SCHED;
      PG8_STAGE(PG8_SB(1, 1), b3 + hstep, voffA);
      PG8_WAIT_V(6); PG8_BAR; PG8_MMA(1, 1, At, B1); PG8_BAR;
    }
    epi_apply(ph, c, acc, cur.pm, cur.pn, cur.at, wr, wc, fr, fq);
    if (!has_next) break;
#pragma unroll
    for (int a = 0; a < 2; ++a)
#pragma unroll
      for (int b = 0; b < 2; ++b)
#pragma unroll
        for (int m = 0; m < 4; ++m)
#pragma unroll
          for (int n = 0; n < 2; ++n) acc[a][b][m][n] = (f32x4){0.f, 0.f, 0.f, 0.f};
    cur = nxt; cA = nA; cB = nB; ++ui;
  }
  PG8_WAIT_V(0);
  if (wr == 0) PG8_BAR;
  PG8_BAR;
}

__device__ void phase_init(int wv, ldsp lds, const Ctx& c) {
  int wvo = wv; asm volatile("" : "+s"(wvo)); int lno; asm volatile("v_mbcnt_lo_u32_b32 %0, -1, 0\n\tv_mbcnt_hi_u32_b32 %0, -1, %0" : "=v"(lno)); int tid = (wvo << 6) | lno; const int wid = tid >> 6, lane = tid & 63;
  LAS float* sc = (LAS float*)lds;
  LAS float* red = (LAS float*)(lds + 20480);
  for (int i = tid; i < 5120; i += 512) { const int s = i >> 10, k = i & 1023; const float v = s < 4 ? c.c[s * 1024 + k] : c.c_ctx[k]; sc[i] = siluf(v); }
  __syncthreads();
  for (int item = blockIdx.x; item < 288; item += gridDim.x) {
    const int l = item / 144, j0 = (item % 144) * 64;
    const float* w = c.mod_w + (size_t)l * 1024 * 9216 + j0 + lane;
    float a0 = 0, a1 = 0, a2 = 0, a3 = 0, a4 = 0;
    for (int k = wid * 128; k < wid * 128 + 128; ++k) {
      const float wv = w[(size_t)k * 9216];
      a0 += sc[k] * wv; a1 += sc[1024 + k] * wv; a2 += sc[2048 + k] * wv; a3 += sc[3072 + k] * wv; a4 += sc[4096 + k] * wv;
    }
    red[(wid * 5 + 0) * 64 + lane] = a0; red[(wid * 5 + 1) * 64 + lane] = a1; red[(wid * 5 + 2) * 64 + lane] = a2; red[(wid * 5 + 3) * 64 + lane] = a3; red[(wid * 5 + 4) * 64 + lane] = a4;
    __syncthreads();
    if (tid < 320) { const int s = tid >> 6; float v = 0; for (int ww = 0; ww < 8; ++ww) v += red[(ww * 5 + s) * 64 + lane];
      c.modv[(size_t)(l * 5 + s) * 9216 + j0 + lane] = v + c.mod_b[l * 9216 + j0 + lane]; }
    __syncthreads();
  }
  const size_t gt = (size_t)blockIdx.x * 512 + tid, gs = (size_t)gridDim.x * 512;
  for (size_t i = gt; i < (size_t)8192 * 128; i += gs) {
    const int t = (int)(i >> 7), p = (int)(i & 127); const int f = p & 63; const int pos = p < 64 ? (t >> 6) : (t & 63);
    const double inv = (double)exp2f(-(float)f * 0.20762050593046015f);
    const double rev = (double)pos * inv * 0.15915494309189535; const float fr = (float)(rev - rint(rev));
    c.rope[i * 2] = __builtin_amdgcn_cosf(fr); c.rope[i * 2 + 1] = __builtin_amdgcn_sinf(fr);
  }
  const float4* cs = (const float4*)c.ctx; float4* xd = (float4*)c.xr;
  for (size_t i = gt; i < (size_t)(NT - NL) * 256; i += gs) xd[(size_t)NL * 256 + i] = cs[i];
}

struct TileD { const float* src; u16* dst; int ld, nvalid, sc0, K, n0, k0, perm; float scale; };
__device__ __forceinline__ void tile_desc(const Ctx& c, int kind, int l, int f, int it, TileD& d) {
  const float* src; u16* dst; int ld, nvalid, sc0, K, n0, k0, perm = 1; float scale = 1.f;
  if (kind == 0) {
    if (it < 1408) { const int nb = it >> 4, kb = it & 15; const int pn = nb >> 2, q = nb & 3;
      src = c.w13 + (size_t)(l * 2 + f) * 1024 * 5632; dst = c.wb; ld = 5632; nvalid = 5632; sc0 = (q < 2 ? 0 : 2816) + 128 * pn + (q & 1) * 64; K = 1024; n0 = nb * 64; k0 = kb * 64; }
    else { const int i2 = it - 1408; const int nb = i2 / 44, kb = i2 % 44;
      perm = 0; src = c.w2 + (size_t)(l * 2 + f) * 2816 * 1024; dst = c.wb + (size_t)5632 * 1024; ld = 1024; nvalid = 1024; sc0 = nb * 64; K = 2816; n0 = nb * 64; k0 = kb * 64; }
  } else if (kind == 1) {
    if (it < 832) { const int nb = it >> 4, kb = it & 15; src = c.m_w_in; dst = c.wb; ld = 3104; nvalid = 3104; sc0 = nb * 64; K = 1024; n0 = nb * 64; k0 = kb * 64; }
    else { const int i2 = it - 832; const int nb = i2 >> 4, kb = i2 & 15; perm = 0; src = c.m_w_out; dst = c.wb + (size_t)3328 * 1024; ld = 1024; nvalid = 1024; sc0 = nb * 64; K = 1024; n0 = nb * 64; k0 = kb * 64; }
  } else {
    if (it < 1536) { const int nb = it >> 4, kb = it & 15; const int n = nb * 64; int s0;
      if (n < 4096) { const int hp = n >> 11, r = n & 2047; if (r < 512) s0 = hp * 512 + r; else if (r < 1024) { s0 = 1024 + hp * 512 + (r - 512); scale = 0.0625f; } else s0 = 2048 + hp * 1024 + (r - 1024); }
      else s0 = n;
      src = c.r_w_in; dst = c.wb; ld = 6144; nvalid = 6144; sc0 = s0; K = 1024; n0 = n; k0 = kb * 64; }
    else { const int i2 = it - 1536; const int nb = i2 >> 5, kb = i2 & 31; perm = 0; src = c.r_w_out; dst = c.wb + (size_t)6144 * 1024; ld = 1024; nvalid = 1024; sc0 = nb * 64; K = 2048; n0 = nb * 64; k0 = kb * 64; }
  }
  d.src = src; d.dst = dst; d.ld = ld; d.nvalid = nvalid; d.sc0 = sc0; d.K = K; d.n0 = n0; d.k0 = k0; d.perm = perm; d.scale = scale;
}
__device__ __forceinline__ void tile_load(const TileD& d, int tid, float4& v0, float4& v1) {
  const int kk = tid >> 4, c4 = (tid & 15) * 4; const int col = d.sc0 + c4;
  v0 = make_float4(0.f, 0.f, 0.f, 0.f); v1 = v0;
  if (col < d.nvalid) { const float* p = d.src + (size_t)(d.k0 + kk) * d.ld + col; v0 = *(const float4*)p; v1 = *(const float4*)(p + (size_t)32 * d.ld); }
}

__device__ void phase_norm(int wv, ldsp lds, const Phase& ph, const Ctx& c) {
  int wvo = wv; asm volatile("" : "+s"(wvo)); int lno; asm volatile("v_mbcnt_lo_u32_b32 %0, -1, 0\n\tv_mbcnt_hi_u32_b32 %0, -1, %0" : "=v"(lno)); int tid = (wvo << 6) | lno; const int wid = tid >> 6, lane = tid & 63;
  const int l = ph.i0, j = ph.i1, kind = ph.pad;
  {
    const int ntile = kind == 0 ? 2112 : (kind == 1 ? 1088 : 2048);
    LAS float* tile = (LAS float*)lds;
    TileD d; float4 p0, p1; int it = blockIdx.x; asm volatile("" : "+s"(it));
    if (it < ntile) { tile_desc(c, kind, l, ph.K, it, d); tile_load(d, tid, p0, p1); }
#pragma unroll 1
    for (; it < ntile; it += gridDim.x) {
      const float sc = d.scale; const int dperm = d.perm; u16* dptr = d.dst + (size_t)(d.n0 + (tid >> 3)) * d.K + d.k0 + (tid & 7) * 8;
      { const int kk = tid >> 4, c4 = (tid & 15) * 4;
        tile[kk * 65 + c4] = p0.x * sc; tile[kk * 65 + c4 + 1] = p0.y * sc; tile[kk * 65 + c4 + 2] = p0.z * sc; tile[kk * 65 + c4 + 3] = p0.w * sc;
        tile[(kk + 32) * 65 + c4] = p1.x * sc; tile[(kk + 32) * 65 + c4 + 1] = p1.y * sc; tile[(kk + 32) * 65 + c4 + 2] = p1.z * sc; tile[(kk + 32) * 65 + c4 + 3] = p1.w * sc; }
      if (it + (int)gridDim.x < ntile) { tile_desc(c, kind, l, ph.K, it + gridDim.x, d); tile_load(d, tid, p0, p1); }
      __syncthreads();
      { const int nd = tid >> 3, kc = (tid & 7) * 8; const int n = dperm ? (nd & 32) + perm32(nd & 31) : nd; u32x4 o;
        o.x = pack2(tile[(kc + 0) * 65 + n], tile[(kc + 1) * 65 + n]); o.y = pack2(tile[(kc + 2) * 65 + n], tile[(kc + 3) * 65 + n]);
        o.z = pack2(tile[(kc + 4) * 65 + n], tile[(kc + 5) * 65 + n]); o.w = pack2(tile[(kc + 6) * 65 + n], tile[(kc + 7) * 65 + n]);
        *(u32x4*)dptr = o; }
      __syncthreads();
    }
  }
  const float* g = c.norm_g + (size_t)(l * 3 + j) * 1024;
  const int nsplit = ph.N >> 8; const float* pbase = (ph.N & 2) ? c.part2 : c.part;
  const int rstride = gridDim.x * 8;
  float4 nv[4];
  { const int row = blockIdx.x * 8 + wid;
    if (row < ph.M) { const float4* xp = (const float4*)((((ph.N & 1) && row < NL) ? c.x : c.xr) + (size_t)row * 1024);
#pragma unroll
      for (int i = 0; i < 4; ++i) nv[i] = ldnt4(xp + lane + 64 * i); } }
  for (int row = blockIdx.x * 8 + wid; row < ph.M; row += rstride) {
    float4 v[4]; float ss = 0.f;
#pragma unroll
    for (int i = 0; i < 4; ++i) v[i] = nv[i];
    { const int nrow = row + rstride;
      if (nrow < ph.M) { const float4* xp = (const float4*)((((ph.N & 1) && nrow < NL) ? c.x : c.xr) + (size_t)nrow * 1024);
#pragma unroll
        for (int i = 0; i < 4; ++i) nv[i] = ldnt4(xp + lane + 64 * i); } }
    if (nsplit > 0 && row >= NL) {
      const float4* gp = (const float4*)((const float*)ph.X + (size_t)4 * 9216);
#pragma unroll
      for (int i = 0; i < 4; ++i) { float4 a = make_float4(0.f, 0.f, 0.f, 0.f);
        for (int ks = 0; ks < nsplit; ++ks) { const float4 pv = ((const float4*)(pbase + ((size_t)ks * 1024 + (row - NL)) * 1024))[lane + 64 * i]; a.x += pv.x; a.y += pv.y; a.z += pv.z; a.w += pv.w; }
        const float4 g4 = gp[lane + 64 * i]; const float f0 = ph.f0;
        v[i].x += f0 * g4.x * a.x; v[i].y += f0 * g4.y * a.y; v[i].z += f0 * g4.z * a.z; v[i].w += f0 * g4.w * a.w;
        ((float4*)(c.xr + (size_t)row * 1024))[lane + 64 * i] = v[i]; }
    }
#pragma unroll
    for (int i = 0; i < 4; ++i) ss += v[i].x * v[i].x + v[i].y * v[i].y + v[i].z * v[i].z + v[i].w * v[i].w;
#pragma unroll
    for (int o = 1; o < 64; o <<= 1) ss += shx(ss, o, lane);
    const float rstd = rsqrtf(ss * (1.f / 1024.f) + 1e-6f);
    const int set = row < NL ? (row >> 13) : 4;
    const float* sh = c.modv + (size_t)(l * 5 + set) * 9216 + (3 * j) * 1024; const float* sc = sh + 1024;
#pragma unroll
    for (int i = 0; i < 4; ++i) {
      const int q = lane + 64 * i; const float4 g4 = ((const float4*)g)[q], s4 = ((const float4*)sh)[q], c4 = ((const float4*)sc)[q];
      u32x2 o; o.x = pack2(v[i].x * rstd * g4.x * (1.f + c4.x) + s4.x, v[i].y * rstd * g4.y * (1.f + c4.y) + s4.y);
      o.y = pack2(v[i].z * rstd * g4.z * (1.f + c4.z) + s4.z, v[i].w * rstd * g4.w * (1.f + c4.w) + s4.w);
      *(u32x2*)(c.hb + (size_t)row * 1024 + q * 4) = o;
    }
  }
}

__device__ void phase_final(int wv, const Ctx& c) {
  int wvo = wv; asm volatile("" : "+s"(wvo)); int lno; asm volatile("v_mbcnt_lo_u32_b32 %0, -1, 0\n\tv_mbcnt_hi_u32_b32 %0, -1, %0" : "=v"(lno)); int tid = (wvo << 6) | lno; const int wid = tid >> 6, lane = tid & 63;
  for (int row = blockIdx.x * 8 + wid; row < NL; row += gridDim.x * 8) {
    const float4* xp = (const float4*)(c.xr + (size_t)row * 1024);
    float4 v[4]; float ss = 0.f;
#pragma unroll
    for (int i = 0; i < 4; ++i) { v[i] = ldnt4(xp + lane + 64 * i); ss += v[i].x * v[i].x + v[i].y * v[i].y + v[i].z * v[i].z + v[i].w * v[i].w; }
#pragma unroll
    for (int o = 1; o < 64; o <<= 1) ss += shx(ss, o, lane);
    const float rstd = rsqrtf(ss * (1.f / 1024.f) + 1e-6f);
#pragma unroll
    for (int i = 0; i < 4; ++i) { const int q = lane + 64 * i; const float4 g4 = ((const float4*)c.final_g)[q];
      float4 o; o.x = v[i].x * rstd * g4.x; o.y = v[i].y * rstd * g4.y; o.z = v[i].z * rstd * g4.z; o.w = v[i].w * rstd * g4.w;
      stnt4((float4*)(c.out + (size_t)row * 1024) + q, o); }
  }
}

#define MPRE_ELEMS ((size_t)NT * 3072)
__device__ __forceinline__ int m_chunk_row0(int b, int dir, int cs) {
  if (cs < 2) { const int j = dir ? 1 - cs : cs; return NL + b * 256 + j * 128; }
  const int j = dir ? 65 - cs : cs - 2; return b * 8192 + j * 128;
}

__device__ void phase_mconv(int wv, const Ctx& c) {
  const u16* pre = c.big; const float* cw = c.m_conv_w;
  int wvo = wv; asm volatile("" : "+s"(wvo)); int lno; asm volatile("v_mbcnt_lo_u32_b32 %0, -1, 0\n\tv_mbcnt_hi_u32_b32 %0, -1, %0" : "=v"(lno)); int tid = (wvo << 6) | lno; const size_t gt = (size_t)blockIdx.x * 512 + tid, gs = (size_t)gridDim.x * 512;
  for (size_t i = gt; i < (size_t)NT * 128; i += gs) {
    const int r = (int)(i >> 7), cg = (int)(i & 127) * 8;
    int pos, len; if (r < NL) { pos = r & 8191; len = 8192; } else { pos = (r - NL) & 255; len = 256; }
    float a[8];
#pragma unroll
    for (int q = 0; q < 8; ++q) a[q] = 0.f;
#pragma unroll
    for (int j = 0; j < 5; ++j) {
      const int pp = pos + j - 2;
      if (pp >= 0 && pp < len) {
        const u32x4 u = *(const u32x4*)(pre + (size_t)(r + j - 2) * 3072 + cg);
        const float4 w0 = *(const float4*)(cw + j * 1024 + cg), w1 = *(const float4*)(cw + j * 1024 + cg + 4);
        a[0] += w0.x * lo2f(u.x); a[1] += w0.y * hi2f(u.x); a[2] += w0.z * lo2f(u.y); a[3] += w0.w * hi2f(u.y);
        a[4] += w1.x * lo2f(u.z); a[5] += w1.y * hi2f(u.z); a[6] += w1.z * lo2f(u.w); a[7] += w1.w * hi2f(u.w);
      }
    }
    const float sc = cg >= 512 ? 0.125f : 1.f;
    u32x4 o; o.x = pack2(siluf(a[0]) * sc, siluf(a[1]) * sc); o.y = pack2(siluf(a[2]) * sc, siluf(a[3]) * sc);
    o.z = pack2(siluf(a[4]) * sc, siluf(a[5]) * sc); o.w = pack2(siluf(a[6]) * sc, siluf(a[7]) * sc);
    *(u32x4*)(c.hb + (size_t)r * 1024 + cg) = o;
  }
}

__device__ void phase_ma(int wv, ldsp lds, const Ctx& c) {
  int wvo = wv; asm volatile("" : "+s"(wvo)); int lno; asm volatile("v_mbcnt_lo_u32_b32 %0, -1, 0\n\tv_mbcnt_hi_u32_b32 %0, -1, %0" : "=v"(lno)); int tid = (wvo << 6) | lno; const int wid = tid >> 6, lane = tid & 63;
  ldsp sK = lds; ldsp sV = lds + 128 * 144; LAS float* sf = (LAS float*)(lds + 128 * 144 + 128 * 272);
  const u16* pre = c.big; u16* mc = c.big + MPRE_ELEMS;
  for (int item = blockIdx.x; item < 2 * 4 * 8 * 65; item += gridDim.x) {
    const int cs = item % 65; const int sq = item / 65; const int h = sq & 7, b = (sq >> 3) & 3, dir = sq >> 5;
    const int row0 = m_chunk_row0(b, dir, cs);
    if (wid == 0) {
      const float* gp = c.gates + (size_t)(row0 + 2 * lane) * 32 + dir * 16 + h;
      const float ig0 = gp[0], lf0 = logsig(gp[8]), ig1 = gp[32], lf1 = logsig(gp[40]);
      const float s2 = lf0 + lf1; float inc = s2;
#pragma unroll
      for (int d = 1; d < 64; d <<= 1) inc += shup(inc, d, lane, 0.f);
      const float total = lane63(inc); const float ex = inc - s2;
      const float g0 = (dir ? ex : total - ex - lf0) + ig0;
      const float g1 = (dir ? ex + lf0 : total - ex - lf0 - lf1) + ig1;
      float mx = fmaxf(g0, g1);
#pragma unroll
      for (int m = 1; m < 64; m <<= 1) mx = fmaxf(mx, shx(mx, m, lane));
      sf[256 + 2 * lane] = __expf(g0 - mx); sf[257 + 2 * lane] = __expf(g1 - mx);
      if (lane == 0) { c.mst_s[4224 + sq * 66 + cs] = total; c.mst_s[sq * 66 + cs] = mx; }
    }
    __syncthreads();
    { const int row = tid >> 2, part = tid & 3; const float w = sf[256 + row];
      const u16* kp = c.hb + (size_t)(row0 + row) * 1024 + 512 + h * 64 + part * 16;
#pragma unroll
      for (int q = 0; q < 2; ++q) { const u32x4 u = *(const u32x4*)(kp + q * 8); u32x4 o;
        o.x = pack2(lo2f(u.x) * w, hi2f(u.x) * w); o.y = pack2(lo2f(u.y) * w, hi2f(u.y) * w); o.z = pack2(lo2f(u.z) * w, hi2f(u.z) * w); o.w = pack2(lo2f(u.w) * w, hi2f(u.w) * w);
        *(LAS u32x4*)(sK + row * 144 + part * 32 + q * 16) = o; }
      const u16* vp = pre + (size_t)(row0 + row) * 3072 + 1024 + h * 128 + part * 32;
#pragma unroll
      for (int q = 0; q < 4; ++q) *(LAS u32x4*)(sV + row * 272 + part * 64 + q * 16) = *(const u32x4*)(vp + q * 8);
    }
    __syncthreads();
    f32x4 acc[4];
#pragma unroll
    for (int n = 0; n < 4; ++n) acc[n] = (f32x4){0.f, 0.f, 0.f, 0.f};
#pragma unroll
    for (int k0 = 0; k0 < 128; k0 += 32) {
      const bf16x8 a = frag_tr(sV, 272, wid * 16, k0, lane);
#pragma unroll
      for (int n = 0; n < 4; ++n) { const bf16x8 bb = frag_tr(sK, 144, n * 16, k0, lane); acc[n] = MFMA16(a, bb, acc[n]); }
    }
    u16* dst = mc + (size_t)(sq * 66 + cs) * 8192;
#pragma unroll
    for (int n = 0; n < 4; ++n)
#pragma unroll
      for (int r = 0; r < 4; ++r) dst[(wid * 16 + 4 * (lane >> 4) + r) * 64 + n * 16 + (lane & 15)] = f2bf(acc[n][r]);
    { float s = 0.f;
#pragma unroll
      for (int p = 0; p < 16; ++p) s += bf2f(*(LAS u16*)(sK + (wid * 16 + p) * 144 + lane * 2));
      sf[384 + wid * 64 + lane] = s; }
    __syncthreads();
    if (tid < 64) { float s = 0.f;
#pragma unroll
      for (int w8 = 0; w8 < 8; ++w8) s += sf[384 + w8 * 64 + tid];
      c.mst_n[(size_t)(sq * 66 + cs) * 64 + tid] = s; }
    __syncthreads();
  }
}

__device__ void phase_mb(int wv, const Ctx& c) {
  int wvo = wv; asm volatile("" : "+s"(wvo)); int lno; asm volatile("v_mbcnt_lo_u32_b32 %0, -1, 0\n\tv_mbcnt_hi_u32_b32 %0, -1, %0" : "=v"(lno)); int tid = (wvo << 6) | lno;
  u16* mc = c.big + MPRE_ELEMS;
  for (int item = blockIdx.x; item < 64 * 8; item += gridDim.x) {
    const int sq = item >> 3, slab = item & 7;
    unsigned* p = (unsigned*)(mc + (size_t)sq * 66 * 8192 + slab * 1024 + tid * 2);
    const bool nth = (slab == 0 && tid < 64);
    float* np = c.mst_n + (size_t)sq * 66 * 64 + tid;
    float m = -1e30f, c0 = 0.f, c1 = 0.f, cn = 0.f;
#pragma unroll 1
    for (int cb = 0; cb < 66; cb += 11) {
      unsigned loc[11]; float nl[11], bl[11], ml[11];
#pragma unroll
      for (int q = 0; q < 11; ++q) { const int cs = cb + q; loc[q] = 0u; nl[q] = 0.f; bl[q] = 0.f; ml[q] = 0.f;
        if (cs < 65) { loc[q] = p[(size_t)cs * 4096]; bl[q] = c.mst_s[4224 + sq * 66 + cs]; ml[q] = c.mst_s[sq * 66 + cs]; if (nth) nl[q] = np[cs * 64]; } }
#pragma unroll
      for (int q = 0; q < 11; ++q) { const int cs = cb + q;
        p[(size_t)cs * 4096] = pack2(c0, c1);
        if (nth) np[cs * 64] = cn;
        if (slab == 0 && tid == 0) c.mst_s[8448 + sq * 66 + cs] = m;
        if (cs < 65) {
          const float mn = fmaxf(bl[q] + m, ml[q]); const float wp = __expf(bl[q] + m - mn), wl = __expf(ml[q] - mn);
          c0 = wp * c0 + wl * lo2f(loc[q]); c1 = wp * c1 + wl * hi2f(loc[q]); cn = wp * cn + wl * nl[q]; m = mn;
        } }
    }
  }
}

__device__ void phase_mc(int wv, ldsp lds, const Ctx& c) {
  int wvo = wv; asm volatile("" : "+s"(wvo)); int lno; asm volatile("v_mbcnt_lo_u32_b32 %0, -1, 0\n\tv_mbcnt_hi_u32_b32 %0, -1, %0" : "=v"(lno)); int tid = (wvo << 6) | lno; const int wid = tid >> 6, lane = tid & 63;
  ldsp sQ = lds, sK = lds + 18432, sV = lds + 36864, sP = lds + 71680, sC0 = lds + 106496, sC1 = lds + 124928;
  LAS float* sf = (LAS float*)(lds + 143360);
  const u16* pre = c.big; const u16* mc = c.big + MPRE_ELEMS;
  for (int item = blockIdx.x; item < 4 * 8 * 66; item += gridDim.x) {
    const int j = item % 66; const int bh = item / 66; const int h = bh & 7, b = bh >> 3;
    const int row0 = j < 2 ? NL + b * 256 + j * 128 : b * 8192 + (j - 2) * 128;
    const int csf = j, csb = j < 2 ? 1 - j : 67 - j;
    const int sqf = b * 8 + h, sqb = 32 + b * 8 + h;
    const int d2 = tid >> 7, po = tid & 127;
    if (wid < 2) {
      const int dd = wid;
      const float* gp = c.gates + (size_t)(row0 + 2 * lane) * 32 + dd * 16 + h;
      const float ig0 = gp[0], lf0 = logsig(gp[8]), ig1 = gp[32], lf1 = logsig(gp[40]);
      const float s2 = lf0 + lf1; float inc = s2;
#pragma unroll
      for (int d = 1; d < 64; d <<= 1) inc += shup(inc, d, lane, 0.f);
      const float total = lane63(inc); const float ex = inc - s2;
      const float bb0 = dd ? total - ex : ex + lf0;
      const float bb1 = dd ? total - ex - lf0 : ex + s2;
      const float e0 = ig0 - bb0, e1 = ig1 - bb1, e01 = fmaxf(e0, e1);
      const float mpre = c.mst_s[8448 + (dd ? sqb * 66 + csb : sqf * 66 + csf)];
      float pm0, pm1;
      if (!dd) { float P = e01;
#pragma unroll
        for (int d = 1; d < 64; d <<= 1) P = fmaxf(P, shup(P, d, lane, -3.0e38f));
        const float xp = shup(P, 1, lane, -3.0e38f); pm0 = fmaxf(xp, e0); pm1 = fmaxf(xp, e01); }
      else { float S = e01;
#pragma unroll
        for (int d = 1; d < 64; d <<= 1) S = fmaxf(S, shdn(S, d, lane, -3.0e38f));
        const float xs = shdn(S, 1, lane, -3.0e38f); pm1 = fmaxf(xs, e1); pm0 = fmaxf(xs, e01); }
      const float M0 = fmaxf(mpre, pm0), M1 = fmaxf(mpre, pm1);
      const int o = dd * 128 + 2 * lane;
      sf[768 + o] = bb0; sf[769 + o] = bb1; sf[256 + o] = e0; sf[257 + o] = e1; sf[512 + o] = M0; sf[513 + o] = M1;
      sf[1024 + o] = __expf(mpre - M0); sf[1025 + o] = __expf(mpre - M1);
    }
    if (tid >= 256 && tid < 384) { const int q = tid - 256; const int d3 = q >> 6, dd = q & 63; sf[1536 + q] = c.mst_n[(size_t)(d3 ? sqb * 66 + csb : sqf * 66 + csf) * 64 + dd]; }
    { const int row = tid >> 2, part = tid & 3;
      const u16* qp = c.hb + (size_t)(row0 + row) * 1024 + h * 64 + part * 16;
#pragma unroll
      for (int q = 0; q < 2; ++q) { *(LAS u32x4*)(sQ + row * 144 + part * 32 + q * 16) = *(const u32x4*)(qp + q * 8); *(LAS u32x4*)(sK + row * 144 + part * 32 + q * 16) = *(const u32x4*)(qp + 512 + q * 8); }
      const u16* vp = pre + (size_t)(row0 + row) * 3072 + 1024 + h * 128 + part * 32;
#pragma unroll
      for (int q = 0; q < 4; ++q) *(LAS u32x4*)(sV + row * 272 + part * 64 + q * 16) = *(const u32x4*)(vp + q * 8);
      const u16* cf = mc + (size_t)(sqf * 66 + csf) * 8192 + row * 64 + part * 16; const u16* cb = mc + (size_t)(sqb * 66 + csb) * 8192 + row * 64 + part * 16;
#pragma unroll
      for (int q = 0; q < 2; ++q) { *(LAS u32x4*)(sC0 + row * 144 + part * 32 + q * 16) = *(const u32x4*)(cf + q * 8); *(LAS u32x4*)(sC1 + row * 144 + part * 32 + q * 16) = *(const u32x4*)(cb + q * 8); }
    }
    __syncthreads();
    { const int row = tid >> 2, part = tid & 3; float qf = 0.f, qb = 0.f;
#pragma unroll
      for (int q = 0; q < 2; ++q) { const u32x4 u = *(const LAS u32x4*)(sQ + row * 144 + part * 32 + q * 16); const int d0 = part * 16 + q * 8;
        const float v0 = lo2f(u.x), v1 = hi2f(u.x), v2 = lo2f(u.y), v3 = hi2f(u.y), v4 = lo2f(u.z), v5 = hi2f(u.z), v6 = lo2f(u.w), v7 = hi2f(u.w);
        qf += v0 * sf[1536 + d0] + v1 * sf[1537 + d0] + v2 * sf[1538 + d0] + v3 * sf[1539 + d0] + v4 * sf[1540 + d0] + v5 * sf[1541 + d0] + v6 * sf[1542 + d0] + v7 * sf[1543 + d0];
        qb += v0 * sf[1600 + d0] + v1 * sf[1601 + d0] + v2 * sf[1602 + d0] + v3 * sf[1603 + d0] + v4 * sf[1604 + d0] + v5 * sf[1605 + d0] + v6 * sf[1606 + d0] + v7 * sf[1607 + d0]; }
      qf += shx(qf, 1, lane); qf += shx(qf, 2, lane); qb += shx(qb, 1, lane); qb += shx(qb, 2, lane);
      if (part == 0) { sf[1280 + row] = qf; sf[1408 + row] = qb; } }
    f32x4 accS[8];
#pragma unroll
    for (int n = 0; n < 8; ++n) accS[n] = (f32x4){0.f, 0.f, 0.f, 0.f};
#pragma unroll
    for (int k0 = 0; k0 < 64; k0 += 32) {
      const bf16x8 a = frag_row(sQ, 144, wid * 16, k0, lane);
#pragma unroll
      for (int n = 0; n < 8; ++n) { const bf16x8 bb = frag_row(sK, 144, n * 16, k0, lane); accS[n] = MFMA16(a, bb, accS[n]); }
    }
    __syncthreads();
    f32x4 hs[8];
#pragma unroll
    for (int n = 0; n < 8; ++n) hs[n] = (f32x4){0.f, 0.f, 0.f, 0.f};
    const int tb = wid * 16 + 4 * (lane >> 4), sl = lane & 15;
#pragma unroll 1
    for (int dir = 0; dir < 2; ++dir) {
      float rs[4] = {0.f, 0.f, 0.f, 0.f}; float Mt[4];
#pragma unroll
      for (int r = 0; r < 4; ++r) Mt[r] = sf[512 + dir * 128 + tb + r];
#pragma unroll
      for (int n = 0; n < 8; ++n) { const int s = n * 16 + sl; const float es = sf[256 + dir * 128 + s];
#pragma unroll
        for (int r = 0; r < 4; ++r) { const int t = tb + r; const bool in = dir ? (s >= t) : (s <= t);
          const float pv = in ? accS[n][r] * __expf(es - Mt[r]) : 0.f; rs[r] += pv; *(LAS u16*)(sP + t * 272 + s * 2) = f2bf(pv); } }
#pragma unroll
      for (int r = 0; r < 4; ++r) rs[r] = red16l(rs[r], lane);
      float wi4[4], inv4[4];
#pragma unroll
      for (int r = 0; r < 4; ++r) { const int t = tb + r; const float wi = sf[1024 + dir * 128 + t];
        const float den = wi * sf[1280 + dir * 128 + t] + rs[r]; const float mt = sf[768 + dir * 128 + t] + Mt[r];
        wi4[r] = wi; inv4[r] = 1.f / fmaxf(fabsf(den), __expf(-mt)); }
      ldsp sC = dir ? sC1 : sC0;
#pragma unroll
      for (int eh = 0; eh < 2; ++eh) {
        f32x4 a1[4], a2[4];
#pragma unroll
        for (int n = 0; n < 4; ++n) { a1[n] = (f32x4){0.f, 0.f, 0.f, 0.f}; a2[n] = (f32x4){0.f, 0.f, 0.f, 0.f}; }
#pragma unroll
        for (int k0 = 0; k0 < 128; k0 += 32) { const bf16x8 a = frag_row(sP, 272, wid * 16, k0, lane);
#pragma unroll

#define FR_(n) frag_tr(sV, 272, (eh * 4 + (n)) * 16, k0, lane)
          SWEEP(4, 4, FR_, a, a1);
#undef FR_
        }
#pragma unroll
        for (int k0 = 0; k0 < 64; k0 += 32) { const bf16x8 a = frag_row(sQ, 144, wid * 16, k0, lane);
#pragma unroll

#define FR_(n) frag_row(sC, 144, (eh * 4 + (n)) * 16, k0, lane)
          SWEEP(4, 4, FR_, a, a2);
#undef FR_
        }
#pragma unroll
        for (int r = 0; r < 4; ++r)
#pragma unroll
          for (int n = 0; n < 4; ++n) hs[eh * 4 + n][r] += (a1[n][r] + wi4[r] * a2[n][r]) * inv4[r];
      }
    }
#pragma unroll
    for (int r = 0; r < 4; ++r) {
      float s = 0.f;
#pragma unroll
      for (int n = 0; n < 8; ++n) s += hs[n][r];
      const float mu = red16l(s, lane) * (1.f / 128.f); float v = 0.f;
#pragma unroll
      for (int n = 0; n < 8; ++n) { const float d = hs[n][r] - mu; v += d * d; }
      const float rstd = rsqrtf(red16l(v, lane) * (1.f / 128.f) + 1e-6f);
      const size_t row = row0 + tb + r;
#pragma unroll
      for (int n = 0; n < 8; ++n) { const int e = h * 128 + n * 16 + sl;
        const float og = bf2f(pre[row * 3072 + 2048 + e]);
        c.y[row * 1024 + e] = f2bf((hs[n][r] - mu) * rstd * c.m_norm_g[e] * sigmf(og)); }
    }
    __syncthreads();
  }
}

#define RUQ_ELEMS ((size_t)NT * 2048)
__device__ __forceinline__ float ret_lg(const Ctx& c, int dir, int h) { return logsig(c.r_decay[dir * 4 + h]); }

__device__ void phase_ra(int wv, ldsp lds, const Phase& ph, const Ctx& c) {
  int wvo = wv; asm volatile("" : "+s"(wvo)); int lno; asm volatile("v_mbcnt_lo_u32_b32 %0, -1, 0\n\tv_mbcnt_hi_u32_b32 %0, -1, %0" : "=v"(lno)); int tid = (wvo << 6) | lno; const int wid = tid >> 6, lane = tid & 63;
  ldsp sV = lds; ldsp sK = lds + 64 * 272;
  const u16* uq = c.big; u16* rst = c.big + RUQ_ELEMS; const int hp = ph.i0;
  for (int item = blockIdx.x; item < 1024; item += gridDim.x) {
    const int eq = item & 3, J = (item >> 2) & 15, hl = (item >> 6) & 1, b = (item >> 7) & 3, dir = item >> 9;
    const int sq = (dir * 4 + b) * 2 + hl; const float lg = ret_lg(c, dir, hp * 2 + hl);
    int row0, L; if (J == 0) { row0 = NL + b * 256; L = 256; } else { L = 512; row0 = b * 8192 + (dir ? 16 - J : J - 1) * 512; }
    f32x4 acc[16];
#pragma unroll
    for (int n = 0; n < 16; ++n) acc[n] = (f32x4){0.f, 0.f, 0.f, 0.f};
    const u16* vp = uq + (size_t)(row0 + (tid >> 4)) * 2048 + 1024 + hl * 512 + eq * 128 + (tid & 15) * 8;
    const u16* kp = uq + (size_t)(row0 + (tid >> 5)) * 2048 + 512 + hl * 256 + (tid & 31) * 8;
    u32x4 pv[2], pk[4];
#pragma unroll
    for (int q = 0; q < 2; ++q) pv[q] = *(const u32x4*)(vp + (size_t)q * 32 * 2048);
#pragma unroll
    for (int q = 0; q < 4; ++q) pk[q] = *(const u32x4*)(kp + (size_t)q * 16 * 2048);
    LDS_BAR();
#pragma unroll 1
    for (int s0 = 0; s0 < L; s0 += 64) {
      {
#pragma unroll
        for (int q = 0; q < 2; ++q) *(LAS u32x4*)(sV + (q * 32 + (tid >> 4)) * 272 + (tid & 15) * 16) = pv[q];
#pragma unroll
        for (int q = 0; q < 4; ++q) { const int krow = q * 16 + (tid >> 5); const int o = s0 + krow; const float z = __expf(lg * (float)(dir ? o : L - 1 - o)); const u32x4 u = pk[q]; u32x4 w;
          w.x = pack2(lo2f(u.x) * z, hi2f(u.x) * z); w.y = pack2(lo2f(u.y) * z, hi2f(u.y) * z); w.z = pack2(lo2f(u.z) * z, hi2f(u.z) * z); w.w = pack2(lo2f(u.w) * z, hi2f(u.w) * z);
          *(LAS u32x4*)(sK + krow * 528 + (tid & 31) * 16) = w; }
      }
      if (s0 + 64 < L) {
        const size_t adv = (size_t)(s0 + 64) * 2048;
#pragma unroll
        for (int q = 0; q < 2; ++q) pv[q] = *(const u32x4*)(vp + adv + (size_t)q * 32 * 2048);
#pragma unroll
        for (int q = 0; q < 4; ++q) pk[q] = *(const u32x4*)(kp + adv + (size_t)q * 16 * 2048);
      }
      LDS_BAR();
#pragma unroll
      for (int k0 = 0; k0 < 64; k0 += 32) { const bf16x8 a0 = frag_tr(sV, 272, (wid >> 1) * 32, k0, lane), a1 = frag_tr(sV, 272, (wid >> 1) * 32 + 16, k0, lane);
        bf16x8 bq[4];
#pragma unroll
        for (int n = 0; n < 4; ++n) bq[n] = frag_tr(sK, 528, (wid & 1) * 128 + n * 16, k0, lane);
        __builtin_amdgcn_sched_barrier(0);
#pragma unroll
        for (int n = 0; n < 8; ++n) { const bf16x8 cur = bq[n & 3]; if (n + 4 < 8) bq[n & 3] = frag_tr(sK, 528, (wid & 1) * 128 + (n + 4) * 16, k0, lane);
          acc[n] = MFMA16(a0, cur, acc[n]); acc[8 + n] = MFMA16(a1, cur, acc[8 + n]); __builtin_amdgcn_sched_barrier(0); }
      }
      LDS_BAR();
    }
    u16* dst = rst + (size_t)(sq * 16 + J) * 131072 + (size_t)(eq * 128 + (wid >> 1) * 32 + 4 * (lane >> 4)) * 256 + (wid & 1) * 128 + (lane & 15);
#pragma unroll
    for (int mi = 0; mi < 2; ++mi)
#pragma unroll
      for (int n = 0; n < 8; ++n)
#pragma unroll
        for (int r = 0; r < 4; ++r) dst[(mi * 16 + r) * 256 + n * 16] = f2bf(acc[mi * 8 + n][r]);
  }
}

__device__ void phase_rb(int wv, const Phase& ph, const Ctx& c) {
  int wvo = wv; asm volatile("" : "+s"(wvo)); int lno; asm volatile("v_mbcnt_lo_u32_b32 %0, -1, 0\n\tv_mbcnt_hi_u32_b32 %0, -1, %0" : "=v"(lno)); int tid = (wvo << 6) | lno; u16* rst = c.big + RUQ_ELEMS; const int hp = ph.i0;
  for (int item = blockIdx.x; item < 16 * 32; item += gridDim.x) {
    const int sq = item >> 5, slab = item & 31; const int hl = sq & 1, dir = sq >> 3;
    const float g512 = __expf(512.f * ret_lg(c, dir, hp * 2 + hl));
    u32x4* p = (u32x4*)(rst + (size_t)sq * 16 * 131072 + slab * 4096 + tid * 8);
    float cr[8];
#pragma unroll
    for (int q = 0; q < 8; ++q) cr[q] = 0.f;
    u32x4 uu[16];
#pragma unroll
    for (int J = 0; J < 16; ++J) uu[J] = p[(size_t)J * 16384];
#pragma unroll
    for (int J = 0; J < 16; ++J) {
      const u32x4 u = uu[J];
      cr[0] = g512 * cr[0] + lo2f(u.x); cr[1] = g512 * cr[1] + hi2f(u.x); cr[2] = g512 * cr[2] + lo2f(u.y); cr[3] = g512 * cr[3] + hi2f(u.y);
      cr[4] = g512 * cr[4] + lo2f(u.z); cr[5] = g512 * cr[5] + hi2f(u.z); cr[6] = g512 * cr[6] + lo2f(u.w); cr[7] = g512 * cr[7] + hi2f(u.w);
      u32x4 o; o.x = pack2(cr[0], cr[1]); o.y = pack2(cr[2], cr[3]); o.z = pack2(cr[4], cr[5]); o.w = pack2(cr[6], cr[7]);
      p[(size_t)J * 16384] = o;
    }
  }
}

__device__ __forceinline__ bf16x8 scale_frag(bf16x8 a, float s) {
  bf16x8 r;
#pragma unroll
  for (int q = 0; q < 8; ++q) r[q] = (short)f2bf(bf2f((u16)a[q]) * s);
  return r;
}

#define SWEEP2(NT, DEPTH, FRAG, A0, A1, ACC, OFF1) do { bf16x8 bq_[DEPTH]; \
    _Pragma("unroll") for (int n_ = 0; n_ < DEPTH; ++n_) bq_[n_] = FRAG(n_); __builtin_amdgcn_sched_barrier(0); \
    _Pragma("unroll") for (int n_ = 0; n_ < NT; ++n_) { const bf16x8 cur_ = bq_[n_ % DEPTH]; if (n_ + DEPTH < NT) bq_[n_ % DEPTH] = FRAG(n_ + DEPTH); \
      ACC[n_] = MFMA16(A0, cur_, ACC[n_]); ACC[OFF1 + n_] = MFMA16(A1, cur_, ACC[OFF1 + n_]); __builtin_amdgcn_sched_barrier(0); } } while (0)
__device__ void phase_rc(int wv, ldsp lds, const Phase& ph, const Ctx& c) {
  ldsp sQ = lds, sKP = lds + 67584, sV = lds + 102400;
  const u16* uq = c.big; const u16* rst = c.big + RUQ_ELEMS; const int hp = ph.i0;
  for (int item = blockIdx.x; item < 512; item += gridDim.x) {
    int wvo = wv; asm volatile("" : "+s"(wvo)); int lno; asm volatile("v_mbcnt_lo_u32_b32 %0, -1, 0\n\tv_mbcnt_hi_u32_b32 %0, -1, %0" : "=v"(lno)); int tid = (wvo << 6) | lno; const int wid = tid >> 6, lane = tid & 63;
    const int i = item & 3, Jo = (item >> 2) & 15, hl = (item >> 6) & 1, b = item >> 7;
    const int h = hp * 2 + hl; const float lgf = ret_lg(c, 0, h), lgb = ret_lg(c, 1, h);
    const int rowb = b * 8192 + Jo * 512;
    const unsigned kofs = (unsigned)((rowb + (tid >> 4)) * 2048 + 512 + hl * 256 + (tid & 15) * 8);
    const unsigned vofs = (unsigned)((rowb + (tid >> 6)) * 2048 + 1024 + hl * 512 + (tid & 63) * 8);
    const unsigned rofs = (unsigned)((tid >> 2) * 256 + (tid & 3) * 8);
    const u16* rs0 = rst + (size_t)(((0 * 4 + b) * 2 + hl) * 16 + Jo) * 131072;
    const u16* rs1 = rst + (size_t)(((1 * 4 + b) * 2 + hl) * 16 + (15 - Jo)) * 131072;
#define kbase (uq + kofs)
#define vbase (uq + vofs)
#define rbase0 (rs0 + rofs)
#define rbase1 (rs1 + rofs)
    const unsigned dK = (unsigned)((tid >> 4) * 272 + (tid & 15) * 16), dV = (unsigned)((tid >> 6) * 1040 + (tid & 63) * 16), dR = (unsigned)((tid >> 2) * 80 + (tid & 3) * 16);
    constexpr int KQ = 32 * 2048, VQ = 8 * 2048, RQ = 128 * 256, KD = 32 * 272, VD = 8 * 1040, RD = 128 * 80;
    u32x4 pf[4];
#pragma unroll
    for (int q = 0; q < 4; ++q) pf[q] = *(const u32x4*)(kbase + q * KQ);
    { const int row = tid >> 5, ch = tid & 31; const u16* qp = uq + (size_t)(rowb + i * 128 + row) * 2048 + hl * 256 + ch * 8;
#pragma unroll
      for (int q = 0; q < 8; ++q) *(LAS u32x4*)(sQ + (q * 16 + row) * 528 + ch * 16) = *(const u32x4*)(qp + (size_t)q * 16 * 2048); }
    f32x4 acc[32];
#pragma unroll
    for (int n = 0; n < 32; ++n) acc[n] = (f32x4){0.f, 0.f, 0.f, 0.f};
    const int mg = wid >> 1, ng = wid & 1, lq = lane >> 4, sl = lane & 15;
#pragma unroll 1
    for (int j = 0; j < 4; ++j) {
      f32x4 accS[8];
#pragma unroll
      for (int n = 0; n < 8; ++n) accS[n] = (f32x4){0.f, 0.f, 0.f, 0.f};
#pragma unroll 1
      for (int dh = 0; dh < 2; ++dh) {
        LDS_BAR();
#pragma unroll
        for (int q = 0; q < 4; ++q) *(LAS u32x4*)(sKP + dK + q * KD) = pf[q];
        { const u16* src = dh == 0 ? kbase + (size_t)j * 128 * 2048 + 128 : vbase + (size_t)(j * 128) * 2048; const int qs = dh == 0 ? KQ : VQ;
#pragma unroll
          for (int q = 0; q < 4; ++q) pf[q] = *(const u32x4*)(src + q * qs); }
        LDS_BAR();
#pragma unroll
        for (int k0 = 0; k0 < 128; k0 += 32) { const bf16x8 a0 = frag_row(sQ, 528, mg * 32, dh * 128 + k0, lane), a1 = frag_row(sQ, 528, mg * 32 + 16, dh * 128 + k0, lane);
#define FR_(n) frag_row(sKP, 272, ng * 64 + (n) * 16, k0, lane)
          SWEEP2(4, 2, FR_, a0, a1, accS, 4);
#undef FR_
        }
      }
      LDS_BAR();
#pragma unroll
      for (int mi = 0; mi < 2; ++mi)
#pragma unroll
        for (int n = 0; n < 4; ++n) { const int sc = ng * 64 + n * 16 + sl; const int os = j * 128 + sc;
#pragma unroll
          for (int r = 0; r < 4; ++r) { const int t = mg * 32 + mi * 16 + 4 * lq + r; const int df = i * 128 + t - os;
            float w = 0.f; if (df >= 0) w += __expf(lgf * (float)df); if (df <= 0) w += __expf(-lgb * (float)df);
            *(LAS u16*)(sKP + t * 272 + sc * 2) = f2bf(accS[mi * 4 + n][r] * w); } }
#pragma unroll 1
      for (int s4 = 0; s4 < 4; ++s4) {
        LDS_BAR();
#pragma unroll
        for (int q = 0; q < 4; ++q) *(LAS u32x4*)(sV + dV + q * VD) = pf[q];
        { const u16* src = s4 < 3 ? vbase + (size_t)(j * 128 + (s4 + 1) * 32) * 2048 : (j < 3 ? kbase + (size_t)(j + 1) * 128 * 2048 : rbase0); const int qs = s4 < 3 ? VQ : (j < 3 ? KQ : RQ);
#pragma unroll
          for (int q = 0; q < 4; ++q) pf[q] = *(const u32x4*)(src + q * qs); }
        LDS_BAR();
        const bf16x8 a0 = frag_row(sKP, 272, mg * 32, s4 * 32, lane), a1 = frag_row(sKP, 272, mg * 32 + 16, s4 * 32, lane);
#define FR_(n) frag_tr(sV, 1040, ng * 256 + (n) * 16, 0, lane)
        SWEEP2(16, 2, FR_, a0, a1, acc, 16);
#undef FR_
      }
    }
#pragma unroll 1
    for (int dir = 0; dir < 2; ++dir) {
      const int off = i * 128 + mg * 32 + sl;
      const float xi0 = dir ? __expf(lgb * (float)(512 - off)) : __expf(lgf * (float)(off + 1));
      const float xi1 = dir ? __expf(lgb * (float)(496 - off)) : __expf(lgf * (float)(off + 17));
#pragma unroll 1
      for (int ds = 0; ds < 8; ++ds) {
        LDS_BAR();
#pragma unroll
        for (int q = 0; q < 4; ++q) *(LAS u32x4*)(sV + dR + q * RD) = pf[q];
        if (ds < 7 || dir == 0) { const u16* src = ds < 7 ? (dir ? rbase1 : rbase0) + (ds + 1) * 32 : rbase1;
#pragma unroll
          for (int q = 0; q < 4; ++q) pf[q] = *(const u32x4*)(src + q * RQ); }
        LDS_BAR();
        const bf16x8 a0 = scale_frag(frag_row(sQ, 528, mg * 32, ds * 32, lane), xi0), a1 = scale_frag(frag_row(sQ, 528, mg * 32 + 16, ds * 32, lane), xi1);
#define FR_(n) frag_row(sV, 80, ng * 256 + (n) * 16, 0, lane)
        SWEEP2(16, 2, FR_, a0, a1, acc, 16);
#undef FR_
      }
    }
#undef kbase
#undef vbase
#undef rbase0
#undef rbase1
    LDS_BAR();
    LAS float* sst = (LAS float*)sKP;
#pragma unroll
    for (int mi = 0; mi < 2; ++mi)
#pragma unroll
      for (int r = 0; r < 4; ++r) { float sm = 0.f;
#pragma unroll
        for (int n = 0; n < 16; ++n) sm += acc[mi * 16 + n][r];
        sm = red16l(sm, lane);
        if (sl == 0) sst[ng * 128 + mg * 32 + mi * 16 + 4 * lq + r] = sm; }
    LDS_BAR();
#pragma unroll
    for (int mi = 0; mi < 2; ++mi)
#pragma unroll
      for (int r = 0; r < 4; ++r) { const int t = mg * 32 + mi * 16 + 4 * lq + r; const float mu = (sst[t] + sst[128 + t]) * (1.f / 512.f); float v = 0.f;
#pragma unroll
        for (int n = 0; n < 16; ++n) { const float d = acc[mi * 16 + n][r] - mu; v += d * d; }
        v = red16l(v, lane);
        if (sl == 0) sst[256 + ng * 128 + t] = v; }
    LDS_BAR();
#pragma unroll
    for (int mi = 0; mi < 2; ++mi)
#pragma unroll
      for (int r = 0; r < 4; ++r) { const int t = mg * 32 + mi * 16 + 4 * lq + r; const float mu = (sst[t] + sst[128 + t]) * (1.f / 512.f);
        const float rstd = rsqrtf((sst[256 + t] + sst[384 + t]) * (1.f / 512.f) + 1e-6f);
        const size_t row = rowb + i * 128 + t;
#pragma unroll
        for (int n = 0; n < 16; ++n) { const int e = h * 512 + ng * 256 + n * 16 + sl; c.y[row * 2048 + e] = f2bf((acc[mi * 16 + n][r] - mu) * rstd * c.r_norm_g[e]); } }
    LDS_BAR();
  }
}

#define XB_TMO      128
#define XB_XCNT(j)  (256  + 64 * (j))
#define XB_XSUB(j)  (1280 + 64 * (j))
#define XB_XGEN(j)  (2304 + 64 * (j))
#define XB_TOP      3328
#define XB_TOPGEN   3392
#define XCD_BAR_WORDS 3456
#define XB_SPIN_CAP (1u << 18)
__device__ __forceinline__ unsigned xb_ld(unsigned* p)              { return __hip_atomic_load(p, __ATOMIC_RELAXED, __HIP_MEMORY_SCOPE_AGENT); }
__device__ __forceinline__ unsigned xb_add(unsigned* p, unsigned v) { return __hip_atomic_fetch_add(p, v, __ATOMIC_RELAXED, __HIP_MEMORY_SCOPE_AGENT); }
__device__ __forceinline__ unsigned xb_xcc_id() { return (unsigned)__builtin_amdgcn_s_getreg((3 << 11) | 20) & 0xFu; }
#define XB_SPIN(cond, bar) do { unsigned _sp = 0; while (cond) { __builtin_amdgcn_s_sleep(1); \
    if ((++_sp & 255u) == 0u) { if (xb_ld(&(bar)[XB_TMO])) break; if (_sp > XB_SPIN_CAP) { atomicAdd(&(bar)[XB_TMO], 1u); break; } } } } while (0)
struct XcdBarrier { unsigned* bar; unsigned x; volatile LAS unsigned* st; };
__device__ __forceinline__ XcdBarrier xcd_barrier_post(unsigned* bar, volatile LAS unsigned* st) {
    XcdBarrier b; b.bar = bar; b.x = xb_xcc_id(); b.st = st;
    if (threadIdx.x == 0) (void)xb_add(&bar[XB_XCNT(b.x)], 1u);
    return b;
}
__device__ __forceinline__ void xcd_barrier_complete(unsigned* bar, unsigned x, unsigned& nloc, unsigned& nx) {
    const unsigned G = gridDim.x * gridDim.y * gridDim.z;
    unsigned sum, cnt, mine, sp = 0u;
    for (;;) {
        sum = 0u; cnt = 0u; mine = 0u;
#pragma unroll
        for (unsigned j = 0; j < 16; ++j) { const unsigned c = xb_ld(&bar[XB_XCNT(j)]); sum += c; cnt += (c > 0u) ? 1u : 0u; mine = (j == x) ? c : mine; }
        if (sum == G) break;
        __builtin_amdgcn_s_sleep(1);
        if ((++sp & 255u) == 0u) { if (xb_ld(&bar[XB_TMO])) break; if (sp > XB_SPIN_CAP) { atomicAdd(&bar[XB_TMO], 1u); break; } }
    }
    nloc = mine > 0u ? mine : 1u; nx = cnt > 0u ? cnt : 1u;
}
__device__ __forceinline__ void xcd_barrier(const XcdBarrier& b, int wv) {
    asm volatile("s_waitcnt vmcnt(0)" ::: "memory");
    __syncthreads();
    int lno; asm volatile("v_mbcnt_lo_u32_b32 %0, -1, 0\n\tv_mbcnt_hi_u32_b32 %0, -1, %0" : "=v"(lno));
    if (wv == 0 && lno == 0) {
        unsigned* bar = b.bar;
        __builtin_amdgcn_s_waitcnt(0);
        unsigned nloc = b.st[0], nx = b.st[1];
        if (nloc == 0u) { xcd_barrier_complete(bar, b.x, nloc, nx); b.st[0] = nloc; b.st[1] = nx; }
        const unsigned old = xb_add(&bar[XB_XSUB(b.x)], 1u);
        const unsigned gen = old / nloc;
        if (old + 1u == (gen + 1u) * nloc) {
            __builtin_amdgcn_fence(__ATOMIC_RELEASE, "agent");
            asm volatile("s_waitcnt vmcnt(0)" ::: "memory");
            const unsigned og = xb_add(&bar[XB_TOP], 1u);
            const unsigned tg = og / nx;
            if (og + 1u == (tg + 1u) * nx) xb_add(&bar[XB_TOPGEN], 1u);
            else XB_SPIN(xb_ld(&bar[XB_TOPGEN]) == tg, bar);
            __builtin_amdgcn_fence(__ATOMIC_ACQUIRE, "agent");
            xb_add(&bar[XB_XGEN(b.x)], 1u);
            asm volatile("s_waitcnt vmcnt(0)" ::: "memory");
        } else {
            XB_SPIN(xb_ld(&bar[XB_XGEN(b.x)]) == gen, bar);
            __builtin_amdgcn_fence(__ATOMIC_ACQUIRE, "agent");
            asm volatile("s_waitcnt vmcnt(0)" ::: "memory");
        }
    }
    __syncthreads();
}

__global__ void __launch_bounds__(512) fwd_megakernel(Params p) {
  extern __shared__ __attribute__((aligned(16))) unsigned char shm[];
  ldsp lds = (ldsp)shm;
  cg::grid_group grid = cg::this_grid();
  const int wv = __builtin_amdgcn_readfirstlane((int)(threadIdx.x >> 6));
  volatile LAS unsigned* xst = (volatile LAS unsigned*)(lds + LDS_BYTES - 16);
  if (threadIdx.x == 0) { xst[0] = 0u; xst[1] = 0u; }
  __syncthreads();
  const XcdBarrier xb = xcd_barrier_post(p.c.bar, xst);
#pragma unroll 1
  for (int pi = 0; pi < p.nph; ++pi) {
    const Phase& ph = p.ph[pi];
    switch (ph.type) {
      case PH_INIT:
#ifndef NO_INIT
      phase_init(wv, lds, p.c);
#endif
      break;
      case PH_NORM:
#ifndef NO_NORM
      phase_norm(wv, lds, ph, p.c);
#endif
      break;
      case PH_GEMM:
#ifndef NO_GEMM
      gemm_phase(wv, lds, ph, p.c);
#endif
      break;
      case PH_MCONV:
#ifndef NO_MCONV
      phase_mconv(wv, p.c);
#endif
      break;
      case PH_MA:
#ifndef NO_MA
      phase_ma(wv, lds, p.c);
#endif
      break;
      case PH_MB:
#ifndef NO_MB
      phase_mb(wv, p.c);
#endif
      break;
      case PH_MC:
#ifndef NO_MC
      phase_mc(wv, lds, p.c);
#endif
      break;
      case PH_RA:
#ifndef NO_RA
      phase_ra(wv, lds, ph, p.c);
#endif
      break;
      case PH_RB:
#ifndef NO_RB
      phase_rb(wv, ph, p.c);
#endif
      break;
      case PH_RC:
#ifndef NO_RC
      phase_rc(wv, lds, ph, p.c);
#endif
      break;
      case PH_FINAL: phase_final(wv, p.c); break;
      default: break;
    }
    if (p.nph > 100000) grid.sync();
    xcd_barrier(xb, wv);
  }
}

static void add_phase(Params& P, int type, int M, int N, int K, int i0, int i1, float f0, int pad, const void* A, const void* B, void* O, const void* X) {
  const int reps = (((DUP_TYPES >> type) & 1u) && (type != PH_GEMM || ((DUP_EPIS >> i0) & 1u))) ? 2 : 1;
  for (int rep = 0; rep < reps; ++rep) {
  Phase& ph = P.ph[P.nph++]; ph.type = type; ph.M = M; ph.N = N; ph.K = K; ph.i0 = i0; ph.i1 = i1; ph.f0 = f0; ph.pad = pad; ph.A = A; ph.B = B; ph.O = O; ph.X = X;
  }
}

extern "C" void kernel_launch(void* const* d_in, const int* in_sizes, int n_in, void* d_out, int out_size, void* d_ws, size_t ws_size, hipStream_t stream) {
  static int grid_blocks = 0;
  if (!grid_blocks) {
    int dev = 0, cus = 0, per_cu = 0;
    hipGetDevice(&dev);
    hipDeviceGetAttribute(&cus, hipDeviceAttributeMultiprocessorCount, dev);
    hipFuncSetAttribute((const void*)fwd_megakernel, hipFuncAttributeMaxDynamicSharedMemorySize, LDS_BYTES);
    hipOccupancyMaxActiveBlocksPerMultiprocessor(&per_cu, (const void*)fwd_megakernel, 512, LDS_BYTES);
    if (per_cu < 1) per_cu = 1;
    grid_blocks = cus * per_cu;
  }
  Params P; memset(&P, 0, sizeof(P));
  Ctx& c = P.c;
  c.x = (const float*)d_in[0]; c.c = (const float*)d_in[1]; c.ctx = (const float*)d_in[2]; c.c_ctx = (const float*)d_in[3];
  c.mod_w = (const float*)d_in[4]; c.mod_b = (const float*)d_in[5]; c.norm_g = (const float*)d_in[6]; c.w13 = (const float*)d_in[7]; c.w2 = (const float*)d_in[8];
  c.m_w_in = (const float*)d_in[9]; c.m_gate_b = (const float*)d_in[10]; c.m_conv_w = (const float*)d_in[11]; c.m_norm_g = (const float*)d_in[12]; c.m_w_out = (const float*)d_in[13];
  c.r_w_in = (const float*)d_in[14]; c.r_decay = (const float*)d_in[15]; c.r_norm_g = (const float*)d_in[16]; c.r_w_out = (const float*)d_in[17]; c.final_g = (const float*)d_in[18];
  c.out = (float*)d_out; c.y = (u16*)d_out;
  char* w = (char*)d_ws; size_t off = 0;
  auto take = [&](size_t bytes) { char* r = w + off; off += (bytes + 255) & ~(size_t)255; return r; };
  c.bar = (unsigned*)take((size_t)XCD_BAR_WORDS * 4);
  c.modv = (float*)take((size_t)2 * 5 * 9216 * 4);
  c.rope = (float*)take((size_t)8192 * 128 * 8);
  c.gates = (float*)take((size_t)NT * 32 * 4);
  c.mst_n = (float*)take((size_t)64 * 66 * 64 * 4);
  c.mst_s = (float*)take((size_t)3 * 4224 * 4);
  c.xr = (float*)take((size_t)NT * 1024 * 4);
  c.hb = (u16*)take((size_t)NT * 1024 * 2);
  c.wb = (u16*)take((size_t)(5632 + 2816) * 1024 * 2);
  c.big = (u16*)take((size_t)NT * 3072 * 2 + (size_t)64 * 66 * 8192 * 2);
  c.part = (float*)((char*)c.big + (size_t)NT * 2816 * 2);
  c.part2 = (float*)take((size_t)4 * 1024 * 1024 * 4);
  if (off > ws_size) { fprintf(stderr, "workspace too small: need %zu have %zu\n", off, ws_size); return; }
  u16* hid = c.big;
  for (int l = 0; l < 2; ++l) {
    if (l == 0) add_phase(P, PH_INIT, 0, 0, 0, 0, 0, 0.f, 0, nullptr, nullptr, nullptr, nullptr);
    const float* modl = c.modv + (size_t)l * 5 * 9216;
    add_phase(P, PH_NORM, NT, l == 0 ? 1 : (NSPL << 8), 0, l, 0, 0.5f, 0, nullptr, nullptr, nullptr, c.modv + 8 * 1024);
    add_phase(P, PH_GEMM, NT, 5632, 1024, EPI_SWIGLU, 0, 0.f, 0, c.hb, c.wb, hid, nullptr);
    add_phase(P, PH_GEMM, NT, 1024, 2816, EPI_RESID, SPLITF | (l == 0 ? 2 : 0), 0.5f, 0, hid, c.wb + (size_t)5632 * 1024, c.xr, modl + 2 * 1024);
    if (l == 0) {
      add_phase(P, PH_NORM, NT, NSPL << 8, 0, l, 1, 0.5f, 1, nullptr, nullptr, nullptr, modl + 2 * 1024);
      add_phase(P, PH_GEMM, NT, 3328, 1024, EPI_MLSTM_U, 0, 0.f, 0, c.hb, c.wb, c.big, nullptr);
      add_phase(P, PH_MCONV, 0, 0, 0, 0, 0, 0.f, 0, nullptr, nullptr, nullptr, nullptr);
      add_phase(P, PH_MA, 0, 0, 0, 0, 0, 0.f, 0, nullptr, nullptr, nullptr, nullptr);
      add_phase(P, PH_MB, 0, 0, 0, 0, 0, 0.f, 0, nullptr, nullptr, nullptr, nullptr);
      add_phase(P, PH_MC, 0, 0, 0, 0, 0, 0.f, 0, nullptr, nullptr, nullptr, nullptr);
      add_phase(P, PH_GEMM, NT, 1024, 1024, EPI_RESID, 1 | 4, 1.0f, 0, c.y, c.wb + (size_t)3328 * 1024, c.xr, modl + 5 * 1024);
    } else {
      add_phase(P, PH_NORM, NT, NSPL << 8, 0, l, 1, 0.5f, 2, nullptr, nullptr, nullptr, modl + 2 * 1024);
      for (int hp = 0; hp < 2; ++hp) {
        add_phase(P, PH_GEMM, NT, 2048, 1024, EPI_RET_U, 0, 0.f, 0, c.hb, c.wb + (size_t)hp * 2048 * 1024, c.big, nullptr);
        add_phase(P, PH_RA, 0, 0, 0, hp, 0, 0.f, 0, nullptr, nullptr, nullptr, nullptr);
        add_phase(P, PH_RB, 0, 0, 0, hp, 0, 0.f, 0, nullptr, nullptr, nullptr, nullptr);
        add_phase(P, PH_RC, 0, 0, 0, hp, 0, 0.f, 0, nullptr, nullptr, nullptr, nullptr);
      }
      add_phase(P, PH_GEMM, NL, 2048, 1024, EPI_GATE, 0, 0.f, 0, c.hb, c.wb + (size_t)4096 * 1024, c.y, nullptr);
      add_phase(P, PH_GEMM, NL, 1024, 2048, EPI_RESID, 0, 1.0f, 0, c.y, c.wb + (size_t)6144 * 1024, c.xr, modl + 5 * 1024);
    }
    const int M2 = l == 1 ? NL : NT;
    add_phase(P, PH_NORM, M2, l == 0 ? ((4 << 8) | 2) : 0, 1, l, 2, 1.0f, 0, nullptr, nullptr, nullptr, modl + 5 * 1024);
    add_phase(P, PH_GEMM, M2, 5632, 1024, EPI_SWIGLU, 0, 0.f, 0, c.hb, c.wb, hid, nullptr);
    add_phase(P, PH_GEMM, M2, 1024, 2816, EPI_RESID, l == 0 ? SPLITF : 0, 0.5f, 0, hid, c.wb + (size_t)5632 * 1024, c.xr, modl + 8 * 1024);
  }
#ifdef EXTRA_NOPS
  for (int q = 0; q < EXTRA_NOPS; ++q) add_phase(P, PH_NOP, 0, 0, 0, 0, 0, 0.f, 0, nullptr, nullptr, nullptr, nullptr);
#endif
  add_phase(P, PH_FINAL, 0, 0, 0, 0, 0, 0.f, 0, nullptr, nullptr, nullptr, nullptr);
  hipMemsetAsync(c.bar, 0, (size_t)XCD_BAR_WORDS * 4, stream);
  void* args[] = {&P};
  hipError_t e = hipLaunchCooperativeKernel((const void*)fwd_megakernel, dim3(grid_blocks), dim3(512), args, LDS_BYTES, stream);
  if (e != hipSuccess) fprintf(stderr, "cooperative launch failed: %s (grid %d)\n", hipGetErrorString(e), grid_blocks);
}
```

```cpp
#include <hip/hip_runtime.h>
#include <hip/hip_cooperative_groups.h>
#include <cstdio>
#include <cstring>
namespace cg = cooperative_groups;

typedef unsigned short u16;
typedef short bf16x8 __attribute__((ext_vector_type(8)));
typedef short s16x4 __attribute__((ext_vector_type(4)));
typedef float f32x4 __attribute__((ext_vector_type(4)));
typedef unsigned u32x4 __attribute__((ext_vector_type(4)));
typedef unsigned u32x2 __attribute__((ext_vector_type(2)));
#define LAS __attribute__((address_space(3)))
typedef LAS unsigned char* ldsp;

#define NT 33792
#define NL 32768
#define LDS_BYTES 155648

enum { PH_INIT = 0, PH_NORM, PH_GEMM, PH_MCONV, PH_MA, PH_MB, PH_MC, PH_RA, PH_RB, PH_RC, PH_FINAL, PH_NOP };
enum { EPI_SWIGLU = 0, EPI_RESID, EPI_MLSTM_U, EPI_RET_U, EPI_GATE };

struct Phase { int type, M, N, K; int i0, i1; float f0; int pad; const void* A; const void* B; void* O; const void* X; };
#define MAXPH 56
#ifndef SPLITF
#define SPLITF 1
#endif
#define NSPL (SPLITF ? 11 : 0)
#ifndef DUP_TYPES
#define DUP_TYPES 0u
#endif
#ifndef DUP_EPIS
#define DUP_EPIS 0u
#endif
struct Ctx {
  const float *x, *c, *ctx, *c_ctx, *mod_w, *mod_b, *norm_g, *w13, *w2, *m_w_in, *m_gate_b, *m_conv_w, *m_norm_g, *m_w_out, *r_w_in, *r_decay, *r_norm_g, *r_w_out, *final_g;
  float* out; float* modv; float* rope; float* gates; float* mst_n; float* mst_s; float* xr;
  u16* hb; u16* wb; u16* big; u16* y; unsigned* bar; float* part; float* part2;
};
struct Params { Ctx c; int nph; int pad; Phase ph[MAXPH]; };

typedef __bf16 bf16x2_t __attribute__((ext_vector_type(2)));
__device__ __forceinline__ u16 f2bf(float f) { return __builtin_bit_cast(u16, (__bf16)f); }
__device__ __forceinline__ float bf2f(u16 b) { return __uint_as_float(((unsigned)b) << 16); }
__device__ __forceinline__ unsigned pack2(float a, float b) { bf16x2_t v; v[0] = (__bf16)a; v[1] = (__bf16)b; return __builtin_bit_cast(unsigned, v); }
__device__ __forceinline__ float lo2f(unsigned w) { return __uint_as_float(w << 16); }
__device__ __forceinline__ float hi2f(unsigned w) { return __uint_as_float(w & 0xffff0000u); }
__device__ __forceinline__ float4 ldnt4(const float4* p) { const f32x4 v = __builtin_nontemporal_load((const f32x4*)p); return make_float4(v[0], v[1], v[2], v[3]); }
__device__ __forceinline__ void stnt4(float4* p, float4 v) { f32x4 t; t[0] = v.x; t[1] = v.y; t[2] = v.z; t[3] = v.w; __builtin_nontemporal_store(t, (f32x4*)p); }
__device__ __forceinline__ float siluf(float a) { return a * __builtin_amdgcn_rcpf(1.f + __expf(-a)); }
__device__ __forceinline__ float sigmf(float a) { return __builtin_amdgcn_rcpf(1.f + __expf(-a)); }
__device__ __forceinline__ float logsig(float a) { return fminf(a, 0.f) - log1pf(expf(-fabsf(a))); }

__device__ __forceinline__ bf16x8 frag_row(ldsp base, int pitch, int idx0, int k0, int lane) {
  return *(const LAS bf16x8*)(base + (idx0 + (lane & 15)) * pitch + (k0 + 8 * (lane >> 4)) * 2);
}
__device__ __forceinline__ bf16x8 frag_tr(ldsp base, int pitch, int idx0, int k0, int lane) {
  const int g = lane >> 4, li = lane & 15, q = li >> 2, p = li & 3;
  ldsp a = base + (k0 + 8 * g + q) * pitch + (idx0 + 4 * p) * 2;
  s16x4 lo = __builtin_amdgcn_ds_read_tr16_b64_v4i16((LAS s16x4*)a);
  s16x4 hi = __builtin_amdgcn_ds_read_tr16_b64_v4i16((LAS s16x4*)(a + 4 * pitch));
  bf16x8 r; r[0] = lo[0]; r[1] = lo[1]; r[2] = lo[2]; r[3] = lo[3]; r[4] = hi[0]; r[5] = hi[1]; r[6] = hi[2]; r[7] = hi[3]; return r;
}
#define LDS_BAR() do { asm volatile("s_waitcnt lgkmcnt(0)" ::: "memory"); __builtin_amdgcn_s_barrier(); asm volatile("" ::: "memory"); } while (0)
#define SWEEP(NT, DEPTH, FRAG, A, ACC) do { bf16x8 bq_[DEPTH]; \
    _Pragma("unroll") for (int n_ = 0; n_ < DEPTH; ++n_) bq_[n_] = FRAG(n_); __builtin_amdgcn_sched_barrier(0); \
    _Pragma("unroll") for (int n_ = 0; n_ < NT; ++n_) { const bf16x8 cur_ = bq_[n_ % DEPTH]; if (n_ + DEPTH < NT) bq_[n_ % DEPTH] = FRAG(n_ + DEPTH); ACC[n_] = MFMA16(A, cur_, ACC[n_]); __builtin_amdgcn_sched_barrier(0); } } while (0)
#define MFMA16(a, b, c) __builtin_amdgcn_mfma_f32_16x16x32_bf16((a), (b), (c), 0, 0, 0)
__device__ __forceinline__ float shx(float v, int m, int lane) { return __int_as_float(__builtin_amdgcn_ds_bpermute((lane ^ m) << 2, __float_as_int(v))); }
__device__ __forceinline__ float shup(float v, int d, int lane, float ident) { const int src = lane - d; const float r = __int_as_float(__builtin_amdgcn_ds_bpermute(src << 2, __float_as_int(v))); return src >= 0 ? r : ident; }
__device__ __forceinline__ float shdn(float v, int d, int lane, float ident) { const int src = lane + d; const float r = __int_as_float(__builtin_amdgcn_ds_bpermute(src << 2, __float_as_int(v))); return src < 64 ? r : ident; }
__device__ __forceinline__ float lane63(float v) { return __int_as_float(__builtin_amdgcn_readlane(__float_as_int(v), 63)); }
__device__ __forceinline__ float red16l(float v, int lane) { v += shx(v, 1, lane); v += shx(v, 2, lane); v += shx(v, 4, lane); v += shx(v, 8, lane); return v; }

namespace pg8 {
constexpr int BM = 256, BK = 64, HALF = 128, HTB = HALF * BK * 2, NXCD = 8, WGM = 8;
__device__ __forceinline__ int lds_byte(int r, int c) { const int st = (r >> 4) * 2 + (c >> 5), rr = r & 15, cc = c & 31, ob = rr * 64 + cc * 2; return st * 1024 + (ob ^ (((ob >> 9) & 1) << 5)); }
__device__ __forceinline__ void stage_rc(int b, int& R, int& C) { const int st = b / 1024, sb = b % 1024, swz = sb ^ (((sb >> 9) & 1) << 5); R = (st >> 1) * 16 + swz / 64; C = (st & 1) * 32 + (swz % 64) / 2; }
struct Unit { int pm, pn, k0, nt, at; };
struct StaticOrder {
  int nM, nN, nwg, G, c, nsplit, nsu, ntf;
  __device__ void init(int M, int N, int K, int split, int G_, int c_) { nM = M / BM; nN = N / BM; nsplit = 0; nsu = 0; ntf = K / BK;
    if (split) { nM = NL / BM; nsplit = K / 256; nsu = (M / BM - nM) * nN * nsplit; }
    nwg = nM * nN; G = G_; c = c_; }
  __device__ bool next(int i, Unit& u) const {
    const long L = (long)i * G + c;
    int pm = 0, pn = 0, k0 = 0, nt = ntf, at = 0; bool ok = true;
    if (L >= nwg) {
      const long s = L - nwg;
      if (s >= nsu) ok = false;
      else { const int ks = (int)(s % nsplit), r = (int)(s / nsplit); pn = r % nN; pm = nM + r / nN; k0 = ks * 256; nt = 4; at = ks + 1; }
    } else {
      int wgid = (int)L; { const int q = nwg / NXCD, r = nwg % NXCD, xcd = wgid % NXCD, off = wgid / NXCD; wgid = (xcd < r ? xcd * (q + 1) : r * (q + 1) + (xcd - r) * q) + off; }
      const int nig = WGM * nN, gid = wgid / nig, fm = gid * WGM, gsz = (nM - fm) < WGM ? (nM - fm) : WGM;
      pm = fm + ((wgid % nig) % gsz); pn = (wgid % nig) / gsz;
    }
    u.pm = pm; u.pn = pn; u.k0 = k0; u.nt = nt; u.at = at; return ok;
  }
};
}

__device__ __forceinline__ int perm32(int rho) { const int n = rho >> 4, i = rho & 15; return 8 * (i >> 2) + 4 * n + (i & 3); }
__device__ __forceinline__ void epi_apply(const Phase& ph, const Ctx& c, const f32x4 (&acc)[2][2][4][2], int pm, int pn, int at, int wr, int wc, int fr, int fq) {
  const int row0 = pm * 256 + wr * 64 + fr;
  const int epi = ph.i0;
  if (epi == EPI_SWIGLU) {
    u16* O = (u16*)ph.O;
    const int hc = pn * 128 + wc * 32 + fq * 8;
#pragma unroll
    for (int ai = 0; ai < 2; ++ai)
#pragma unroll
      for (int m = 0; m < 4; ++m) {
        const size_t row = row0 + ai * 128 + m * 16;
        const f32x4 a0 = acc[ai][0][m][0], b0 = acc[ai][1][m][0], a1 = acc[ai][0][m][1], b1 = acc[ai][1][m][1];
        u32x4 o; o.x = pack2(siluf(a0[0]) * b0[0], siluf(a0[1]) * b0[1]); o.y = pack2(siluf(a0[2]) * b0[2], siluf(a0[3]) * b0[3]);
        o.z = pack2(siluf(a1[0]) * b1[0], siluf(a1[1]) * b1[1]); o.w = pack2(siluf(a1[2]) * b1[2], siluf(a1[3]) * b1[3]);
        *(u32x4*)(O + row * 2816 + hc) = o;
      }
  } else if (epi == EPI_RESID) {
    float* X = (float*)ph.O; const float* gate = (const float*)ph.X; const float f0 = ph.f0;
    const int r256 = pm * 256; const int set = r256 < NL ? (r256 >> 13) : 4;
    const float* Xs = ((ph.i1 & 2) && r256 < NL) ? c.x : (const float*)X;
    gate += (size_t)set * 9216;
    if (ph.i1 & 16) {
      u16* D = c.hb;
#pragma unroll
      for (int bj = 0; bj < 2; ++bj)
#pragma unroll
        for (int n = 0; n < 2; ++n) {
          const int col = pn * 256 + bj * 128 + wc * 32 + n * 16 + fq * 4;
          const f32x4 g = *(const f32x4*)(gate + col);
#pragma unroll
          for (int ai = 0; ai < 2; ++ai)
#pragma unroll
            for (int m = 0; m < 4; ++m) { const size_t row = row0 + ai * 128 + m * 16; const f32x4 a4 = acc[ai][bj][m][n];
              u32x2 o; o.x = pack2(f0 * g[0] * a4[0], f0 * g[1] * a4[1]); o.y = pack2(f0 * g[2] * a4[2], f0 * g[3] * a4[3]);
              *(u32x2*)(D + row * 1024 + col) = o; }
        }
    } else if (at) {
      float* P = ((ph.i1 & 4) ? c.part2 : c.part) + ((size_t)(at - 1) * 1024 - NL) * 1024;
#pragma unroll
      for (int bj = 0; bj < 2; ++bj)
#pragma unroll
        for (int n = 0; n < 2; ++n) {
          const int col = pn * 256 + bj * 128 + wc * 32 + n * 16 + fq * 4;
#pragma unroll
          for (int ai = 0; ai < 2; ++ai)
#pragma unroll
            for (int m = 0; m < 4; ++m) { const size_t row = row0 + ai * 128 + m * 16; *(f32x4*)(P + row * 1024 + col) = acc[ai][bj][m][n]; }
        }
    } else {
#pragma unroll
      for (int bj = 0; bj < 2; ++bj)
#pragma unroll
        for (int n = 0; n < 2; ++n) {
          const int col = pn * 256 + bj * 128 + wc * 32 + n * 16 + fq * 4;
          const f32x4 g = *(const f32x4*)(gate + col);
#pragma unroll
          for (int ai = 0; ai < 2; ++ai)
#pragma unroll
            for (int m = 0; m < 4; ++m) {
              const size_t row = row0 + ai * 128 + m * 16;
              f32x4 xv = *(const f32x4*)(Xs + row * 1024 + col); const f32x4 a = acc[ai][bj][m][n];
              xv[0] += f0 * g[0] * a[0]; xv[1] += f0 * g[1] * a[1]; xv[2] += f0 * g[2] * a[2]; xv[3] += f0 * g[3] * a[3];
              *(f32x4*)(X + row * 1024 + col) = xv;
            }
        }
    }
  } else if (epi == EPI_MLSTM_U) {
    if (pn < 12) {
      u16* O = (u16*)ph.O;
#pragma unroll
      for (int ai = 0; ai < 2; ++ai)
#pragma unroll
        for (int m = 0; m < 4; ++m) {
          const size_t row = row0 + ai * 128 + m * 16;
#pragma unroll
          for (int bj = 0; bj < 2; ++bj) {
            const int col = pn * 256 + bj * 128 + wc * 32 + fq * 8; const f32x4 a0 = acc[ai][bj][m][0], a1 = acc[ai][bj][m][1];
            u32x4 o; o.x = pack2(a0[0], a0[1]); o.y = pack2(a0[2], a0[3]); o.z = pack2(a1[0], a1[1]); o.w = pack2(a1[2], a1[3]);
            *(u32x4*)(O + row * 3072 + col) = o;
          }
        }
    } else if (wc == 0) {
      float* G = c.gates; const float* gb = c.m_gate_b;
#pragma unroll
      for (int n = 0; n < 2; ++n) {
        const int col = fq * 8 + n * 4; const f32x4 b = *(const f32x4*)(gb + col);
#pragma unroll
        for (int ai = 0; ai < 2; ++ai)
#pragma unroll
          for (int m = 0; m < 4; ++m) {
            const size_t row = row0 + ai * 128 + m * 16; const f32x4 a = acc[ai][0][m][n];
            f32x4 o; o[0] = a[0] + b[0]; o[1] = a[1] + b[1]; o[2] = a[2] + b[2]; o[3] = a[3] + b[3];
            *(f32x4*)(G + row * 32 + col) = o;
          }
      }
    }
  } else if (epi == EPI_RET_U) {
    u16* O = (u16*)ph.O; const float* rope = c.rope;
    const bool dorope = (pn < 4) && (pm * 256 < NL);
#pragma unroll
    for (int ai = 0; ai < 2; ++ai)
#pragma unroll
      for (int m = 0; m < 4; ++m) {
        const size_t row = row0 + ai * 128 + m * 16; const int t = (int)(row & 8191);
#pragma unroll
        for (int bj = 0; bj < 2; ++bj) {
          const int col = pn * 256 + bj * 128 + wc * 32 + fq * 8; f32x4 a0 = acc[ai][bj][m][0], a1 = acc[ai][bj][m][1];
          if (dorope) {
            const int p0 = (col & 255) >> 1;
            const f32x4 c0 = *(const f32x4*)(rope + ((size_t)t * 128 + p0) * 2), c1 = *(const f32x4*)(rope + ((size_t)t * 128 + p0) * 2 + 4);
            const float e0 = a0[0] * c0[0] - a0[1] * c0[1], o0 = a0[0] * c0[1] + a0[1] * c0[0];
            const float e1 = a0[2] * c0[2] - a0[3] * c0[3], o1 = a0[2] * c0[3] + a0[3] * c0[2];
            const float e2 = a1[0] * c1[0] - a1[1] * c1[1], o2 = a1[0] * c1[1] + a1[1] * c1[0];
            const float e3 = a1[2] * c1[2] - a1[3] * c1[3], o3 = a1[2] * c1[3] + a1[3] * c1[2];
            a0[0] = e0; a0[1] = o0; a0[2] = e1; a0[3] = o1; a1[0] = e2; a1[1] = o2; a1[2] = e3; a1[3] = o3;
          }
          u32x4 o; o.x = pack2(a0[0], a0[1]); o.y = pack2(a0[2], a0[3]); o.z = pack2(a1[0], a1[1]); o.w = pack2(a1[2], a1[3]);
          *(u32x4*)(O + row * 2048 + col) = o;
        }
      }
  } else {
    u16* O = (u16*)ph.O;
#pragma unroll
    for (int ai = 0; ai < 2; ++ai)
#pragma unroll
      for (int m = 0; m < 4; ++m) {
        const size_t row = row0 + ai * 128 + m * 16;
#pragma unroll
        for (int bj = 0; bj < 2; ++bj) {
          const int col = pn * 256 + bj * 128 + wc * 32 + fq * 8; const f32x4 a0 = acc[ai][bj][m][0], a1 = acc[ai][bj][m][1];
          u32x4* yp = (u32x4*)(O + row * 2048 + col); u32x4 yv = *yp;
          yv.x = pack2(lo2f(yv.x) * siluf(a0[0]), hi2f(yv.x) * siluf(a0[1])); yv.y = pack2(lo2f(yv.y) * siluf(a0[2]), hi2f(yv.y) * siluf(a0[3]));
          yv.z = pack2(lo2f(yv.z) * siluf(a1[0]), hi2f(yv.z) * siluf(a1[1])); yv.w = pack2(lo2f(yv.w) * siluf(a1[2]), hi2f(yv.w) * siluf(a1[3]));
          *yp = yv;
        }
      }
  }
}

__device__ __forceinline__ void gemm_phase(int wv, ldsp lds, const Phase& ph, const Ctx& c) {
  using namespace pg8;
  int wvo = wv; asm volatile("" : "+s"(wvo)); int lno; asm volatile("v_mbcnt_lo_u32_b32 %0, -1, 0\n\tv_mbcnt_hi_u32_b32 %0, -1, %0" : "=v"(lno)); int tid = (wvo << 6) | lno; const int wid = __builtin_amdgcn_readfirstlane(tid >> 6), lane = tid & 63, wr = wid >> 2, wc = wid & 3, fr = lane & 15, fq = lane >> 4;
  const int K = ph.K;
  StaticOrder S; S.init(ph.M, ph.N, ph.K, ph.i1 & 1, gridDim.x, blockIdx.x);
  unsigned voffA[2];
#pragma unroll
  for (int i = 0; i < 2; ++i) { int R, C; stage_rc(tid * 16 + i * 8192, R, C); voffA[i] = (unsigned)(R * K + C) * 2u; }
  const size_t kstep = (size_t)(BK * 2);
  const size_t hstep = (size_t)HALF * K * 2;
  const size_t tstep = 2 * hstep;
  const unsigned ldsw = (unsigned)wid * 1024u;
  const int aoff = lds_byte(wr * 64 + fr, fq * 8), boff = lds_byte(wc * 32 + fr, fq * 8);
#define PG8_SA(b, h) (((b) * 2 + (h)) * HTB)
#define PG8_SB(b, h) ((4 + (b) * 2 + (h)) * HTB)
#define PG8_STAGE(bufoff, gbase, voff) do { _Pragma("unroll") for (int _i = 0; _i < 2; ++_i) \
    __builtin_amdgcn_global_load_lds((const unsigned*)((const char*)(gbase) + (voff)[_i]), (LAS unsigned*)(lds + (bufoff) + ldsw + _i * 8192), 16, 0, 0); } while (0)
#define PG8_LDA(dst, b, h) do { _Pragma("unroll") for (int m = 0; m < 4; ++m) _Pragma("unroll") for (int k = 0; k < 2; ++k) dst[m][k] = *(const LAS bf16x8*)(lds + PG8_SA(b, h) + aoff + m * 2048 + k * 1024); } while (0)
#define PG8_LDB(dst, b, h) do { _Pragma("unroll") for (int n = 0; n < 2; ++n) _Pragma("unroll") for (int k = 0; k < 2; ++k) dst[n][k] = *(const LAS bf16x8*)(lds + PG8_SB(b, h) + boff + n * 2048 + k * 1024); } while (0)
#define PG8_MMA(ai, bj, At, Bt) do { __builtin_amdgcn_s_setprio(1); _Pragma("unroll") for (int m = 0; m < 4; ++m) _Pragma("unroll") for (int n = 0; n < 2; ++n) _Pragma("unroll") for (int k = 0; k < 2; ++k) \
    acc[ai][bj][m][n] = __builtin_amdgcn_mfma_f32_16x16x32_bf16(Bt[n][k], At[m][k], acc[ai][bj][m][n], 0, 0, 0); __builtin_amdgcn_s_setprio(0); } while (0)
#define PG8_WAIT_V(n) asm volatile("s_waitcnt vmcnt(" #n ")" ::: "memory")
#define PG8_WAIT_L(n) asm volatile("s_waitcnt lgkmcnt(" #n ")" ::: "memory")
#define PG8_BAR __builtin_amdgcn_s_barrier()
#define PG8_SCHED __builtin_amdgcn_sched_barrier(0)
  Unit cur, nxt; int ui = 0;
  if (!S.next(0, cur)) return;
  f32x4 acc[2][2][4][2];
#pragma unroll
  for (int a = 0; a < 2; ++a)
#pragma unroll
    for (int b = 0; b < 2; ++b)
#pragma unroll
      for (int m = 0; m < 4; ++m)
#pragma unroll
        for (int n = 0; n < 2; ++n) acc[a][b][m][n] = (f32x4){0.f, 0.f, 0.f, 0.f};
  bf16x8 At[4][2], B0[2][2], B1[2][2];
  const char* cA = (const char*)ph.A + (size_t)cur.pm * tstep + (size_t)cur.k0 * 2; const char* cB = (const char*)ph.B + (size_t)cur.pn * tstep + (size_t)cur.k0 * 2;
  PG8_STAGE(PG8_SB(0, 0), cB, voffA); PG8_STAGE(PG8_SA(0, 0), cA, voffA); PG8_STAGE(PG8_SB(0, 1), cB + hstep, voffA); PG8_STAGE(PG8_SA(0, 1), cA + hstep, voffA);
  if (wr == 1) PG8_BAR;
  PG8_WAIT_V(4); PG8_BAR;
  PG8_STAGE(PG8_SB(1, 0), cB + kstep, voffA); PG8_STAGE(PG8_SA(1, 0), cA + kstep, voffA); PG8_STAGE(PG8_SB(1, 1), cB + hstep + kstep, voffA);
  PG8_WAIT_V(6); PG8_BAR;
  for (;;) {
    const bool has_next = S.next(ui + 1, nxt);
    const char* nA = has_next ? (const char*)ph.A + (size_t)nxt.pm * tstep + (size_t)nxt.k0 * 2 : cA; const char* nB = has_next ? (const char*)ph.B + (size_t)nxt.pn * tstep + (size_t)nxt.k0 * 2 : cB;
    const int nt = cur.nt;
    asm volatile(".p2align 8");
    for (int t = 0; t < nt; t += 2) {
      const bool last = (t == nt - 2);
      const char* a1 = cA + (size_t)(t + 1) * kstep;
      const char* a2 = last ? nA : cA + (size_t)(t + 2) * kstep; const char* b2 = last ? nB : cB + (size_t)(t + 2) * kstep;
      const char* a3 = a2 + kstep; const char* b3 = b2 + kstep;
      PG8_LDB(B0, 0, 0); PG8_SCHED; PG8_LDA(At, 0, 0); PG8_STAGE(PG8_SA(1, 1), a1 + hstep, voffA);
      PG8_WAIT_L(8); PG8_BAR; PG8_WAIT_L(0); PG8_MMA(0, 0, At, B0); PG8_BAR; PG8_SCHED;
      PG8_LDB(B1, 0, 1); PG8_STAGE(PG8_SB(0, 0), b2, voffA);
      PG8_BAR; PG8_WAIT_L(0); PG8_MMA(0, 1, At, B1); PG8_BAR;
      PG8_LDA(At, 0, 1); PG8_STAGE(PG8_SA(0, 0), a2, voffA);
      PG8_BAR; PG8_WAIT_L(0); PG8_MMA(1, 0, At, B0); PG8_BAR; PG8_SCHED;
      PG8_STAGE(PG8_SB(0, 1), b2 + hstep, voffA);
      PG8_WAIT_V(6); PG8_BAR; PG8_MMA(1, 1, At, B1); PG8_BAR;
      PG8_LDB(B0, 1, 0); PG8_SCHED; PG8_LDA(At, 1, 0); PG8_STAGE(PG8_SA(0, 1), a2 + hstep, voffA);
      PG8_WAIT_L(8); PG8_BAR; PG8_WAIT_L(0); PG8_MMA(0, 0, At, B0); PG8_BAR; PG8_SCHED;
      PG8_LDB(B1, 1, 1); PG8_STAGE(PG8_SB(1, 0), b3, voffA);
      PG8_BAR; PG8_WAIT_L(0); PG8_MMA(0, 1, At, B1); PG8_BAR;
      PG8_LDA(At, 1, 1); PG8_STAGE(PG8_SA(1, 0), a3, voffA);
      PG8_BAR; PG8_WAIT_L(0); PG8_MMA(1, 0, At, B0); PG8_BAR; PG8_SCHED;
      PG8_STAGE(PG8_SB(1, 1), b3 + hstep, voffA);
      PG8_WAIT_V(6); PG8_BAR; PG8_MMA(1, 1, At, B1); PG8_BAR;
    }
    epi_apply(ph, c, acc, cur.pm, cur.pn, cur.at, wr, wc, fr, fq);
    if (!has_next) break;
#pragma unroll
    for (int a = 0; a < 2; ++a)
#pragma unroll
      for (int b = 0; b < 2; ++b)
#pragma unroll
        for (int m = 0; m < 4; ++m)
#pragma unroll
          for (int n = 0; n < 2; ++n) acc[a][b][m][n] = (f32x4){0.f, 0.f, 0.f, 0.f};
    cur = nxt; cA = nA; cB = nB; ++ui;
  }
  PG8_WAIT_V(0);
  if (wr == 0) PG8_BAR;
  PG8_BAR;
}

__device__ void phase_init(int wv, ldsp lds, const Ctx& c) {
  int wvo = wv; asm volatile("" : "+s"(wvo)); int lno; asm volatile("v_mbcnt_lo_u32_b32 %0, -1, 0\n\tv_mbcnt_hi_u32_b32 %0, -1, %0" : "=v"(lno)); int tid = (wvo << 6) | lno; const int wid = tid >> 6, lane = tid & 63;
  LAS float* sc = (LAS float*)lds;
  LAS float* red = (LAS float*)(lds + 20480);
  for (int i = tid; i < 5120; i += 512) { const int s = i >> 10, k = i & 1023; const float v = s < 4 ? c.c[s * 1024 + k] : c.c_ctx[k]; sc[i] = siluf(v); }
  __syncthreads();
  for (int item = blockIdx.x; item < 288; item += gridDim.x) {
    const int l = item / 144, j0 = (item % 144) * 64;
    const float* w = c.mod_w + (size_t)l * 1024 * 9216 + j0 + lane;
    float a0 = 0, a1 = 0, a2 = 0, a3 = 0, a4 = 0;
    for (int k = wid * 128; k < wid * 128 + 128; ++k) {
      const float wv = w[(size_t)k * 9216];
      a0 += sc[k] * wv; a1 += sc[1024 + k] * wv; a2 += sc[2048 + k] * wv; a3 += sc[3072 + k] * wv; a4 += sc[4096 + k] * wv;
    }
    red[(wid * 5 + 0) * 64 + lane] = a0; red[(wid * 5 + 1) * 64 + lane] = a1; red[(wid * 5 + 2) * 64 + lane] = a2; red[(wid * 5 + 3) * 64 + lane] = a3; red[(wid * 5 + 4) * 64 + lane] = a4;
    __syncthreads();
    if (tid < 320) { const int s = tid >> 6; float v = 0; for (int ww = 0; ww < 8; ++ww) v += red[(ww * 5 + s) * 64 + lane];
      c.modv[(size_t)(l * 5 + s) * 9216 + j0 + lane] = v + c.mod_b[l * 9216 + j0 + lane]; }
    __syncthreads();
  }
  const size_t gt = (size_t)blockIdx.x * 512 + tid, gs = (size_t)gridDim.x * 512;
  for (size_t i = gt; i < (size_t)8192 * 128; i += gs) {
    const int t = (int)(i >> 7), p = (int)(i & 127); const int f = p & 63; const int pos = p < 64 ? (t >> 6) : (t & 63);
    const double inv = (double)exp2f(-(float)f * 0.20762050593046015f);
    const double rev = (double)pos * inv * 0.15915494309189535; const float fr = (float)(rev - rint(rev));
    c.rope[i * 2] = __builtin_amdgcn_cosf(fr); c.rope[i * 2 + 1] = __builtin_amdgcn_sinf(fr);
  }
  const float4* cs = (const float4*)c.ctx; float4* xd = (float4*)c.xr;
  for (size_t i = gt; i < (size_t)(NT - NL) * 256; i += gs) xd[(size_t)NL * 256 + i] = cs[i];
}

struct TileD { const float* src; u16* dst; int ld, nvalid, sc0, K, n0, k0, perm; float scale; };
__device__ __forceinline__ void tile_desc(const Ctx& c, int kind, int l, int f, int it, TileD& d) {
  const float* src; u16* dst; int ld, nvalid, sc0, K, n0, k0, perm = 1; float scale = 1.f;
  if (kind == 0) {
    if (it < 1408) { const int nb = it >> 4, kb = it & 15; const int pn = nb >> 2, q = nb & 3;
      src = c.w13 + (size_t)(l * 2 + f) * 1024 * 5632; dst = c.wb; ld = 5632; nvalid = 5632; sc0 = (q < 2 ? 0 : 2816) + 128 * pn + (q & 1) * 64; K = 1024; n0 = nb * 64; k0 = kb * 64; }
    else { const int i2 = it - 1408; const int nb = i2 / 44, kb = i2 % 44;
      perm = 0; src = c.w2 + (size_t)(l * 2 + f) * 2816 * 1024; dst = c.wb + (size_t)5632 * 1024; ld = 1024; nvalid = 1024; sc0 = nb * 64; K = 2816; n0 = nb * 64; k0 = kb * 64; }
  } else if (kind == 1) {
    if (it < 832) { const int nb = it >> 4, kb = it & 15; src = c.m_w_in; dst = c.wb; ld = 3104; nvalid = 3104; sc0 = nb * 64; K = 1024; n0 = nb * 64; k0 = kb * 64; }
    else { const int i2 = it - 832; const int nb = i2 >> 4, kb = i2 & 15; perm = 0; src = c.m_w_out; dst = c.wb + (size_t)3328 * 1024; ld = 1024; nvalid = 1024; sc0 = nb * 64; K = 1024; n0 = nb * 64; k0 = kb * 64; }
  } else {
    if (it < 1536) { const int nb = it >> 4, kb = it & 15; const int n = nb * 64; int s0;
      if (n < 4096) { const int hp = n >> 11, r = n & 2047; if (r < 512) s0 = hp * 512 + r; else if (r < 1024) { s0 = 1024 + hp * 512 + (r - 512); scale = 0.0625f; } else s0 = 2048 + hp * 1024 + (r - 1024); }
      else s0 = n;
      src = c.r_w_in; dst = c.wb; ld = 6144; nvalid = 6144; sc0 = s0; K = 1024; n0 = n; k0 = kb * 64; }
    else { const int i2 = it - 1536; const int nb = i2 >> 5, kb = i2 & 31; perm = 0; src = c.r_w_out; dst = c.wb + (size_t)6144 * 1024; ld = 1024; nvalid = 1024; sc0 = nb * 64; K = 2048; n0 = nb * 64; k0 = kb * 64; }
  }
  d.src = src; d.dst = dst; d.ld = ld; d.nvalid = nvalid; d.sc0 = sc0; d.K = K; d.n0 = n0; d.k0 = k0; d.perm = perm; d.scale = scale;
}
__device__ __forceinline__ void tile_load(const TileD& d, int tid, float4& v0, float4& v1) {
  const int kk = tid >> 4, c4 = (tid & 15) * 4; const int col = d.sc0 + c4;
  v0 = make_float4(0.f, 0.f, 0.f, 0.f); v1 = v0;
  if (col < d.nvalid) { const float* p = d.src + (size_t)(d.k0 + kk) * d.ld + col; v0 = *(const float4*)p; v1 = *(const float4*)(p + (size_t)32 * d.ld); }
}

__device__ void phase_norm(int wv, ldsp lds, const Phase& ph, const Ctx& c) {
  int wvo = wv; asm volatile("" : "+s"(wvo)); int lno; asm volatile("v_mbcnt_lo_u32_b32 %0, -1, 0\n\tv_mbcnt_hi_u32_b32 %0, -1, %0" : "=v"(lno)); int tid = (wvo << 6) | lno; const int wid = tid >> 6, lane = tid & 63;
  const int l = ph.i0, j = ph.i1, kind = ph.pad;
  {
    const int ntile = kind == 0 ? 2112 : (kind == 1 ? 1088 : 2048);
    LAS float* tile = (LAS float*)lds;
    TileD d; float4 p0, p1; int it = blockIdx.x; asm volatile("" : "+s"(it));
    if (it < ntile) { tile_desc(c, kind, l, ph.K, it, d); tile_load(d, tid, p0, p1); }
#pragma unroll 1
    for (; it < ntile; it += gridDim.x) {
      const float sc = d.scale; const int dperm = d.perm; u16* dptr = d.dst + (size_t)(d.n0 + (tid >> 3)) * d.K + d.k0 + (tid & 7) * 8;
      { const int kk = tid >> 4, c4 = (tid & 15) * 4;
        tile[kk * 65 + c4] = p0.x * sc; tile[kk * 65 + c4 + 1] = p0.y * sc; tile[kk * 65 + c4 + 2] = p0.z * sc; tile[kk * 65 + c4 + 3] = p0.w * sc;
        tile[(kk + 32) * 65 + c4] = p1.x * sc; tile[(kk + 32) * 65 + c4 + 1] = p1.y * sc; tile[(kk + 32) * 65 + c4 + 2] = p1.z * sc; tile[(kk + 32) * 65 + c4 + 3] = p1.w * sc; }
      if (it + (int)gridDim.x < ntile) { tile_desc(c, kind, l, ph.K, it + gridDim.x, d); tile_load(d, tid, p0, p1); }
      __syncthreads();
      { const int nd = tid >> 3, kc = (tid & 7) * 8; const int n = dperm ? (nd & 32) + perm32(nd & 31) : nd; u32x4 o;
        o.x = pack2(tile[(kc + 0) * 65 + n], tile[(kc + 1) * 65 + n]); o.y = pack2(tile[(kc + 2) * 65 + n], tile[(kc + 3) * 65 + n]);
        o.z = pack2(tile[(kc + 4) * 65 + n], tile[(kc + 5) * 65 + n]); o.w = pack2(tile[(kc + 6) * 65 + n], tile[(kc + 7) * 65 + n]);
        *(u32x4*)dptr = o; }
      __syncthreads();
    }
  }
  const float* g = c.norm_g + (size_t)(l * 3 + j) * 1024;
  const int nsplit = ph.N >> 8; const float* pbase = (ph.N & 2) ? c.part2 : c.part;
  const int rstride = gridDim.x * 8;
  float4 nv[4];
  { const int row = blockIdx.x * 8 + wid;
    if (row < ph.M) { const float4* xp = (const float4*)((((ph.N & 1) && row < NL) ? c.x : c.xr) + (size_t)row * 1024);
#pragma unroll
      for (int i = 0; i < 4; ++i) nv[i] = ldnt4(xp + lane + 64 * i); } }
  int curset = -1; float4 cA[4], cB[4];
#pragma unroll
  for (int i = 0; i < 4; ++i) { cA[i] = make_float4(0.f, 0.f, 0.f, 0.f); cB[i] = cA[i]; }
  for (int row = blockIdx.x * 8 + wid; row < ph.M; row += rstride) {
    float4 v[4]; float ss = 0.f;
#pragma unroll
    for (int i = 0; i < 4; ++i) v[i] = nv[i];
    { const int nrow = row + rstride;
      if (nrow < ph.M) { const float4* xp = (const float4*)((((ph.N & 1) && nrow < NL) ? c.x : c.xr) + (size_t)nrow * 1024);
#pragma unroll
        for (int i = 0; i < 4; ++i) nv[i] = ldnt4(xp + lane + 64 * i); } }
    if (nsplit > 0 && row >= NL) {
      const float4* gp = (const float4*)((const float*)ph.X + (size_t)4 * 9216);
#pragma unroll
      for (int i = 0; i < 4; ++i) { float4 a = make_float4(0.f, 0.f, 0.f, 0.f);
        for (int ks = 0; ks < nsplit; ++ks) { const float4 pv = ((const float4*)(pbase + ((size_t)ks * 1024 + (row - NL)) * 1024))[lane + 64 * i]; a.x += pv.x; a.y += pv.y; a.z += pv.z; a.w += pv.w; }
        const float4 g4 = gp[lane + 64 * i]; const float f0 = ph.f0;
        v[i].x += f0 * g4.x * a.x; v[i].y += f0 * g4.y * a.y; v[i].z += f0 * g4.z * a.z; v[i].w += f0 * g4.w * a.w;
        ((float4*)(c.xr + (size_t)row * 1024))[lane + 64 * i] = v[i]; }
    }
#pragma unroll
    for (int i = 0; i < 4; ++i) ss += v[i].x * v[i].x + v[i].y * v[i].y + v[i].z * v[i].z + v[i].w * v[i].w;
#pragma unroll
    for (int o = 1; o < 64; o <<= 1) ss += shx(ss, o, lane);
    const float rstd = rsqrtf(ss * (1.f / 1024.f) + 1e-6f);
    const int set = row < NL ? (row >> 13) : 4;
    if (set != curset) { curset = set;
      const float* sh = c.modv + (size_t)(l * 5 + set) * 9216 + (3 * j) * 1024; const float* sc = sh + 1024;
#pragma unroll
      for (int i = 0; i < 4; ++i) { const int q = lane + 64 * i; const float4 g4 = ((const float4*)g)[q], s4 = ((const float4*)sh)[q], c4 = ((const float4*)sc)[q];
        cA[i] = make_float4(g4.x * (1.f + c4.x), g4.y * (1.f + c4.y), g4.z * (1.f + c4.z), g4.w * (1.f + c4.w)); cB[i] = s4; } }
#pragma unroll
    for (int i = 0; i < 4; ++i) {
      const int q = lane + 64 * i;
      u32x2 o; o.x = pack2(v[i].x * rstd * cA[i].x + cB[i].x, v[i].y * rstd * cA[i].y + cB[i].y);
      o.y = pack2(v[i].z * rstd * cA[i].z + cB[i].z, v[i].w * rstd * cA[i].w + cB[i].w);
      *(u32x2*)(c.hb + (size_t)row * 1024 + q * 4) = o;
    }
  }
}

__device__ void phase_final(int wv, const Ctx& c) {
  int wvo = wv; asm volatile("" : "+s"(wvo)); int lno; asm volatile("v_mbcnt_lo_u32_b32 %0, -1, 0\n\tv_mbcnt_hi_u32_b32 %0, -1, %0" : "=v"(lno)); int tid = (wvo << 6) | lno; const int wid = tid >> 6, lane = tid & 63;
  for (int row = blockIdx.x * 8 + wid; row < NL; row += gridDim.x * 8) {
    const float4* xp = (const float4*)(c.xr + (size_t)row * 1024);
    float4 v[4]; float ss = 0.f;
#pragma unroll
    for (int i = 0; i < 4; ++i) { v[i] = ldnt4(xp + lane + 64 * i);
      { const u32x2 d = *(const u32x2*)(c.hb + (size_t)row * 1024 + (lane + 64 * i) * 4); v[i].x += lo2f(d.x); v[i].y += hi2f(d.x); v[i].z += lo2f(d.y); v[i].w += hi2f(d.y); }
      ss += v[i].x * v[i].x + v[i].y * v[i].y + v[i].z * v[i].z + v[i].w * v[i].w; }
#pragma unroll
    for (int o = 1; o < 64; o <<= 1) ss += shx(ss, o, lane);
    const float rstd = rsqrtf(ss * (1.f / 1024.f) + 1e-6f);
#pragma unroll
    for (int i = 0; i < 4; ++i) { const int q = lane + 64 * i; const float4 g4 = ((const float4*)c.final_g)[q];
      float4 o; o.x = v[i].x * rstd * g4.x; o.y = v[i].y * rstd * g4.y; o.z = v[i].z * rstd * g4.z; o.w = v[i].w * rstd * g4.w;
      stnt4((float4*)(c.out + (size_t)row * 1024) + q, o); }
  }
}

#define MPRE_ELEMS ((size_t)NT * 3072)
__device__ __forceinline__ int m_chunk_row0(int b, int dir, int cs) {
  if (cs < 2) { const int j = dir ? 1 - cs : cs; return NL + b * 256 + j * 128; }
  const int j = dir ? 65 - cs : cs - 2; return b * 8192 + j * 128;
}

__device__ void phase_mconv(int wv, const Ctx& c) {
  const u16* pre = c.big; const float* cw = c.m_conv_w;
  int wvo = wv; asm volatile("" : "+s"(wvo)); int lno; asm volatile("v_mbcnt_lo_u32_b32 %0, -1, 0\n\tv_mbcnt_hi_u32_b32 %0, -1, %0" : "=v"(lno)); int tid = (wvo << 6) | lno; const size_t gt = (size_t)blockIdx.x * 512 + tid, gs = (size_t)gridDim.x * 512;
  for (size_t i = gt; i < (size_t)NT * 128; i += gs) {
    const int r = (int)(i >> 7), cg = (int)(i & 127) * 8;
    int pos, len; if (r < NL) { pos = r & 8191; len = 8192; } else { pos = (r - NL) & 255; len = 256; }
    float a[8];
#pragma unroll
    for (int q = 0; q < 8; ++q) a[q] = 0.f;
#pragma unroll
    for (int j = 0; j < 5; ++j) {
      const int pp = pos + j - 2;
      if (pp >= 0 && pp < len) {
        const u32x4 u = *(const u32x4*)(pre + (size_t)(r + j - 2) * 3072 + cg);
        const float4 w0 = *(const float4*)(cw + j * 1024 + cg), w1 = *(const float4*)(cw + j * 1024 + cg + 4);
        a[0] += w0.x * lo2f(u.x); a[1] += w0.y * hi2f(u.x); a[2] += w0.z * lo2f(u.y); a[3] += w0.w * hi2f(u.y);
        a[4] += w1.x * lo2f(u.z); a[5] += w1.y * hi2f(u.z); a[6] += w1.z * lo2f(u.w); a[7] += w1.w * hi2f(u.w);
      }
    }
    const float sc = cg >= 512 ? 0.125f : 1.f;
    u32x4 o; o.x = pack2(siluf(a[0]) * sc, siluf(a[1]) * sc); o.y = pack2(siluf(a[2]) * sc, siluf(a[3]) * sc);
    o.z = pack2(siluf(a[4]) * sc, siluf(a[5]) * sc); o.w = pack2(siluf(a[6]) * sc, siluf(a[7]) * sc);
    *(u32x4*)(c.hb + (size_t)r * 1024 + cg) = o;
  }
}

__device__ void phase_ma(int wv, ldsp lds, const Ctx& c) {
  int wvo = wv; asm volatile("" : "+s"(wvo)); int lno; asm volatile("v_mbcnt_lo_u32_b32 %0, -1, 0\n\tv_mbcnt_hi_u32_b32 %0, -1, %0" : "=v"(lno)); int tid = (wvo << 6) | lno; const int wid = tid >> 6, lane = tid & 63;
  ldsp sK = lds; ldsp sV = lds + 128 * 144; LAS float* sf = (LAS float*)(lds + 128 * 144 + 128 * 272);
  const u16* pre = c.big; u16* mc = c.big + MPRE_ELEMS;
  for (int item = blockIdx.x; item < 2 * 4 * 8 * 65; item += gridDim.x) {
    const int cs = item % 65; const int sq = item / 65; const int h = sq & 7, b = (sq >> 3) & 3, dir = sq >> 5;
    const int row0 = m_chunk_row0(b, dir, cs);
    if (wid == 0) {
      const float* gp = c.gates + (size_t)(row0 + 2 * lane) * 32 + dir * 16 + h;
      const float ig0 = gp[0], lf0 = logsig(gp[8]), ig1 = gp[32], lf1 = logsig(gp[40]);
      const float s2 = lf0 + lf1; float inc = s2;
#pragma unroll
      for (int d = 1; d < 64; d <<= 1) inc += shup(inc, d, lane, 0.f);
      const float total = lane63(inc); const float ex = inc - s2;
      const float g0 = (dir ? ex : total - ex - lf0) + ig0;
      const float g1 = (dir ? ex + lf0 : total - ex - lf0 - lf1) + ig1;
      float mx = fmaxf(g0, g1);
#pragma unroll
      for (int m = 1; m < 64; m <<= 1) mx = fmaxf(mx, shx(mx, m, lane));
      sf[256 + 2 * lane] = __expf(g0 - mx); sf[257 + 2 * lane] = __expf(g1 - mx);
      if (lane == 0) { c.mst_s[4224 + sq * 66 + cs] = total; c.mst_s[sq * 66 + cs] = mx; }
    }
    __syncthreads();
    { const int row = tid >> 2, part = tid & 3; const float w = sf[256 + row];
      const u16* kp = c.hb + (size_t)(row0 + row) * 1024 + 512 + h * 64 + part * 16;
#pragma unroll
      for (int q = 0; q < 2; ++q) { const u32x4 u = *(const u32x4*)(kp + q * 8); u32x4 o;
        o.x = pack2(lo2f(u.x) * w, hi2f(u.x) * w); o.y = pack2(lo2f(u.y) * w, hi2f(u.y) * w); o.z = pack2(lo2f(u.z) * w, hi2f(u.z) * w); o.w = pack2(lo2f(u.w) * w, hi2f(u.w) * w);
        *(LAS u32x4*)(sK + row * 144 + part * 32 + q * 16) = o; }
      const u16* vp = pre + (size_t)(row0 + row) * 3072 + 1024 + h * 128 + part * 32;
#pragma unroll
      for (int q = 0; q < 4; ++q) *(LAS u32x4*)(sV + row * 272 + part * 64 + q * 16) = *(const u32x4*)(vp + q * 8);
    }
    __syncthreads();
    f32x4 acc[4];
#pragma unroll
    for (int n = 0; n < 4; ++n) acc[n] = (f32x4){0.f, 0.f, 0.f, 0.f};
#pragma unroll
    for (int k0 = 0; k0 < 128; k0 += 32) {
      const bf16x8 a = frag_tr(sV, 272, wid * 16, k0, lane);
#pragma unroll
      for (int n = 0; n < 4; ++n) { const bf16x8 bb = frag_tr(sK, 144, n * 16, k0, lane); acc[n] = MFMA16(a, bb, acc[n]); }
    }
    u16* dst = mc + (size_t)(sq * 66 + cs) * 8192;
#pragma unroll
    for (int n = 0; n < 4; ++n)
#pragma unroll
      for (int r = 0; r < 4; ++r) dst[(wid * 16 + 4 * (lane >> 4) + r) * 64 + n * 16 + (lane & 15)] = f2bf(acc[n][r]);
    { float s = 0.f;
#pragma unroll
      for (int p = 0; p < 16; ++p) s += bf2f(*(LAS u16*)(sK + (wid * 16 + p) * 144 + lane * 2));
      sf[384 + wid * 64 + lane] = s; }
    __syncthreads();
    if (tid < 64) { float s = 0.f;
#pragma unroll
      for (int w8 = 0; w8 < 8; ++w8) s += sf[384 + w8 * 64 + tid];
      c.mst_n[(size_t)(sq * 66 + cs) * 64 + tid] = s; }
    __syncthreads();
  }
}

__device__ void phase_mb(int wv, const Ctx& c) {
  int wvo = wv; asm volatile("" : "+s"(wvo)); int lno; asm volatile("v_mbcnt_lo_u32_b32 %0, -1, 0\n\tv_mbcnt_hi_u32_b32 %0, -1, %0" : "=v"(lno)); int tid = (wvo << 6) | lno;
  u16* mc = c.big + MPRE_ELEMS;
  for (int item = blockIdx.x; item < 64 * 8; item += gridDim.x) {
    const int sq = item >> 3, slab = item & 7;
    unsigned* p = (unsigned*)(mc + (size_t)sq * 66 * 8192 + slab * 1024 + tid * 2);
    const bool nth = (slab == 0 && tid < 64);
    float* np = c.mst_n + (size_t)sq * 66 * 64 + tid;
    float m = -1e30f, c0 = 0.f, c1 = 0.f, cn = 0.f;
#pragma unroll 1
    for (int cb = 0; cb < 66; cb += 11) {
      unsigned loc[11]; float nl[11], bl[11], ml[11];
#pragma unroll
      for (int q = 0; q < 11; ++q) { const int cs = cb + q; loc[q] = 0u; nl[q] = 0.f; bl[q] = 0.f; ml[q] = 0.f;
        if (cs < 65) { loc[q] = p[(size_t)cs * 4096]; bl[q] = c.mst_s[4224 + sq * 66 + cs]; ml[q] = c.mst_s[sq * 66 + cs]; if (nth) nl[q] = np[cs * 64]; } }
#pragma unroll
      for (int q = 0; q < 11; ++q) { const int cs = cb + q;
        p[(size_t)cs * 4096] = pack2(c0, c1);
        if (nth) np[cs * 64] = cn;
        if (slab == 0 && tid == 0) c.mst_s[8448 + sq * 66 + cs] = m;
        if (cs < 65) {
          const float mn = fmaxf(bl[q] + m, ml[q]); const float wp = __expf(bl[q] + m - mn), wl = __expf(ml[q] - mn);
          c0 = wp * c0 + wl * lo2f(loc[q]); c1 = wp * c1 + wl * hi2f(loc[q]); cn = wp * cn + wl * nl[q]; m = mn;
        } }
    }
  }
}

__device__ void phase_mc(int wv, ldsp lds, const Ctx& c) {
  int wvo = wv; asm volatile("" : "+s"(wvo)); int lno; asm volatile("v_mbcnt_lo_u32_b32 %0, -1, 0\n\tv_mbcnt_hi_u32_b32 %0, -1, %0" : "=v"(lno)); int tid = (wvo << 6) | lno; const int wid = tid >> 6, lane = tid & 63;
  ldsp sQ = lds, sK = lds + 18432, sV = lds + 36864, sP = lds + 71680, sC0 = lds + 106496, sC1 = lds + 124928;
  LAS float* sf = (LAS float*)(lds + 143360);
  const u16* pre = c.big; const u16* mc = c.big + MPRE_ELEMS;
  for (int item = blockIdx.x; item < 4 * 8 * 66; item += gridDim.x) {
    const int j = item % 66; const int bh = item / 66; const int h = bh & 7, b = bh >> 3;
    const int row0 = j < 2 ? NL + b * 256 + j * 128 : b * 8192 + (j - 2) * 128;
    const int csf = j, csb = j < 2 ? 1 - j : 67 - j;
    const int sqf = b * 8 + h, sqb = 32 + b * 8 + h;
    const int d2 = tid >> 7, po = tid & 127;
    if (wid < 2) {
      const int dd = wid;
      const float* gp = c.gates + (size_t)(row0 + 2 * lane) * 32 + dd * 16 + h;
      const float ig0 = gp[0], lf0 = logsig(gp[8]), ig1 = gp[32], lf1 = logsig(gp[40]);
      const float s2 = lf0 + lf1; float inc = s2;
#pragma unroll
      for (int d = 1; d < 64; d <<= 1) inc += shup(inc, d, lane, 0.f);
      const float total = lane63(inc); const float ex = inc - s2;
      const float bb0 = dd ? total - ex : ex + lf0;
      const float bb1 = dd ? total - ex - lf0 : ex + s2;
      const float e0 = ig0 - bb0, e1 = ig1 - bb1, e01 = fmaxf(e0, e1);
      const float mpre = c.mst_s[8448 + (dd ? sqb * 66 + csb : sqf * 66 + csf)];
      float pm0, pm1;
      if (!dd) { float P = e01;
#pragma unroll
        for (int d = 1; d < 64; d <<= 1) P = fmaxf(P, shup(P, d, lane, -3.0e38f));
        const float xp = shup(P, 1, lane, -3.0e38f); pm0 = fmaxf(xp, e0); pm1 = fmaxf(xp, e01); }
      else { float S = e01;
#pragma unroll
        for (int d = 1; d < 64; d <<= 1) S = fmaxf(S, shdn(S, d, lane, -3.0e38f));
        const float xs = shdn(S, 1, lane, -3.0e38f); pm1 = fmaxf(xs, e1); pm0 = fmaxf(xs, e01); }
      const float M0 = fmaxf(mpre, pm0), M1 = fmaxf(mpre, pm1);
      const int o = dd * 128 + 2 * lane;
      sf[768 + o] = bb0; sf[769 + o] = bb1; sf[256 + o] = e0; sf[257 + o] = e1; sf[512 + o] = M0; sf[513 + o] = M1;
      sf[1024 + o] = __expf(mpre - M0); sf[1025 + o] = __expf(mpre - M1);
    }
    if (tid >= 256 && tid < 384) { const int q = tid - 256; const int d3 = q >> 6, dd = q & 63; sf[1536 + q] = c.mst_n[(size_t)(d3 ? sqb * 66 + csb : sqf * 66 + csf) * 64 + dd]; }
    { const int row = tid >> 2, part = tid & 3;
      const u16* qp = c.hb + (size_t)(row0 + row) * 1024 + h * 64 + part * 16;
#pragma unroll
      for (int q = 0; q < 2; ++q) { *(LAS u32x4*)(sQ + row * 144 + part * 32 + q * 16) = *(const u32x4*)(qp + q * 8); *(LAS u32x4*)(sK + row * 144 + part * 32 + q * 16) = *(const u32x4*)(qp + 512 + q * 8); }
      const u16* vp = pre + (size_t)(row0 + row) * 3072 + 1024 + h * 128 + part * 32;
#pragma unroll
      for (int q = 0; q < 4; ++q) *(LAS u32x4*)(sV + row * 272 + part * 64 + q * 16) = *(const u32x4*)(vp + q * 8);
      const u16* cf = mc + (size_t)(sqf * 66 + csf) * 8192 + row * 64 + part * 16; const u16* cb = mc + (size_t)(sqb * 66 + csb) * 8192 + row * 64 + part * 16;
#pragma unroll
      for (int q = 0; q < 2; ++q) { *(LAS u32x4*)(sC0 + row * 144 + part * 32 + q * 16) = *(const u32x4*)(cf + q * 8); *(LAS u32x4*)(sC1 + row * 144 + part * 32 + q * 16) = *(const u32x4*)(cb + q * 8); }
    }
    __syncthreads();
    { const int row = tid >> 2, part = tid & 3; float qf = 0.f, qb = 0.f;
#pragma unroll
      for (int q = 0; q < 2; ++q) { const u32x4 u = *(const LAS u32x4*)(sQ + row * 144 + part * 32 + q * 16); const int d0 = part * 16 + q * 8;
        const float v0 = lo2f(u.x), v1 = hi2f(u.x), v2 = lo2f(u.y), v3 = hi2f(u.y), v4 = lo2f(u.z), v5 = hi2f(u.z), v6 = lo2f(u.w), v7 = hi2f(u.w);
        qf += v0 * sf[1536 + d0] + v1 * sf[1537 + d0] + v2 * sf[1538 + d0] + v3 * sf[1539 + d0] + v4 * sf[1540 + d0] + v5 * sf[1541 + d0] + v6 * sf[1542 + d0] + v7 * sf[1543 + d0];
        qb += v0 * sf[1600 + d0] + v1 * sf[1601 + d0] + v2 * sf[1602 + d0] + v3 * sf[1603 + d0] + v4 * sf[1604 + d0] + v5 * sf[1605 + d0] + v6 * sf[1606 + d0] + v7 * sf[1607 + d0]; }
      qf += shx(qf, 1, lane); qf += shx(qf, 2, lane); qb += shx(qb, 1, lane); qb += shx(qb, 2, lane);
      if (part == 0) { sf[1280 + row] = qf; sf[1408 + row] = qb; } }
    f32x4 accS[8];
#pragma unroll
    for (int n = 0; n < 8; ++n) accS[n] = (f32x4){0.f, 0.f, 0.f, 0.f};
#pragma unroll
    for (int k0 = 0; k0 < 64; k0 += 32) {
      const bf16x8 a = frag_row(sQ, 144, wid * 16, k0, lane);
#pragma unroll
      for (int n = 0; n < 8; ++n) { const bf16x8 bb = frag_row(sK, 144, n * 16, k0, lane); accS[n] = MFMA16(a, bb, accS[n]); }
    }
    __syncthreads();
    f32x4 hs[8];
#pragma unroll
    for (int n = 0; n < 8; ++n) hs[n] = (f32x4){0.f, 0.f, 0.f, 0.f};
    const int tb = wid * 16 + 4 * (lane >> 4), sl = lane & 15;
#pragma unroll 1
    for (int dir = 0; dir < 2; ++dir) {
      float rs[4] = {0.f, 0.f, 0.f, 0.f}; float Mt[4];
#pragma unroll
      for (int r = 0; r < 4; ++r) Mt[r] = sf[512 + dir * 128 + tb + r];
#pragma unroll
      for (int n = 0; n < 8; ++n) { const int s = n * 16 + sl; const float es = sf[256 + dir * 128 + s];
#pragma unroll
        for (int r = 0; r < 4; ++r) { const int t = tb + r; const bool in = dir ? (s >= t) : (s <= t);
          const float pv = in ? accS[n][r] * __expf(es - Mt[r]) : 0.f; rs[r] += pv; *(LAS u16*)(sP + t * 272 + s * 2) = f2bf(pv); } }
#pragma unroll
      for (int r = 0; r < 4; ++r) rs[r] = red16l(rs[r], lane);
      float wi4[4], inv4[4];
#pragma unroll
      for (int r = 0; r < 4; ++r) { const int t = tb + r; const float wi = sf[1024 + dir * 128 + t];
        const float den = wi * sf[1280 + dir * 128 + t] + rs[r]; const float mt = sf[768 + dir * 128 + t] + Mt[r];
        wi4[r] = wi; inv4[r] = 1.f / fmaxf(fabsf(den), __expf(-mt)); }
      ldsp sC = dir ? sC1 : sC0;
#pragma unroll
      for (int eh = 0; eh < 2; ++eh) {
        f32x4 a1[4], a2[4];
#pragma unroll
        for (int n = 0; n < 4; ++n) { a1[n] = (f32x4){0.f, 0.f, 0.f, 0.f}; a2[n] = (f32x4){0.f, 0.f, 0.f, 0.f}; }
#pragma unroll
        for (int k0 = 0; k0 < 128; k0 += 32) { const bf16x8 a = frag_row(sP, 272, wid * 16, k0, lane);
#pragma unroll

#define FR_(n) frag_tr(sV, 272, (eh * 4 + (n)) * 16, k0, lane)
          SWEEP(4, 4, FR_, a, a1);
#undef FR_
        }
#pragma unroll
        for (int k0 = 0; k0 < 64; k0 += 32) { const bf16x8 a = frag_row(sQ, 144, wid * 16, k0, lane);
#pragma unroll

#define FR_(n) frag_row(sC, 144, (eh * 4 + (n)) * 16, k0, lane)
          SWEEP(4, 4, FR_, a, a2);
#undef FR_
        }
#pragma unroll
        for (int r = 0; r < 4; ++r)
#pragma unroll
          for (int n = 0; n < 4; ++n) hs[eh * 4 + n][r] += (a1[n][r] + wi4[r] * a2[n][r]) * inv4[r];
      }
    }
#pragma unroll
    for (int r = 0; r < 4; ++r) {
      float s = 0.f;
#pragma unroll
      for (int n = 0; n < 8; ++n) s += hs[n][r];
      const float mu = red16l(s, lane) * (1.f / 128.f); float v = 0.f;
#pragma unroll
      for (int n = 0; n < 8; ++n) { const float d = hs[n][r] - mu; v += d * d; }
      const float rstd = rsqrtf(red16l(v, lane) * (1.f / 128.f) + 1e-6f);
      const size_t row = row0 + tb + r;
#pragma unroll
      for (int n = 0; n < 8; ++n) { const int e = h * 128 + n * 16 + sl;
        const float og = bf2f(pre[row * 3072 + 2048 + e]);
        c.y[row * 1024 + e] = f2bf((hs[n][r] - mu) * rstd * c.m_norm_g[e] * sigmf(og)); }
    }
    __syncthreads();
  }
}

#define RUQ_ELEMS ((size_t)NT * 2048)
__device__ __forceinline__ float ret_lg(const Ctx& c, int dir, int h) { return logsig(c.r_decay[dir * 4 + h]); }

__device__ void phase_ra(int wv, ldsp lds, const Phase& ph, const Ctx& c) {
  int wvo = wv; asm volatile("" : "+s"(wvo)); int lno; asm volatile("v_mbcnt_lo_u32_b32 %0, -1, 0\n\tv_mbcnt_hi_u32_b32 %0, -1, %0" : "=v"(lno)); int tid = (wvo << 6) | lno; const int wid = tid >> 6, lane = tid & 63;
  ldsp sV = lds; ldsp sK = lds + 64 * 272;
  const u16* uq = c.big; u16* rst = c.big + RUQ_ELEMS; const int hp = ph.i0;
  for (int item = blockIdx.x; item < 1024; item += gridDim.x) {
    const int eq = item & 3, J = (item >> 2) & 15, hl = (item >> 6) & 1, b = (item >> 7) & 3, dir = item >> 9;
    const int sq = (dir * 4 + b) * 2 + hl; const float lg = ret_lg(c, dir, hp * 2 + hl);
    int row0, L; if (J == 0) { row0 = NL + b * 256; L = 256; } else { L = 512; row0 = b * 8192 + (dir ? 16 - J : J - 1) * 512; }
    f32x4 acc[16];
#pragma unroll
    for (int n = 0; n < 16; ++n) acc[n] = (f32x4){0.f, 0.f, 0.f, 0.f};
    const u16* vp = uq + (size_t)(row0 + (tid >> 4)) * 2048 + 1024 + hl * 512 + eq * 128 + (tid & 15) * 8;
    const u16* kp = uq + (size_t)(row0 + (tid >> 5)) * 2048 + 512 + hl * 256 + (tid & 31) * 8;
    u32x4 pv[2], pk[4];
#pragma unroll
    for (int q = 0; q < 2; ++q) pv[q] = *(const u32x4*)(vp + (size_t)q * 32 * 2048);
#pragma unroll
    for (int q = 0; q < 4; ++q) pk[q] = *(const u32x4*)(kp + (size_t)q * 16 * 2048);
    LDS_BAR();
#pragma unroll 1
    for (int s0 = 0; s0 < L; s0 += 64) {
      {
#pragma unroll
        for (int q = 0; q < 2; ++q) *(LAS u32x4*)(sV + (q * 32 + (tid >> 4)) * 272 + (tid & 15) * 16) = pv[q];
#pragma unroll
        for (int q = 0; q < 4; ++q) { const int krow = q * 16 + (tid >> 5); const int o = s0 + krow; const float z = __expf(lg * (float)(dir ? o : L - 1 - o)); const u32x4 u = pk[q]; u32x4 w;
          w.x = pack2(lo2f(u.x) * z, hi2f(u.x) * z); w.y = pack2(lo2f(u.y) * z, hi2f(u.y) * z); w.z = pack2(lo2f(u.z) * z, hi2f(u.z) * z); w.w = pack2(lo2f(u.w) * z, hi2f(u.w) * z);
          *(LAS u32x4*)(sK + krow * 528 + (tid & 31) * 16) = w; }
      }
      if (s0 + 64 < L) {
        const size_t adv = (size_t)(s0 + 64) * 2048;
#pragma unroll
        for (int q = 0; q < 2; ++q) pv[q] = *(const u32x4*)(vp + adv + (size_t)q * 32 * 2048);
#pragma unroll
        for (int q = 0; q < 4; ++q) pk[q] = *(const u32x4*)(kp + adv + (size_t)q * 16 * 2048);
      }
      LDS_BAR();
#pragma unroll
      for (int k0 = 0; k0 < 64; k0 += 32) { const bf16x8 a0 = frag_tr(sV, 272, (wid >> 1) * 32, k0, lane), a1 = frag_tr(sV, 272, (wid >> 1) * 32 + 16, k0, lane);
        bf16x8 bq[4];
#pragma unroll
        for (int n = 0; n < 4; ++n) bq[n] = frag_tr(sK, 528, (wid & 1) * 128 + n * 16, k0, lane);
        __builtin_amdgcn_sched_barrier(0);
#pragma unroll
        for (int n = 0; n < 8; ++n) { const bf16x8 cur = bq[n & 3]; if (n + 4 < 8) bq[n & 3] = frag_tr(sK, 528, (wid & 1) * 128 + (n + 4) * 16, k0, lane);
          acc[n] = MFMA16(a0, cur, acc[n]); acc[8 + n] = MFMA16(a1, cur, acc[8 + n]); __builtin_amdgcn_sched_barrier(0); }
      }
      LDS_BAR();
    }
    u16* dst = rst + (size_t)(sq * 16 + J) * 131072 + (size_t)(eq * 128 + (wid >> 1) * 32 + 4 * (lane >> 4)) * 256 + (wid & 1) * 128 + (lane & 15);
#pragma unroll
    for (int mi = 0; mi < 2; ++mi)
#pragma unroll
      for (int n = 0; n < 8; ++n)
#pragma unroll
        for (int r = 0; r < 4; ++r) dst[(mi * 16 + r) * 256 + n * 16] = f2bf(acc[mi * 8 + n][r]);
  }
}

__device__ void phase_rb(int wv, const Phase& ph, const Ctx& c) {
  int wvo = wv; asm volatile("" : "+s"(wvo)); int lno; asm volatile("v_mbcnt_lo_u32_b32 %0, -1, 0\n\tv_mbcnt_hi_u32_b32 %0, -1, %0" : "=v"(lno)); int tid = (wvo << 6) | lno; u16* rst = c.big + RUQ_ELEMS; const int hp = ph.i0;
  for (int item = blockIdx.x; item < 16 * 32; item += gridDim.x) {
    const int sq = item >> 5, slab = item & 31; const int hl = sq & 1, dir = sq >> 3;
    const float g512 = __expf(512.f * ret_lg(c, dir, hp * 2 + hl));
    u32x4* p = (u32x4*)(rst + (size_t)sq * 16 * 131072 + slab * 4096 + tid * 8);
    float cr[8];
#pragma unroll
    for (int q = 0; q < 8; ++q) cr[q] = 0.f;
    u32x4 uu[16];
#pragma unroll
    for (int J = 0; J < 16; ++J) uu[J] = p[(size_t)J * 16384];
#pragma unroll
    for (int J = 0; J < 16; ++J) {
      const u32x4 u = uu[J];
      cr[0] = g512 * cr[0] + lo2f(u.x); cr[1] = g512 * cr[1] + hi2f(u.x); cr[2] = g512 * cr[2] + lo2f(u.y); cr[3] = g512 * cr[3] + hi2f(u.y);
      cr[4] = g512 * cr[4] + lo2f(u.z); cr[5] = g512 * cr[5] + hi2f(u.z); cr[6] = g512 * cr[6] + lo2f(u.w); cr[7] = g512 * cr[7] + hi2f(u.w);
      u32x4 o; o.x = pack2(cr[0], cr[1]); o.y = pack2(cr[2], cr[3]); o.z = pack2(cr[4], cr[5]); o.w = pack2(cr[6], cr[7]);
      p[(size_t)J * 16384] = o;
    }
  }
}

__device__ __forceinline__ bf16x8 scale_frag(bf16x8 a, float s) {
  bf16x8 r;
#pragma unroll
  for (int q = 0; q < 8; ++q) r[q] = (short)f2bf(bf2f((u16)a[q]) * s);
  return r;
}

#define SWEEP2(NT, DEPTH, FRAG, A0, A1, ACC, OFF1) do { bf16x8 bq_[DEPTH]; \
    _Pragma("unroll") for (int n_ = 0; n_ < DEPTH; ++n_) bq_[n_] = FRAG(n_); __builtin_amdgcn_sched_barrier(0); \
    _Pragma("unroll") for (int n_ = 0; n_ < NT; ++n_) { const bf16x8 cur_ = bq_[n_ % DEPTH]; if (n_ + DEPTH < NT) bq_[n_ % DEPTH] = FRAG(n_ + DEPTH); \
      ACC[n_] = MFMA16(A0, cur_, ACC[n_]); ACC[OFF1 + n_] = MFMA16(A1, cur_, ACC[OFF1 + n_]); __builtin_amdgcn_sched_barrier(0); } } while (0)
__device__ void phase_rc(int wv, ldsp lds, const Phase& ph, const Ctx& c) {
  ldsp sQ = lds, sKP = lds + 67584, sV = lds + 102400;
  const u16* uq = c.big; const u16* rst = c.big + RUQ_ELEMS; const int hp = ph.i0;
  for (int item = blockIdx.x; item < 512; item += gridDim.x) {
    int wvo = wv; asm volatile("" : "+s"(wvo)); int lno; asm volatile("v_mbcnt_lo_u32_b32 %0, -1, 0\n\tv_mbcnt_hi_u32_b32 %0, -1, %0" : "=v"(lno)); int tid = (wvo << 6) | lno; const int wid = tid >> 6, lane = tid & 63;
    const int i = item & 3, Jo = (item >> 2) & 15, hl = (item >> 6) & 1, b = item >> 7;
    const int h = hp * 2 + hl; const float lgf = ret_lg(c, 0, h), lgb = ret_lg(c, 1, h);
    const int rowb = b * 8192 + Jo * 512;
    const unsigned kofs = (unsigned)((rowb + (tid >> 4)) * 2048 + 512 + hl * 256 + (tid & 15) * 8);
    const unsigned vofs = (unsigned)((rowb + (tid >> 6)) * 2048 + 1024 + hl * 512 + (tid & 63) * 8);
    const unsigned rofs = (unsigned)((tid >> 2) * 256 + (tid & 3) * 8);
    const u16* rs0 = rst + (size_t)(((0 * 4 + b) * 2 + hl) * 16 + Jo) * 131072;
    const u16* rs1 = rst + (size_t)(((1 * 4 + b) * 2 + hl) * 16 + (15 - Jo)) * 131072;
#define kbase (uq + kofs)
#define vbase (uq + vofs)
#define rbase0 (rs0 + rofs)
#define rbase1 (rs1 + rofs)
    const unsigned dK = (unsigned)((tid >> 4) * 272 + (tid & 15) * 16), dV = (unsigned)((tid >> 6) * 1040 + (tid & 63) * 16), dR = (unsigned)((tid >> 2) * 80 + (tid & 3) * 16);
    constexpr int KQ = 32 * 2048, VQ = 8 * 2048, RQ = 128 * 256, KD = 32 * 272, VD = 8 * 1040, RD = 128 * 80;
    u32x4 pf[4];
#pragma unroll
    for (int q = 0; q < 4; ++q) pf[q] = *(const u32x4*)(kbase + q * KQ);
    { const int row = tid >> 5, ch = tid & 31; const u16* qp = uq + (size_t)(rowb + i * 128 + row) * 2048 + hl * 256 + ch * 8;
#pragma unroll
      for (int q = 0; q < 8; ++q) *(LAS u32x4*)(sQ + (q * 16 + row) * 528 + ch * 16) = *(const u32x4*)(qp + (size_t)q * 16 * 2048); }
    f32x4 acc[32];
#pragma unroll
    for (int n = 0; n < 32; ++n) acc[n] = (f32x4){0.f, 0.f, 0.f, 0.f};
    const int mg = wid >> 1, ng = wid & 1, lq = lane >> 4, sl = lane & 15;
#pragma unroll 1
    for (int j = 0; j < 4; ++j) {
      f32x4 accS[8];
#pragma unroll
      for (int n = 0; n < 8; ++n) accS[n] = (f32x4){0.f, 0.f, 0.f, 0.f};
#pragma unroll 1
      for (int dh = 0; dh < 2; ++dh) {
        LDS_BAR();
#pragma unroll
        for (int q = 0; q < 4; ++q) *(LAS u32x4*)(sKP + dK + q * KD) = pf[q];
        { const u16* src = dh == 0 ? kbase + (size_t)j * 128 * 2048 + 128 : vbase + (size_t)(j * 128) * 2048; const int qs = dh == 0 ? KQ : VQ;
#pragma unroll
          for (int q = 0; q < 4; ++q) pf[q] = *(const u32x4*)(src + q * qs); }
        LDS_BAR();
#pragma unroll
        for (int k0 = 0; k0 < 128; k0 += 32) { const bf16x8 a0 = frag_row(sQ, 528, mg * 32, dh * 128 + k0, lane), a1 = frag_row(sQ, 528, mg * 32 + 16, dh * 128 + k0, lane);
#define FR_(n) frag_row(sKP, 272, ng * 64 + (n) * 16, k0, lane)
          SWEEP2(4, 2, FR_, a0, a1, accS, 4);
#undef FR_
        }
      }
      LDS_BAR();
#pragma unroll
      for (int mi = 0; mi < 2; ++mi)
#pragma unroll
        for (int n = 0; n < 4; ++n) { const int sc = ng * 64 + n * 16 + sl; const int os = j * 128 + sc;
#pragma unroll
          for (int r = 0; r < 4; ++r) { const int t = mg * 32 + mi * 16 + 4 * lq + r; const int df = i * 128 + t - os;
            float w = 0.f; if (df >= 0) w += __expf(lgf * (float)df); if (df <= 0) w += __expf(-lgb * (float)df);
            *(LAS u16*)(sKP + t * 272 + sc * 2) = f2bf(accS[mi * 4 + n][r] * w); } }
#pragma unroll 1
      for (int s4 = 0; s4 < 4; ++s4) {
        LDS_BAR();
#pragma unroll
        for (int q = 0; q < 4; ++q) *(LAS u32x4*)(sV + dV + q * VD) = pf[q];
        { const u16* src = s4 < 3 ? vbase + (size_t)(j * 128 + (s4 + 1) * 32) * 2048 : (j < 3 ? kbase + (size_t)(j + 1) * 128 * 2048 : rbase0); const int qs = s4 < 3 ? VQ : (j < 3 ? KQ : RQ);
#pragma unroll
          for (int q = 0; q < 4; ++q) pf[q] = *(const u32x4*)(src + q * qs); }
        LDS_BAR();
        const bf16x8 a0 = frag_row(sKP, 272, mg * 32, s4 * 32, lane), a1 = frag_row(sKP, 272, mg * 32 + 16, s4 * 32, lane);
#define FR_(n) frag_tr(sV, 1040, ng * 256 + (n) * 16, 0, lane)
        SWEEP2(16, 2, FR_, a0, a1, acc, 16);
#undef FR_
      }
    }
#pragma unroll 1
    for (int dir = 0; dir < 2; ++dir) {
      const int off = i * 128 + mg * 32 + sl;
      const float xi0 = dir ? __expf(lgb * (float)(512 - off)) : __expf(lgf * (float)(off + 1));
      const float xi1 = dir ? __expf(lgb * (float)(496 - off)) : __expf(lgf * (float)(off + 17));
#pragma unroll 1
      for (int ds = 0; ds < 8; ++ds) {
        LDS_BAR();
#pragma unroll
        for (int q = 0; q < 4; ++q) *(LAS u32x4*)(sV + dR + q * RD) = pf[q];
        if (ds < 7 || dir == 0) { const u16* src = ds < 7 ? (dir ? rbase1 : rbase0) + (ds + 1) * 32 : rbase1;
#pragma unroll
          for (int q = 0; q < 4; ++q) pf[q] = *(const u32x4*)(src + q * RQ); }
        LDS_BAR();
        const bf16x8 a0 = scale_frag(frag_row(sQ, 528, mg * 32, ds * 32, lane), xi0), a1 = scale_frag(frag_row(sQ, 528, mg * 32 + 16, ds * 32, lane), xi1);
#define FR_(n) frag_row(sV, 80, ng * 256 + (n) * 16, 0, lane)
        SWEEP2(16, 2, FR_, a0, a1, acc, 16);
#undef FR_
      }
    }
#undef kbase
#undef vbase
#undef rbase0
#undef rbase1
    LDS_BAR();
    LAS float* sst = (LAS float*)sKP;
#pragma unroll
    for (int mi = 0; mi < 2; ++mi)
#pragma unroll
      for (int r = 0; r < 4; ++r) { float sm = 0.f;
#pragma unroll
        for (int n = 0; n < 16; ++n) sm += acc[mi * 16 + n][r];
        sm = red16l(sm, lane);
        if (sl == 0) sst[ng * 128 + mg * 32 + mi * 16 + 4 * lq + r] = sm; }
    LDS_BAR();
#pragma unroll
    for (int mi = 0; mi < 2; ++mi)
#pragma unroll
      for (int r = 0; r < 4; ++r) { const int t = mg * 32 + mi * 16 + 4 * lq + r; const float mu = (sst[t] + sst[128 + t]) * (1.f / 512.f); float v = 0.f;
#pragma unroll
        for (int n = 0; n < 16; ++n) { const float d = acc[mi * 16 + n][r] - mu; v += d * d; }
        v = red16l(v, lane);
        if (sl == 0) sst[256 + ng * 128 + t] = v; }
    LDS_BAR();
#pragma unroll
    for (int mi = 0; mi < 2; ++mi)
#pragma unroll
      for (int r = 0; r < 4; ++r) { const int t = mg * 32 + mi * 16 + 4 * lq + r; const float mu = (sst[t] + sst[128 + t]) * (1.f / 512.f);
        const float rstd = rsqrtf((sst[256 + t] + sst[384 + t]) * (1.f / 512.f) + 1e-6f);
        const size_t row = rowb + i * 128 + t;
#pragma unroll
        for (int n = 0; n < 16; ++n) { const int e = h * 512 + ng * 256 + n * 16 + sl; c.y[row * 2048 + e] = f2bf((acc[mi * 16 + n][r] - mu) * rstd * c.r_norm_g[e]); } }
    LDS_BAR();
  }
}

#define XB_TMO      128
#define XB_XCNT(j)  (256  + 64 * (j))
#define XB_XSUB(j)  (1280 + 64 * (j))
#define XB_XGEN(j)  (2304 + 64 * (j))
#define XB_TOP      3328
#define XB_TOPGEN   3392
#define XCD_BAR_WORDS 3456
#define XB_SPIN_CAP (1u << 18)
__device__ __forceinline__ unsigned xb_ld(unsigned* p)              { return __hip_atomic_load(p, __ATOMIC_RELAXED, __HIP_MEMORY_SCOPE_AGENT); }
__device__ __forceinline__ unsigned xb_add(unsigned* p, unsigned v) { return __hip_atomic_fetch_add(p, v, __ATOMIC_RELAXED, __HIP_MEMORY_SCOPE_AGENT); }
__device__ __forceinline__ unsigned xb_xcc_id() { return (unsigned)__builtin_amdgcn_s_getreg((3 << 11) | 20) & 0xFu; }
#define XB_SPIN(cond, bar) do { unsigned _sp = 0; while (cond) { __builtin_amdgcn_s_sleep(1); \
    if ((++_sp & 255u) == 0u) { if (xb_ld(&(bar)[XB_TMO])) break; if (_sp > XB_SPIN_CAP) { atomicAdd(&(bar)[XB_TMO], 1u); break; } } } } while (0)
struct XcdBarrier { unsigned* bar; unsigned x; volatile LAS unsigned* st; };
__device__ __forceinline__ XcdBarrier xcd_barrier_post(unsigned* bar, volatile LAS unsigned* st) {
    XcdBarrier b; b.bar = bar; b.x = xb_xcc_id(); b.st = st;
    if (threadIdx.x == 0) (void)xb_add(&bar[XB_XCNT(b.x)], 1u);
    return b;
}
__device__ __forceinline__ void xcd_barrier_complete(unsigned* bar, unsigned x, unsigned& nloc, unsigned& nx) {
    const unsigned G = gridDim.x * gridDim.y * gridDim.z;
    unsigned sum, cnt, mine, sp = 0u;
    for (;;) {
        sum = 0u; cnt = 0u; mine = 0u;
#pragma unroll
        for (unsigned j = 0; j < 16; ++j) { const unsigned c = xb_ld(&bar[XB_XCNT(j)]); sum += c; cnt += (c > 0u) ? 1u : 0u; mine = (j == x) ? c : mine; }
        if (sum == G) break;
        __builtin_amdgcn_s_sleep(1);
        if ((++sp & 255u) == 0u) { if (xb_ld(&bar[XB_TMO])) break; if (sp > XB_SPIN_CAP) { atomicAdd(&bar[XB_TMO], 1u); break; } }
    }
    nloc = mine > 0u ? mine : 1u; nx = cnt > 0u ? cnt : 1u;
}
__device__ __forceinline__ void xcd_barrier(const XcdBarrier& b, int wv) {
    asm volatile("s_waitcnt vmcnt(0)" ::: "memory");
    __syncthreads();
    int lno; asm volatile("v_mbcnt_lo_u32_b32 %0, -1, 0\n\tv_mbcnt_hi_u32_b32 %0, -1, %0" : "=v"(lno));
    if (wv == 0 && lno == 0) {
        unsigned* bar = b.bar;
        __builtin_amdgcn_s_waitcnt(0);
        unsigned nloc = b.st[0], nx = b.st[1];
        if (nloc == 0u) { xcd_barrier_complete(bar, b.x, nloc, nx); b.st[0] = nloc; b.st[1] = nx; }
        const unsigned old = xb_add(&bar[XB_XSUB(b.x)], 1u);
        const unsigned gen = old / nloc;
        if (old + 1u == (gen + 1u) * nloc) {
            __builtin_amdgcn_fence(__ATOMIC_RELEASE, "agent");
            asm volatile("s_waitcnt vmcnt(0)" ::: "memory");
            const unsigned og = xb_add(&bar[XB_TOP], 1u);
            const unsigned tg = og / nx;
            if (og + 1u == (tg + 1u) * nx) xb_add(&bar[XB_TOPGEN], 1u);
            else XB_SPIN(xb_ld(&bar[XB_TOPGEN]) == tg, bar);
            __builtin_amdgcn_fence(__ATOMIC_ACQUIRE, "agent");
            xb_add(&bar[XB_XGEN(b.x)], 1u);
            asm volatile("s_waitcnt vmcnt(0)" ::: "memory");
        } else {
            XB_SPIN(xb_ld(&bar[XB_XGEN(b.x)]) == gen, bar);
            __builtin_amdgcn_fence(__ATOMIC_ACQUIRE, "agent");
            asm volatile("s_waitcnt vmcnt(0)" ::: "memory");
        }
    }
    __syncthreads();
}

__global__ void __launch_bounds__(512) fwd_megakernel(Params p) {
  extern __shared__ __attribute__((aligned(16))) unsigned char shm[];
  ldsp lds = (ldsp)shm;
  cg::grid_group grid = cg::this_grid();
  const int wv = __builtin_amdgcn_readfirstlane((int)(threadIdx.x >> 6));
  volatile LAS unsigned* xst = (volatile LAS unsigned*)(lds + LDS_BYTES - 16);
  if (threadIdx.x == 0) { xst[0] = 0u; xst[1] = 0u; }
  __syncthreads();
  const XcdBarrier xb = xcd_barrier_post(p.c.bar, xst);
#pragma unroll 1
  for (int pi = 0; pi < p.nph; ++pi) {
    const Phase& ph = p.ph[pi];
    switch (ph.type) {
      case PH_INIT:
#ifndef NO_INIT
      phase_init(wv, lds, p.c);
#endif
      break;
      case PH_NORM:
#ifndef NO_NORM
      phase_norm(wv, lds, ph, p.c);
#endif
      break;
      case PH_GEMM:
#ifndef NO_GEMM
      gemm_phase(wv, lds, ph, p.c);
#endif
      break;
      case PH_MCONV:
#ifndef NO_MCONV
      phase_mconv(wv, p.c);
#endif
      break;
      case PH_MA:
#ifndef NO_MA
      phase_ma(wv, lds, p.c);
#endif
      break;
      case PH_MB:
#ifndef NO_MB
      phase_mb(wv, p.c);
#endif
      break;
      case PH_MC:
#ifndef NO_MC
      phase_mc(wv, lds, p.c);
#endif
      break;
      case PH_RA:
#ifndef NO_RA
      phase_ra(wv, lds, ph, p.c);
#endif
      break;
      case PH_RB:
#ifndef NO_RB
      phase_rb(wv, ph, p.c);
#endif
      break;
      case PH_RC:
#ifndef NO_RC
      phase_rc(wv, lds, ph, p.c);
#endif
      break;
      case PH_FINAL: phase_final(wv, p.c); break;
      default: break;
    }
    if (pi == 0) grid.sync(); else xcd_barrier(xb, wv);
  }
}

static void add_phase(Params& P, int type, int M, int N, int K, int i0, int i1, float f0, int pad, const void* A, const void* B, void* O, const void* X) {
  const int reps = (((DUP_TYPES >> type) & 1u) && (type != PH_GEMM || ((DUP_EPIS >> i0) & 1u))) ? 2 : 1;
  for (int rep = 0; rep < reps; ++rep) {
  Phase& ph = P.ph[P.nph++]; ph.type = type; ph.M = M; ph.N = N; ph.K = K; ph.i0 = i0; ph.i1 = i1; ph.f0 = f0; ph.pad = pad; ph.A = A; ph.B = B; ph.O = O; ph.X = X;
  }
}

extern "C" void kernel_launch(void* const* d_in, const int* in_sizes, int n_in, void* d_out, int out_size, void* d_ws, size_t ws_size, hipStream_t stream) {
  static int grid_blocks = 0;
  if (!grid_blocks) {
    int dev = 0, cus = 0, per_cu = 0;
    hipGetDevice(&dev);
    hipDeviceGetAttribute(&cus, hipDeviceAttributeMultiprocessorCount, dev);
    hipFuncSetAttribute((const void*)fwd_megakernel, hipFuncAttributeMaxDynamicSharedMemorySize, LDS_BYTES);
    hipOccupancyMaxActiveBlocksPerMultiprocessor(&per_cu, (const void*)fwd_megakernel, 512, LDS_BYTES);
    if (per_cu < 1) per_cu = 1;
    grid_blocks = cus * per_cu;
  }
  Params P; memset(&P, 0, sizeof(P));
  Ctx& c = P.c;
  c.x = (const float*)d_in[0]; c.c = (const float*)d_in[1]; c.ctx = (const float*)d_in[2]; c.c_ctx = (const float*)d_in[3];
  c.mod_w = (const float*)d_in[4]; c.mod_b = (const float*)d_in[5]; c.norm_g = (const float*)d_in[6]; c.w13 = (const float*)d_in[7]; c.w2 = (const float*)d_in[8];
  c.m_w_in = (const float*)d_in[9]; c.m_gate_b = (const float*)d_in[10]; c.m_conv_w = (const float*)d_in[11]; c.m_norm_g = (const float*)d_in[12]; c.m_w_out = (const float*)d_in[13];
  c.r_w_in = (const float*)d_in[14]; c.r_decay = (const float*)d_in[15]; c.r_norm_g = (const float*)d_in[16]; c.r_w_out = (const float*)d_in[17]; c.final_g = (const float*)d_in[18];
  c.out = (float*)d_out; c.y = (u16*)d_out;
  char* w = (char*)d_ws; size_t off = 0;
  auto take = [&](size_t bytes) { char* r = w + off; off += (bytes + 255) & ~(size_t)255; return r; };
  c.bar = (unsigned*)take((size_t)XCD_BAR_WORDS * 4);
  c.modv = (float*)take((size_t)2 * 5 * 9216 * 4);
  c.rope = (float*)take((size_t)8192 * 128 * 8);
  c.gates = (float*)take((size_t)NT * 32 * 4);
  c.mst_n = (float*)take((size_t)64 * 66 * 64 * 4);
  c.mst_s = (float*)take((size_t)3 * 4224 * 4);
  c.xr = (float*)take((size_t)NT * 1024 * 4);
  c.hb = (u16*)take((size_t)NT * 1024 * 2);
  c.wb = (u16*)take((size_t)(5632 + 2816) * 1024 * 2);
  c.big = (u16*)take((size_t)NT * 3072 * 2 + (size_t)64 * 66 * 8192 * 2);
  c.part = (float*)((char*)c.big + (size_t)NT * 2816 * 2);
  c.part2 = (float*)take((size_t)4 * 1024 * 1024 * 4);
  if (off > ws_size) { fprintf(stderr, "workspace too small: need %zu have %zu\n", off, ws_size); return; }
  u16* hid = c.big;
  for (int l = 0; l < 2; ++l) {
    if (l == 0) add_phase(P, PH_INIT, 0, 0, 0, 0, 0, 0.f, 0, nullptr, nullptr, nullptr, nullptr);
    const float* modl = c.modv + (size_t)l * 5 * 9216;
    add_phase(P, PH_NORM, NT, l == 0 ? 1 : (NSPL << 8), 0, l, 0, 0.5f, 0, nullptr, nullptr, nullptr, c.modv + 8 * 1024);
    add_phase(P, PH_GEMM, NT, 5632, 1024, EPI_SWIGLU, 0, 0.f, 0, c.hb, c.wb, hid, nullptr);
    add_phase(P, PH_GEMM, NT, 1024, 2816, EPI_RESID, SPLITF | (l == 0 ? 2 : 0), 0.5f, 0, hid, c.wb + (size_t)5632 * 1024, c.xr, modl + 2 * 1024);
    if (l == 0) {
      add_phase(P, PH_NORM, NT, NSPL << 8, 0, l, 1, 0.5f, 1, nullptr, nullptr, nullptr, modl + 2 * 1024);
      add_phase(P, PH_GEMM, NT, 3328, 1024, EPI_MLSTM_U, 0, 0.f, 0, c.hb, c.wb, c.big, nullptr);
      add_phase(P, PH_MCONV, 0, 0, 0, 0, 0, 0.f, 0, nullptr, nullptr, nullptr, nullptr);
      add_phase(P, PH_MA, 0, 0, 0, 0, 0, 0.f, 0, nullptr, nullptr, nullptr, nullptr);
      add_phase(P, PH_MB, 0, 0, 0, 0, 0, 0.f, 0, nullptr, nullptr, nullptr, nullptr);
      add_phase(P, PH_MC, 0, 0, 0, 0, 0, 0.f, 0, nullptr, nullptr, nullptr, nullptr);
      add_phase(P, PH_GEMM, NT, 1024, 1024, EPI_RESID, 1 | 4, 1.0f, 0, c.y, c.wb + (size_t)3328 * 1024, c.xr, modl + 5 * 1024);
    } else {
      add_phase(P, PH_NORM, NT, NSPL << 8, 0, l, 1, 0.5f, 2, nullptr, nullptr, nullptr, modl + 2 * 1024);
      for (int hp = 0; hp < 2; ++hp) {
        add_phase(P, PH_GEMM, NT, 2048, 1024, EPI_RET_U, 0, 0.f, 0, c.hb, c.wb + (size_t)hp * 2048 * 1024, c.big, nullptr);
        add_phase(P, PH_RA, 0, 0, 0, hp, 0, 0.f, 0, nullptr, nullptr, nullptr, nullptr);
        add_phase(P, PH_RB, 0, 0, 0, hp, 0, 0.f, 0, nullptr, nullptr, nullptr, nullptr);
        add_phase(P, PH_RC, 0, 0, 0, hp, 0, 0.f, 0, nullptr, nullptr, nullptr, nullptr);
      }
      add_phase(P, PH_GEMM, NL, 2048, 1024, EPI_GATE, 0, 0.f, 0, c.hb, c.wb + (size_t)4096 * 1024, c.y, nullptr);
      add_phase(P, PH_GEMM, NL, 1024, 2048, EPI_RESID, 0, 1.0f, 0, c.y, c.wb + (size_t)6144 * 1024, c.xr, modl + 5 * 1024);
    }
    const int M2 = l == 1 ? NL : NT;
    add_phase(P, PH_NORM, M2, l == 0 ? ((4 << 8) | 2) : 0, 1, l, 2, 1.0f, 0, nullptr, nullptr, nullptr, modl + 5 * 1024);
    add_phase(P, PH_GEMM, M2, 5632, 1024, EPI_SWIGLU, 0, 0.f, 0, c.hb, c.wb, hid, nullptr);
    add_phase(P, PH_GEMM, M2, 1024, 2816, EPI_RESID, l == 0 ? SPLITF : 16, 0.5f, 0, hid, c.wb + (size_t)5632 * 1024, c.xr, modl + 8 * 1024);
  }
#ifdef EXTRA_NOPS
  for (int q = 0; q < EXTRA_NOPS; ++q) add_phase(P, PH_NOP, 0, 0, 0, 0, 0, 0.f, 0, nullptr, nullptr, nullptr, nullptr);
#endif
  add_phase(P, PH_FINAL, 0, 0, 0, 0, 0, 0.f, 0, nullptr, nullptr, nullptr, nullptr);
  hipMemsetAsync(c.bar, 0, (size_t)XCD_BAR_WORDS * 4, stream);
  void* args[] = {&P};
  hipError_t e = hipLaunchCooperativeKernel((const void*)fwd_megakernel, dim3(grid_blocks), dim3(512), args, LDS_BYTES, stream);
  if (e != hipSuccess) fprintf(stderr, "cooperative launch failed: %s (grid %d)\n", hipGetErrorString(e), grid_blocks);
}
```

```cpp
#include <hip/hip_runtime.h>
#include <hip/hip_cooperative_groups.h>
#include <cstdio>
#include <cstring>
namespace cg = cooperative_groups;

typedef unsigned short u16;
typedef short bf16x8 __attribute__((ext_vector_type(8)));
typedef short s16x4 __attribute__((ext_vector_type(4)));
typedef float f32x4 __attribute__((ext_vector_type(4)));
typedef unsigned u32x4 __attribute__((ext_vector_type(4)));
typedef unsigned u32x2 __attribute__((ext_vector_type(2)));
#define LAS __attribute__((address_space(3)))
typedef LAS unsigned char* ldsp;

#define NT 33792
#define NL 32768
#define LDS_BYTES 155648

enum { PH_INIT = 0, PH_NORM, PH_GEMM, PH_MCONV, PH_MA, PH_MB, PH_MC, PH_RA, PH_RB, PH_RC, PH_FINAL, PH_NOP };
enum { EPI_SWIGLU = 0, EPI_RESID, EPI_MLSTM_U, EPI_RET_U, EPI_GATE };

struct Phase { int type, M, N, K; int i0, i1; float f0; int pad; const void* A; const void* B; void* O; const void* X; };
#define MAXPH 56
#ifndef SPLITF
#define SPLITF 1
#endif
#define NSPL (SPLITF ? 11 : 0)
#ifndef DUP_TYPES
#define DUP_TYPES 0u
#endif
#ifndef DUP_EPIS
#define DUP_EPIS 0u
#endif
struct Ctx {
  const float *x, *c, *ctx, *c_ctx, *mod_w, *mod_b, *norm_g, *w13, *w2, *m_w_in, *m_gate_b, *m_conv_w, *m_norm_g, *m_w_out, *r_w_in, *r_decay, *r_norm_g, *r_w_out, *final_g;
  float* out; float* modv; float* rope; float* gates; float* mst_n; float* mst_s; float* xr;
  u16* hb; u16* wb; u16* big; u16* y; unsigned* bar; float* part; float* part2;
};
struct Params { Ctx c; int nph; int pad; Phase ph[MAXPH]; };

typedef __bf16 bf16x2_t __attribute__((ext_vector_type(2)));
__device__ __forceinline__ u16 f2bf(float f) { return __builtin_bit_cast(u16, (__bf16)f); }
__device__ __forceinline__ float bf2f(u16 b) { return __uint_as_float(((unsigned)b) << 16); }
__device__ __forceinline__ unsigned pack2(float a, float b) { bf16x2_t v; v[0] = (__bf16)a; v[1] = (__bf16)b; return __builtin_bit_cast(unsigned, v); }
__device__ __forceinline__ float lo2f(unsigned w) { return __uint_as_float(w << 16); }
__device__ __forceinline__ float hi2f(unsigned w) { return __uint_as_float(w & 0xffff0000u); }
__device__ __forceinline__ float4 ldnt4(const float4* p) { const f32x4 v = __builtin_nontemporal_load((const f32x4*)p); return make_float4(v[0], v[1], v[2], v[3]); }
__device__ __forceinline__ void stnt4(float4* p, float4 v) { f32x4 t; t[0] = v.x; t[1] = v.y; t[2] = v.z; t[3] = v.w; __builtin_nontemporal_store(t, (f32x4*)p); }
__device__ __forceinline__ float siluf(float a) { return a * __builtin_amdgcn_rcpf(1.f + __expf(-a)); }
__device__ __forceinline__ float sigmf(float a) { return __builtin_amdgcn_rcpf(1.f + __expf(-a)); }
__device__ __forceinline__ float logsig(float a) { return fminf(a, 0.f) - log1pf(expf(-fabsf(a))); }

__device__ __forceinline__ bf16x8 frag_row(ldsp base, int pitch, int idx0, int k0, int lane) {
  return *(const LAS bf16x8*)(base + (idx0 + (lane & 15)) * pitch + (k0 + 8 * (lane >> 4)) * 2);
}
__device__ __forceinline__ bf16x8 frag_tr(ldsp base, int pitch, int idx0, int k0, int lane) {
  const int g = lane >> 4, li = lane & 15, q = li >> 2, p = li & 3;
  ldsp a = base + (k0 + 8 * g + q) * pitch + (idx0 + 4 * p) * 2;
  s16x4 lo = __builtin_amdgcn_ds_read_tr16_b64_v4i16((LAS s16x4*)a);
  s16x4 hi = __builtin_amdgcn_ds_read_tr16_b64_v4i16((LAS s16x4*)(a + 4 * pitch));
  bf16x8 r; r[0] = lo[0]; r[1] = lo[1]; r[2] = lo[2]; r[3] = lo[3]; r[4] = hi[0]; r[5] = hi[1]; r[6] = hi[2]; r[7] = hi[3]; return r;
}
#define LDS_BAR() do { asm volatile("s_waitcnt lgkmcnt(0)" ::: "memory"); __builtin_amdgcn_s_barrier(); asm volatile("" ::: "memory"); } while (0)
#define SWEEP(NT, DEPTH, FRAG, A, ACC) do { bf16x8 bq_[DEPTH]; __builtin_amdgcn_s_setprio(1); \
    _Pragma("unroll") for (int n_ = 0; n_ < DEPTH; ++n_) bq_[n_] = FRAG(n_); __builtin_amdgcn_sched_barrier(0); \
    _Pragma("unroll") for (int n_ = 0; n_ < NT; ++n_) { const bf16x8 cur_ = bq_[n_ % DEPTH]; if (n_ + DEPTH < NT) bq_[n_ % DEPTH] = FRAG(n_ + DEPTH); ACC[n_] = MFMA16(A, cur_, ACC[n_]); __builtin_amdgcn_sched_barrier(0); } __builtin_amdgcn_s_setprio(0); } while (0)
#define MFMA16(a, b, c) __builtin_amdgcn_mfma_f32_16x16x32_bf16((a), (b), (c), 0, 0, 0)
__device__ __forceinline__ float shx(float v, int m, int lane) { return __int_as_float(__builtin_amdgcn_ds_bpermute((lane ^ m) << 2, __float_as_int(v))); }
__device__ __forceinline__ float shup(float v, int d, int lane, float ident) { const int src = lane - d; const float r = __int_as_float(__builtin_amdgcn_ds_bpermute(src << 2, __float_as_int(v))); return src >= 0 ? r : ident; }
__device__ __forceinline__ float shdn(float v, int d, int lane, float ident) { const int src = lane + d; const float r = __int_as_float(__builtin_amdgcn_ds_bpermute(src << 2, __float_as_int(v))); return src < 64 ? r : ident; }
__device__ __forceinline__ float lane63(float v) { return __int_as_float(__builtin_amdgcn_readlane(__float_as_int(v), 63)); }
__device__ __forceinline__ float red16l(float v, int lane) { v += shx(v, 1, lane); v += shx(v, 2, lane); v += shx(v, 4, lane); v += shx(v, 8, lane); return v; }

namespace pg8 {
constexpr int BM = 256, BK = 64, HALF = 128, HTB = HALF * BK * 2, NXCD = 8, WGM = 8;
__device__ __forceinline__ int lds_byte(int r, int c) { const int st = (r >> 4) * 2 + (c >> 5), rr = r & 15, cc = c & 31, ob = rr * 64 + cc * 2; return st * 1024 + (ob ^ (((ob >> 9) & 1) << 5)); }
__device__ __forceinline__ void stage_rc(int b, int& R, int& C) { const int st = b / 1024, sb = b % 1024, swz = sb ^ (((sb >> 9) & 1) << 5); R = (st >> 1) * 16 + swz / 64; C = (st & 1) * 32 + (swz % 64) / 2; }
struct Unit { int pm, pn, k0, nt, at; };
struct StaticOrder {
  int nM, nN, nwg, G, c, nsplit, nsu, ntf;
  __device__ void init(int M, int N, int K, int split, int G_, int c_) { nM = M / BM; nN = N / BM; nsplit = 0; nsu = 0; ntf = K / BK;
    if (split) { nM = NL / BM; nsplit = K / 256; nsu = (M / BM - nM) * nN * nsplit; }
    nwg = nM * nN; G = G_; c = c_; }
  __device__ bool next(int i, Unit& u) const {
    const long L = (long)i * G + c;
    int pm = 0, pn = 0, k0 = 0, nt = ntf, at = 0; bool ok = true;
    if (L >= nwg) {
      const long s = L - nwg;
      if (s >= nsu) ok = false;
      else { const int ks = (int)(s % nsplit), r = (int)(s / nsplit); pn = r % nN; pm = nM + r / nN; k0 = ks * 256; nt = 4; at = ks + 1; }
    } else {
      int wgid = (int)L; { const int q = nwg / NXCD, r = nwg % NXCD, xcd = wgid % NXCD, off = wgid / NXCD; wgid = (xcd < r ? xcd * (q + 1) : r * (q + 1) + (xcd - r) * q) + off; }
      const int nig = WGM * nN, gid = wgid / nig, fm = gid * WGM, gsz = (nM - fm) < WGM ? (nM - fm) : WGM;
      pm = fm + ((wgid % nig) % gsz); pn = (wgid % nig) / gsz;
    }
    u.pm = pm; u.pn = pn; u.k0 = k0; u.nt = nt; u.at = at; return ok;
  }
};
}

__device__ __forceinline__ int perm32(int rho) { const int n = rho >> 4, i = rho & 15; return 8 * (i >> 2) + 4 * n + (i & 3); }
__device__ __forceinline__ void epi_apply(const Phase& ph, const Ctx& c, const f32x4 (&acc)[2][2][4][2], int pm, int pn, int at, int wr, int wc, int fr, int fq) {
  const int row0 = pm * 256 + wr * 64 + fr;
  const int epi = ph.i0;
  if (epi == EPI_SWIGLU) {
    u16* O = (u16*)ph.O;
    const int hc = pn * 128 + wc * 32 + fq * 8;
#pragma unroll
    for (int ai = 0; ai < 2; ++ai)
#pragma unroll
      for (int m = 0; m < 4; ++m) {
        const size_t row = row0 + ai * 128 + m * 16;
        const f32x4 a0 = acc[ai][0][m][0], b0 = acc[ai][1][m][0], a1 = acc[ai][0][m][1], b1 = acc[ai][1][m][1];
        u32x4 o; o.x = pack2(siluf(a0[0]) * b0[0], siluf(a0[1]) * b0[1]); o.y = pack2(siluf(a0[2]) * b0[2], siluf(a0[3]) * b0[3]);
        o.z = pack2(siluf(a1[0]) * b1[0], siluf(a1[1]) * b1[1]); o.w = pack2(siluf(a1[2]) * b1[2], siluf(a1[3]) * b1[3]);
        *(u32x4*)(O + row * 2816 + hc) = o;
      }
  } else if (epi == EPI_RESID) {
    float* X = (float*)ph.O; const float* gate = (const float*)ph.X; const float f0 = ph.f0;
    const int r256 = pm * 256; const int set = r256 < NL ? (r256 >> 13) : 4;
    const float* Xs = ((ph.i1 & 2) && r256 < NL) ? c.x : (const float*)X;
    gate += (size_t)set * 9216;
    if (ph.i1 & 16) {
      u16* D = c.hb;
#pragma unroll
      for (int bj = 0; bj < 2; ++bj)
#pragma unroll
        for (int n = 0; n < 2; ++n) {
          const int col = pn * 256 + bj * 128 + wc * 32 + n * 16 + fq * 4;
          const f32x4 g = *(const f32x4*)(gate + col);
#pragma unroll
          for (int ai = 0; ai < 2; ++ai)
#pragma unroll
            for (int m = 0; m < 4; ++m) { const size_t row = row0 + ai * 128 + m * 16; const f32x4 a4 = acc[ai][bj][m][n];
              u32x2 o; o.x = pack2(f0 * g[0] * a4[0], f0 * g[1] * a4[1]); o.y = pack2(f0 * g[2] * a4[2], f0 * g[3] * a4[3]);
              *(u32x2*)(D + row * 1024 + col) = o; }
        }
    } else if (at) {
      float* P = ((ph.i1 & 4) ? c.part2 : c.part) + ((size_t)(at - 1) * 1024 - NL) * 1024;
#pragma unroll
      for (int bj = 0; bj < 2; ++bj)
#pragma unroll
        for (int n = 0; n < 2; ++n) {
          const int col = pn * 256 + bj * 128 + wc * 32 + n * 16 + fq * 4;
#pragma unroll
          for (int ai = 0; ai < 2; ++ai)
#pragma unroll
            for (int m = 0; m < 4; ++m) { const size_t row = row0 + ai * 128 + m * 16; *(f32x4*)(P + row * 1024 + col) = acc[ai][bj][m][n]; }
        }
    } else {
#pragma unroll
      for (int bj = 0; bj < 2; ++bj)
#pragma unroll
        for (int n = 0; n < 2; ++n) {
          const int col = pn * 256 + bj * 128 + wc * 32 + n * 16 + fq * 4;
          const f32x4 g = *(const f32x4*)(gate + col);
#pragma unroll
          for (int ai = 0; ai < 2; ++ai)
#pragma unroll
            for (int m = 0; m < 4; ++m) {
              const size_t row = row0 + ai * 128 + m * 16;
              f32x4 xv = *(const f32x4*)(Xs + row * 1024 + col); const f32x4 a = acc[ai][bj][m][n];
              xv[0] += f0 * g[0] * a[0]; xv[1] += f0 * g[1] * a[1]; xv[2] += f0 * g[2] * a[2]; xv[3] += f0 * g[3] * a[3];
              *(f32x4*)(X + row * 1024 + col) = xv;
            }
        }
    }
  } else if (epi == EPI_MLSTM_U) {
    if (pn < 12) {
      u16* O = (u16*)ph.O;
#pragma unroll
      for (int ai = 0; ai < 2; ++ai)
#pragma unroll
        for (int m = 0; m < 4; ++m) {
          const size_t row = row0 + ai * 128 + m * 16;
#pragma unroll
          for (int bj = 0; bj < 2; ++bj) {
            const int col = pn * 256 + bj * 128 + wc * 32 + fq * 8; const f32x4 a0 = acc[ai][bj][m][0], a1 = acc[ai][bj][m][1];
            u32x4 o; o.x = pack2(a0[0], a0[1]); o.y = pack2(a0[2], a0[3]); o.z = pack2(a1[0], a1[1]); o.w = pack2(a1[2], a1[3]);
            *(u32x4*)(O + row * 3072 + col) = o;
          }
        }
    } else if (wc == 0) {
      float* G = c.gates; const float* gb = c.m_gate_b;
#pragma unroll
      for (int n = 0; n < 2; ++n) {
        const int col = fq * 8 + n * 4; const f32x4 b = *(const f32x4*)(gb + col);
#pragma unroll
        for (int ai = 0; ai < 2; ++ai)
#pragma unroll
          for (int m = 0; m < 4; ++m) {
            const size_t row = row0 + ai * 128 + m * 16; const f32x4 a = acc[ai][0][m][n];
            f32x4 o; o[0] = a[0] + b[0]; o[1] = a[1] + b[1]; o[2] = a[2] + b[2]; o[3] = a[3] + b[3];
            *(f32x4*)(G + row * 32 + col) = o;
          }
      }
    }
  } else if (epi == EPI_RET_U) {
    u16* O = (u16*)ph.O; const float* rope = c.rope;
    const bool dorope = (pn < 4) && (pm * 256 < NL);
#pragma unroll
    for (int ai = 0; ai < 2; ++ai)
#pragma unroll
      for (int m = 0; m < 4; ++m) {
        const size_t row = row0 + ai * 128 + m * 16; const int t = (int)(row & 8191);
#pragma unroll
        for (int bj = 0; bj < 2; ++bj) {
          const int col = pn * 256 + bj * 128 + wc * 32 + fq * 8; f32x4 a0 = acc[ai][bj][m][0], a1 = acc[ai][bj][m][1];
          if (dorope) {
            const int p0 = (col & 255) >> 1;
            const f32x4 c0 = *(const f32x4*)(rope + ((size_t)t * 128 + p0) * 2), c1 = *(const f32x4*)(rope + ((size_t)t * 128 + p0) * 2 + 4);
            const float e0 = a0[0] * c0[0] - a0[1] * c0[1], o0 = a0[0] * c0[1] + a0[1] * c0[0];
            const float e1 = a0[2] * c0[2] - a0[3] * c0[3], o1 = a0[2] * c0[3] + a0[3] * c0[2];
            const float e2 = a1[0] * c1[0] - a1[1] * c1[1], o2 = a1[0] * c1[1] + a1[1] * c1[0];
            const float e3 = a1[2] * c1[2] - a1[3] * c1[3], o3 = a1[2] * c1[3] + a1[3] * c1[2];
            a0[0] = e0; a0[1] = o0; a0[2] = e1; a0[3] = o1; a1[0] = e2; a1[1] = o2; a1[2] = e3; a1[3] = o3;
          }
          u32x4 o; o.x = pack2(a0[0], a0[1]); o.y = pack2(a0[2], a0[3]); o.z = pack2(a1[0], a1[1]); o.w = pack2(a1[2], a1[3]);
          *(u32x4*)(O + row * 2048 + col) = o;
        }
      }
  } else {
    u16* O = (u16*)ph.O;
#pragma unroll
    for (int ai = 0; ai < 2; ++ai)
#pragma unroll
      for (int m = 0; m < 4; ++m) {
        const size_t row = row0 + ai * 128 + m * 16;
#pragma unroll
        for (int bj = 0; bj < 2; ++bj) {
          const int col = pn * 256 + bj * 128 + wc * 32 + fq * 8; const f32x4 a0 = acc[ai][bj][m][0], a1 = acc[ai][bj][m][1];
          u32x4* yp = (u32x4*)(O + row * 2048 + col); u32x4 yv = *yp;
          yv.x = pack2(lo2f(yv.x) * siluf(a0[0]), hi2f(yv.x) * siluf(a0[1])); yv.y = pack2(lo2f(yv.y) * siluf(a0[2]), hi2f(yv.y) * siluf(a0[3]));
          yv.z = pack2(lo2f(yv.z) * siluf(a1[0]), hi2f(yv.z) * siluf(a1[1])); yv.w = pack2(lo2f(yv.w) * siluf(a1[2]), hi2f(yv.w) * siluf(a1[3]));
          *yp = yv;
        }
      }
  }
}

__device__ __forceinline__ void gemm_phase(int wv, ldsp lds, const Phase& ph, const Ctx& c) {
  using namespace pg8;
  int wvo = wv; asm volatile("" : "+s"(wvo)); int lno; asm volatile("v_mbcnt_lo_u32_b32 %0, -1, 0\n\tv_mbcnt_hi_u32_b32 %0, -1, %0" : "=v"(lno)); int tid = (wvo << 6) | lno; const int wid = __builtin_amdgcn_readfirstlane(tid >> 6), lane = tid & 63, wr = wid >> 2, wc = wid & 3, fr = lane & 15, fq = lane >> 4;
  const int K = ph.K;
  StaticOrder S; S.init(ph.M, ph.N, ph.K, ph.i1 & 1, gridDim.x, blockIdx.x);
  unsigned voffA[2];
#pragma unroll
  for (int i = 0; i < 2; ++i) { int R, C; stage_rc(tid * 16 + i * 8192, R, C); voffA[i] = (unsigned)(R * K + C) * 2u; }
  const size_t kstep = (size_t)(BK * 2);
  const size_t hstep = (size_t)HALF * K * 2;
  const size_t tstep = 2 * hstep;
  const unsigned ldsw = (unsigned)wid * 1024u;
  const int aoff = lds_byte(wr * 64 + fr, fq * 8), boff = lds_byte(wc * 32 + fr, fq * 8);
#define PG8_SA(b, h) (((b) * 2 + (h)) * HTB)
#define PG8_SB(b, h) ((4 + (b) * 2 + (h)) * HTB)
#define PG8_STAGE(bufoff, gbase, voff) do { _Pragma("unroll") for (int _i = 0; _i < 2; ++_i) \
    __builtin_amdgcn_global_load_lds((const unsigned*)((const char*)(gbase) + (voff)[_i]), (LAS unsigned*)(lds + (bufoff) + ldsw + _i * 8192), 16, 0, 0); } while (0)
#define PG8_LDA(dst, b, h) do { _Pragma("unroll") for (int m = 0; m < 4; ++m) _Pragma("unroll") for (int k = 0; k < 2; ++k) dst[m][k] = *(const LAS bf16x8*)(lds + PG8_SA(b, h) + aoff + m * 2048 + k * 1024); } while (0)
#define PG8_LDB(dst, b, h) do { _Pragma("unroll") for (int n = 0; n < 2; ++n) _Pragma("unroll") for (int k = 0; k < 2; ++k) dst[n][k] = *(const LAS bf16x8*)(lds + PG8_SB(b, h) + boff + n * 2048 + k * 1024); } while (0)
#define PG8_MMA(ai, bj, At, Bt) do { __builtin_amdgcn_s_setprio(1); _Pragma("unroll") for (int m = 0; m < 4; ++m) _Pragma("unroll") for (int n = 0; n < 2; ++n) _Pragma("unroll") for (int k = 0; k < 2; ++k) \
    acc[ai][bj][m][n] = __builtin_amdgcn_mfma_f32_16x16x32_bf16(Bt[n][k], At[m][k], acc[ai][bj][m][n], 0, 0, 0); __builtin_amdgcn_s_setprio(0); } while (0)
#define PG8_WAIT_V(n) asm volatile("s_waitcnt vmcnt(" #n ")" ::: "memory")
#define PG8_WAIT_L(n) asm volatile("s_waitcnt lgkmcnt(" #n ")" ::: "memory")
#define PG8_BAR __builtin_amdgcn_s_barrier()
#define PG8_SCHED __builtin_amdgcn_sched_barrier(0)
  Unit cur, nxt; int ui = 0;
  if (!S.next(0, cur)) return;
  f32x4 acc[2][2][4][2];
#pragma unroll
  for (int a = 0; a < 2; ++a)
#pragma unroll
    for (int b = 0; b < 2; ++b)
#pragma unroll
      for (int m = 0; m < 4; ++m)
#pragma unroll
        for (int n = 0; n < 2; ++n) acc[a][b][m][n] = (f32x4){0.f, 0.f, 0.f, 0.f};
  bf16x8 At[4][2], B0[2][2], B1[2][2];
  const char* cA = (const char*)ph.A + (size_t)cur.pm * tstep + (size_t)cur.k0 * 2; const char* cB = (const char*)ph.B + (size_t)cur.pn * tstep + (size_t)cur.k0 * 2;
  PG8_STAGE(PG8_SB(0, 0), cB, voffA); PG8_STAGE(PG8_SA(0, 0), cA, voffA); PG8_STAGE(PG8_SB(0, 1), cB + hstep, voffA); PG8_STAGE(PG8_SA(0, 1), cA + hstep, voffA);
  if (wr == 1) PG8_BAR;
  PG8_WAIT_V(4); PG8_BAR;
  PG8_STAGE(PG8_SB(1, 0), cB + kstep, voffA); PG8_STAGE(PG8_SA(1, 0), cA + kstep, voffA); PG8_STAGE(PG8_SB(1, 1), cB + hstep + kstep, voffA);
  PG8_WAIT_V(6); PG8_BAR;
  for (;;) {
    const bool has_next = S.next(ui + 1, nxt);
    const char* nA = has_next ? (const char*)ph.A + (size_t)nxt.pm * tstep + (size_t)nxt.k0 * 2 : cA; const char* nB = has_next ? (const char*)ph.B + (size_t)nxt.pn * tstep + (size_t)nxt.k0 * 2 : cB;
    const int nt = cur.nt;
    asm volatile(".p2align 8");
    for (int t = 0; t < nt; t += 2) {
      const bool last = (t == nt - 2);
      const char* a1 = cA + (size_t)(t + 1) * kstep;
      const char* a2 = last ? nA : cA + (size_t)(t + 2) * kstep; const char* b2 = last ? nB : cB + (size_t)(t + 2) * kstep;
      const char* a3 = a2 + kstep; const char* b3 = b2 + kstep;
      PG8_LDB(B0, 0, 0); PG8_SCHED; PG8_LDA(At, 0, 0); PG8_STAGE(PG8_SA(1, 1), a1 + hstep, voffA);
      PG8_WAIT_L(8); PG8_BAR; PG8_WAIT_L(0); PG8_MMA(0, 0, At, B0); PG8_BAR; PG8_SCHED;
      PG8_LDB(B1, 0, 1); PG8_STAGE(PG8_SB(0, 0), b2, voffA);
      PG8_BAR; PG8_WAIT_L(0); PG8_MMA(0, 1, At, B1); PG8_BAR;
      PG8_LDA(At, 0, 1); PG8_STAGE(PG8_SA(0, 0), a2, voffA);
      PG8_BAR; PG8_WAIT_L(0); PG8_MMA(1, 0, At, B0); PG8_BAR; PG8_SCHED;
      PG8_STAGE(PG8_SB(0, 1), b2 + hstep, voffA);
      PG8_WAIT_V(6); PG8_BAR; PG8_MMA(1, 1, At, B1); PG8_BAR;
      PG8_LDB(B0, 1, 0); PG8_SCHED; PG8_LDA(At, 1, 0); PG8_STAGE(PG8_SA(0, 1), a2 + hstep, voffA);
      PG8_WAIT_L(8); PG8_BAR; PG8_WAIT_L(0); PG8_MMA(0, 0, At, B0); PG8_BAR; PG8_SCHED;
      PG8_LDB(B1, 1, 1); PG8_STAGE(PG8_SB(1, 0), b3, voffA);
      PG8_BAR; PG8_WAIT_L(0); PG8_MMA(0, 1, At, B1); PG8_BAR;
      PG8_LDA(At, 1, 1); PG8_STAGE(PG8_SA(1, 0), a3, voffA);
      PG8_BAR; PG8_WAIT_L(0); PG8_MMA(1, 0, At, B0); PG8_BAR; PG8_SCHED;
      PG8_STAGE(PG8_SB(1, 1), b3 + hstep, voffA);
      PG8_WAIT_V(6); PG8_BAR; PG8_MMA(1, 1, At, B1); PG8_BAR;
    }
    epi_apply(ph, c, acc, cur.pm, cur.pn, cur.at, wr, wc, fr, fq);
    if (!has_next) break;
#pragma unroll
    for (int a = 0; a < 2; ++a)
#pragma unroll
      for (int b = 0; b < 2; ++b)
#pragma unroll
        for (int m = 0; m < 4; ++m)
#pragma unroll
          for (int n = 0; n < 2; ++n) acc[a][b][m][n] = (f32x4){0.f, 0.f, 0.f, 0.f};
    cur = nxt; cA = nA; cB = nB; ++ui;
  }
  PG8_WAIT_V(0);
  if (wr == 0) PG8_BAR;
  PG8_BAR;
}

__device__ void phase_init(int wv, ldsp lds, const Ctx& c) {
  int wvo = wv; asm volatile("" : "+s"(wvo)); int lno; asm volatile("v_mbcnt_lo_u32_b32 %0, -1, 0\n\tv_mbcnt_hi_u32_b32 %0, -1, %0" : "=v"(lno)); int tid = (wvo << 6) | lno; const int wid = tid >> 6, lane = tid & 63;
  LAS float* sc = (LAS float*)lds;
  LAS float* red = (LAS float*)(lds + 20480);
  for (int i = tid; i < 5120; i += 512) { const int s = i >> 10, k = i & 1023; const float v = s < 4 ? c.c[s * 1024 + k] : c.c_ctx[k]; sc[i] = siluf(v); }
  __syncthreads();
  for (int item = blockIdx.x; item < 288; item += gridDim.x) {
    const int l = item / 144, j0 = (item % 144) * 64;
    const float* w = c.mod_w + (size_t)l * 1024 * 9216 + j0 + lane;
    float a0 = 0, a1 = 0, a2 = 0, a3 = 0, a4 = 0;
    for (int k = wid * 128; k < wid * 128 + 128; ++k) {
      const float wv = w[(size_t)k * 9216];
      a0 += sc[k] * wv; a1 += sc[1024 + k] * wv; a2 += sc[2048 + k] * wv; a3 += sc[3072 + k] * wv; a4 += sc[4096 + k] * wv;
    }
    red[(wid * 5 + 0) * 64 + lane] = a0; red[(wid * 5 + 1) * 64 + lane] = a1; red[(wid * 5 + 2) * 64 + lane] = a2; red[(wid * 5 + 3) * 64 + lane] = a3; red[(wid * 5 + 4) * 64 + lane] = a4;
    __syncthreads();
    if (tid < 320) { const int s = tid >> 6; float v = 0; for (int ww = 0; ww < 8; ++ww) v += red[(ww * 5 + s) * 64 + lane];
      c.modv[(size_t)(l * 5 + s) * 9216 + j0 + lane] = v + c.mod_b[l * 9216 + j0 + lane]; }
    __syncthreads();
  }
  const size_t gt = (size_t)blockIdx.x * 512 + tid, gs = (size_t)gridDim.x * 512;
  for (size_t i = gt; i < (size_t)8192 * 128; i += gs) {
    const int t = (int)(i >> 7), p = (int)(i & 127); const int f = p & 63; const int pos = p < 64 ? (t >> 6) : (t & 63);
    const double inv = (double)exp2f(-(float)f * 0.20762050593046015f);
    const double rev = (double)pos * inv * 0.15915494309189535; const float fr = (float)(rev - rint(rev));
    c.rope[i * 2] = __builtin_amdgcn_cosf(fr); c.rope[i * 2 + 1] = __builtin_amdgcn_sinf(fr);
  }
  const float4* cs = (const float4*)c.ctx; float4* xd = (float4*)c.xr;
  for (size_t i = gt; i < (size_t)(NT - NL) * 256; i += gs) xd[(size_t)NL * 256 + i] = cs[i];
}

struct TileD { const float* src; u16* dst; int ld, nvalid, sc0, K, n0, k0, perm; float scale; };
__device__ __forceinline__ void tile_desc(const Ctx& c, int kind, int l, int f, int it, TileD& d) {
  const float* src; u16* dst; int ld, nvalid, sc0, K, n0, k0, perm = 1; float scale = 1.f;
  if (kind == 0) {
    if (it < 1408) { const int nb = it >> 4, kb = it & 15; const int pn = nb >> 2, q = nb & 3;
      src = c.w13 + (size_t)(l * 2 + f) * 1024 * 5632; dst = c.wb; ld = 5632; nvalid = 5632; sc0 = (q < 2 ? 0 : 2816) + 128 * pn + (q & 1) * 64; K = 1024; n0 = nb * 64; k0 = kb * 64; }
    else { const int i2 = it - 1408; const int nb = i2 / 44, kb = i2 % 44;
      perm = 0; src = c.w2 + (size_t)(l * 2 + f) * 2816 * 1024; dst = c.wb + (size_t)5632 * 1024; ld = 1024; nvalid = 1024; sc0 = nb * 64; K = 2816; n0 = nb * 64; k0 = kb * 64; }
  } else if (kind == 1) {
    if (it < 832) { const int nb = it >> 4, kb = it & 15; src = c.m_w_in; dst = c.wb; ld = 3104; nvalid = 3104; sc0 = nb * 64; K = 1024; n0 = nb * 64; k0 = kb * 64; }
    else { const int i2 = it - 832; const int nb = i2 >> 4, kb = i2 & 15; perm = 0; src = c.m_w_out; dst = c.wb + (size_t)3328 * 1024; ld = 1024; nvalid = 1024; sc0 = nb * 64; K = 1024; n0 = nb * 64; k0 = kb * 64; }
  } else {
    if (it < 1536) { const int nb = it >> 4, kb = it & 15; const int n = nb * 64; int s0;
      if (n < 4096) { const int hp = n >> 11, r = n & 2047; if (r < 512) s0 = hp * 512 + r; else if (r < 1024) { s0 = 1024 + hp * 512 + (r - 512); scale = 0.0625f; } else s0 = 2048 + hp * 1024 + (r - 1024); }
      else s0 = n;
      src = c.r_w_in; dst = c.wb; ld = 6144; nvalid = 6144; sc0 = s0; K = 1024; n0 = n; k0 = kb * 64; }
    else { const int i2 = it - 1536; const int nb = i2 >> 5, kb = i2 & 31; perm = 0; src = c.r_w_out; dst = c.wb + (size_t)6144 * 1024; ld = 1024; nvalid = 1024; sc0 = nb * 64; K = 2048; n0 = nb * 64; k0 = kb * 64; }
  }
  d.src = src; d.dst = dst; d.ld = ld; d.nvalid = nvalid; d.sc0 = sc0; d.K = K; d.n0 = n0; d.k0 = k0; d.perm = perm; d.scale = scale;
}
__device__ __forceinline__ void tile_load(const TileD& d, int tid, float4& v0, float4& v1) {
  const int kk = tid >> 4, c4 = (tid & 15) * 4; const int col = d.sc0 + c4;
  v0 = make_float4(0.f, 0.f, 0.f, 0.f); v1 = v0;
  if (col < d.nvalid) { const float* p = d.src + (size_t)(d.k0 + kk) * d.ld + col; v0 = *(const float4*)p; v1 = *(const float4*)(p + (size_t)32 * d.ld); }
}

__device__ void phase_norm(int wv, ldsp lds, const Phase& ph, const Ctx& c) {
  int wvo = wv; asm volatile("" : "+s"(wvo)); int lno; asm volatile("v_mbcnt_lo_u32_b32 %0, -1, 0\n\tv_mbcnt_hi_u32_b32 %0, -1, %0" : "=v"(lno)); int tid = (wvo << 6) | lno; const int wid = tid >> 6, lane = tid & 63;
  const int l = ph.i0, j = ph.i1, kind = ph.pad;
  {
    const int ntile = kind == 0 ? 2112 : (kind == 1 ? 1088 : 2048);
    LAS float* tile = (LAS float*)lds;
    TileD d; float4 p0, p1; int it = blockIdx.x; asm volatile("" : "+s"(it));
    if (it < ntile) { tile_desc(c, kind, l, ph.K, it, d); tile_load(d, tid, p0, p1); }
#pragma unroll 1
    for (; it < ntile; it += gridDim.x) {
      const float sc = d.scale; const int dperm = d.perm; u16* dptr = d.dst + (size_t)(d.n0 + (tid >> 3)) * d.K + d.k0 + (tid & 7) * 8;
      { const int kk = tid >> 4, c4 = (tid & 15) * 4;
        tile[kk * 65 + c4] = p0.x * sc; tile[kk * 65 + c4 + 1] = p0.y * sc; tile[kk * 65 + c4 + 2] = p0.z * sc; tile[kk * 65 + c4 + 3] = p0.w * sc;
        tile[(kk + 32) * 65 + c4] = p1.x * sc; tile[(kk + 32) * 65 + c4 + 1] = p1.y * sc; tile[(kk + 32) * 65 + c4 + 2] = p1.z * sc; tile[(kk + 32) * 65 + c4 + 3] = p1.w * sc; }
      if (it + (int)gridDim.x < ntile) { tile_desc(c, kind, l, ph.K, it + gridDim.x, d); tile_load(d, tid, p0, p1); }
      __syncthreads();
      { const int nd = tid >> 3, kc = (tid & 7) * 8; const int n = dperm ? (nd & 32) + perm32(nd & 31) : nd; u32x4 o;
        o.x = pack2(tile[(kc + 0) * 65 + n], tile[(kc + 1) * 65 + n]); o.y = pack2(tile[(kc + 2) * 65 + n], tile[(kc + 3) * 65 + n]);
        o.z = pack2(tile[(kc + 4) * 65 + n], tile[(kc + 5) * 65 + n]); o.w = pack2(tile[(kc + 6) * 65 + n], tile[(kc + 7) * 65 + n]);
        *(u32x4*)dptr = o; }
      __syncthreads();
    }
  }
  const float* g = c.norm_g + (size_t)(l * 3 + j) * 1024;
  const int nsplit = ph.N >> 8; const float* pbase = (ph.N & 2) ? c.part2 : c.part;
  const int rstride = gridDim.x * 8;
  float4 nv[4];
  { const int row = blockIdx.x * 8 + wid;
    if (row < ph.M) { const float4* xp = (const float4*)((((ph.N & 1) && row < NL) ? c.x : c.xr) + (size_t)row * 1024);
#pragma unroll
      for (int i = 0; i < 4; ++i) nv[i] = ldnt4(xp + lane + 64 * i); } }
  int curset = -1; float4 cA[4], cB[4];
#pragma unroll
  for (int i = 0; i < 4; ++i) { cA[i] = make_float4(0.f, 0.f, 0.f, 0.f); cB[i] = cA[i]; }
  for (int row = blockIdx.x * 8 + wid; row < ph.M; row += rstride) {
    float4 v[4]; float ss = 0.f;
#pragma unroll
    for (int i = 0; i < 4; ++i) v[i] = nv[i];
    { const int nrow = row + rstride;
      if (nrow < ph.M) { const float4* xp = (const float4*)((((ph.N & 1) && nrow < NL) ? c.x : c.xr) + (size_t)nrow * 1024);
#pragma unroll
        for (int i = 0; i < 4; ++i) nv[i] = ldnt4(xp + lane + 64 * i); } }
    if (nsplit > 0 && row >= NL) {
      const float4* gp = (const float4*)((const float*)ph.X + (size_t)4 * 9216);
#pragma unroll
      for (int i = 0; i < 4; ++i) { float4 a = make_float4(0.f, 0.f, 0.f, 0.f);
        for (int ks = 0; ks < nsplit; ++ks) { const float4 pv = ((const float4*)(pbase + ((size_t)ks * 1024 + (row - NL)) * 1024))[lane + 64 * i]; a.x += pv.x; a.y += pv.y; a.z += pv.z; a.w += pv.w; }
        const float4 g4 = gp[lane + 64 * i]; const float f0 = ph.f0;
        v[i].x += f0 * g4.x * a.x; v[i].y += f0 * g4.y * a.y; v[i].z += f0 * g4.z * a.z; v[i].w += f0 * g4.w * a.w;
        ((float4*)(c.xr + (size_t)row * 1024))[lane + 64 * i] = v[i]; }
    }
#pragma unroll
    for (int i = 0; i < 4; ++i) ss += v[i].x * v[i].x + v[i].y * v[i].y + v[i].z * v[i].z + v[i].w * v[i].w;
#pragma unroll
    for (int o = 1; o < 64; o <<= 1) ss += shx(ss, o, lane);
    const float rstd = rsqrtf(ss * (1.f / 1024.f) + 1e-6f);
    const int set = row < NL ? (row >> 13) : 4;
    if (set != curset) { curset = set;
      const float* sh = c.modv + (size_t)(l * 5 + set) * 9216 + (3 * j) * 1024; const float* sc = sh + 1024;
#pragma unroll
      for (int i = 0; i < 4; ++i) { const int q = lane + 64 * i; const float4 g4 = ((const float4*)g)[q], s4 = ((const float4*)sh)[q], c4 = ((const float4*)sc)[q];
        cA[i] = make_float4(g4.x * (1.f + c4.x), g4.y * (1.f + c4.y), g4.z * (1.f + c4.z), g4.w * (1.f + c4.w)); cB[i] = s4; } }
#pragma unroll
    for (int i = 0; i < 4; ++i) {
      const int q = lane + 64 * i;
      u32x2 o; o.x = pack2(v[i].x * rstd * cA[i].x + cB[i].x, v[i].y * rstd * cA[i].y + cB[i].y);
      o.y = pack2(v[i].z * rstd * cA[i].z + cB[i].z, v[i].w * rstd * cA[i].w + cB[i].w);
      *(u32x2*)(c.hb + (size_t)row * 1024 + q * 4) = o;
    }
  }
}

__device__ void phase_final(int wv, const Ctx& c) {
  int wvo = wv; asm volatile("" : "+s"(wvo)); int lno; asm volatile("v_mbcnt_lo_u32_b32 %0, -1, 0\n\tv_mbcnt_hi_u32_b32 %0, -1, %0" : "=v"(lno)); int tid = (wvo << 6) | lno; const int wid = tid >> 6, lane = tid & 63;
  for (int row = blockIdx.x * 8 + wid; row < NL; row += gridDim.x * 8) {
    const float4* xp = (const float4*)(c.xr + (size_t)row * 1024);
    float4 v[4]; float ss = 0.f;
#pragma unroll
    for (int i = 0; i < 4; ++i) { v[i] = ldnt4(xp + lane + 64 * i);
      { const u32x2 d = *(const u32x2*)(c.hb + (size_t)row * 1024 + (lane + 64 * i) * 4); v[i].x += lo2f(d.x); v[i].y += hi2f(d.x); v[i].z += lo2f(d.y); v[i].w += hi2f(d.y); }
      ss += v[i].x * v[i].x + v[i].y * v[i].y + v[i].z * v[i].z + v[i].w * v[i].w; }
#pragma unroll
    for (int o = 1; o < 64; o <<= 1) ss += shx(ss, o, lane);
    const float rstd = rsqrtf(ss * (1.f / 1024.f) + 1e-6f);
#pragma unroll
    for (int i = 0; i < 4; ++i) { const int q = lane + 64 * i; const float4 g4 = ((const float4*)c.final_g)[q];
      float4 o; o.x = v[i].x * rstd * g4.x; o.y = v[i].y * rstd * g4.y; o.z = v[i].z * rstd * g4.z; o.w = v[i].w * rstd * g4.w;
      stnt4((float4*)(c.out + (size_t)row * 1024) + q, o); }
  }
}

#define MPRE_ELEMS ((size_t)NT * 3072)
__device__ __forceinline__ int m_chunk_row0(int b, int dir, int cs) {
  if (cs < 2) { const int j = dir ? 1 - cs : cs; return NL + b * 256 + j * 128; }
  const int j = dir ? 65 - cs : cs - 2; return b * 8192 + j * 128;
}

__device__ void phase_mconv(int wv, const Ctx& c) {
  const u16* pre = c.big; const float* cw = c.m_conv_w;
  int wvo = wv; asm volatile("" : "+s"(wvo)); int lno; asm volatile("v_mbcnt_lo_u32_b32 %0, -1, 0\n\tv_mbcnt_hi_u32_b32 %0, -1, %0" : "=v"(lno)); int tid = (wvo << 6) | lno; const size_t gt = (size_t)blockIdx.x * 512 + tid, gs = (size_t)gridDim.x * 512;
  for (size_t i = gt; i < (size_t)NT * 128; i += gs) {
    const int r = (int)(i >> 7), cg = (int)(i & 127) * 8;
    int pos, len; if (r < NL) { pos = r & 8191; len = 8192; } else { pos = (r - NL) & 255; len = 256; }
    float a[8];
#pragma unroll
    for (int q = 0; q < 8; ++q) a[q] = 0.f;
#pragma unroll
    for (int j = 0; j < 5; ++j) {
      const int pp = pos + j - 2;
      if (pp >= 0 && pp < len) {
        const u32x4 u = *(const u32x4*)(pre + (size_t)(r + j - 2) * 3072 + cg);
        const float4 w0 = *(const float4*)(cw + j * 1024 + cg), w1 = *(const float4*)(cw + j * 1024 + cg + 4);
        a[0] += w0.x * lo2f(u.x); a[1] += w0.y * hi2f(u.x); a[2] += w0.z * lo2f(u.y); a[3] += w0.w * hi2f(u.y);
        a[4] += w1.x * lo2f(u.z); a[5] += w1.y * hi2f(u.z); a[6] += w1.z * lo2f(u.w); a[7] += w1.w * hi2f(u.w);
      }
    }
    const float sc = cg >= 512 ? 0.125f : 1.f;
    u32x4 o; o.x = pack2(siluf(a[0]) * sc, siluf(a[1]) * sc); o.y = pack2(siluf(a[2]) * sc, siluf(a[3]) * sc);
    o.z = pack2(siluf(a[4]) * sc, siluf(a[5]) * sc); o.w = pack2(siluf(a[6]) * sc, siluf(a[7]) * sc);
    *(u32x4*)(c.hb + (size_t)r * 1024 + cg) = o;
  }
}

__device__ void phase_ma(int wv, ldsp lds, const Ctx& c) {
  int wvo = wv; asm volatile("" : "+s"(wvo)); int lno; asm volatile("v_mbcnt_lo_u32_b32 %0, -1, 0\n\tv_mbcnt_hi_u32_b32 %0, -1, %0" : "=v"(lno)); int tid = (wvo << 6) | lno; const int wid = tid >> 6, lane = tid & 63;
  ldsp sK = lds; ldsp sV = lds + 128 * 144; LAS float* sf = (LAS float*)(lds + 128 * 144 + 128 * 272);
  const u16* pre = c.big; u16* mc = c.big + MPRE_ELEMS;
  for (int item = blockIdx.x; item < 2 * 4 * 8 * 65; item += gridDim.x) {
    const int cs = item % 65; const int sq = item / 65; const int h = sq & 7, b = (sq >> 3) & 3, dir = sq >> 5;
    const int row0 = m_chunk_row0(b, dir, cs);
    if (wid == 0) {
      const float* gp = c.gates + (size_t)(row0 + 2 * lane) * 32 + dir * 16 + h;
      const float ig0 = gp[0], lf0 = logsig(gp[8]), ig1 = gp[32], lf1 = logsig(gp[40]);
      const float s2 = lf0 + lf1; float inc = s2;
#pragma unroll
      for (int d = 1; d < 64; d <<= 1) inc += shup(inc, d, lane, 0.f);
      const float total = lane63(inc); const float ex = inc - s2;
      const float g0 = (dir ? ex : total - ex - lf0) + ig0;
      const float g1 = (dir ? ex + lf0 : total - ex - lf0 - lf1) + ig1;
      float mx = fmaxf(g0, g1);
#pragma unroll
      for (int m = 1; m < 64; m <<= 1) mx = fmaxf(mx, shx(mx, m, lane));
      sf[256 + 2 * lane] = __expf(g0 - mx); sf[257 + 2 * lane] = __expf(g1 - mx);
      if (lane == 0) { c.mst_s[4224 + sq * 66 + cs] = total; c.mst_s[sq * 66 + cs] = mx; }
    }
    __syncthreads();
    { const int row = tid >> 2, part = tid & 3; const float w = sf[256 + row];
      const u16* kp = c.hb + (size_t)(row0 + row) * 1024 + 512 + h * 64 + part * 16;
#pragma unroll
      for (int q = 0; q < 2; ++q) { const u32x4 u = *(const u32x4*)(kp + q * 8); u32x4 o;
        o.x = pack2(lo2f(u.x) * w, hi2f(u.x) * w); o.y = pack2(lo2f(u.y) * w, hi2f(u.y) * w); o.z = pack2(lo2f(u.z) * w, hi2f(u.z) * w); o.w = pack2(lo2f(u.w) * w, hi2f(u.w) * w);
        *(LAS u32x4*)(sK + row * 144 + part * 32 + q * 16) = o; }
      const u16* vp = pre + (size_t)(row0 + row) * 3072 + 1024 + h * 128 + part * 32;
#pragma unroll
      for (int q = 0; q < 4; ++q) *(LAS u32x4*)(sV + row * 272 + part * 64 + q * 16) = *(const u32x4*)(vp + q * 8);
    }
    __syncthreads();
    f32x4 acc[4];
#pragma unroll
    for (int n = 0; n < 4; ++n) acc[n] = (f32x4){0.f, 0.f, 0.f, 0.f};
#pragma unroll
    for (int k0 = 0; k0 < 128; k0 += 32) {
      const bf16x8 a = frag_tr(sV, 272, wid * 16, k0, lane);
#pragma unroll
      for (int n = 0; n < 4; ++n) { const bf16x8 bb = frag_tr(sK, 144, n * 16, k0, lane); acc[n] = MFMA16(a, bb, acc[n]); }
    }
    u16* dst = mc + (size_t)(sq * 66 + cs) * 8192;
#pragma unroll
    for (int n = 0; n < 4; ++n)
#pragma unroll
      for (int r = 0; r < 4; ++r) dst[(wid * 16 + 4 * (lane >> 4) + r) * 64 + n * 16 + (lane & 15)] = f2bf(acc[n][r]);
    { float s = 0.f;
#pragma unroll
      for (int p = 0; p < 16; ++p) s += bf2f(*(LAS u16*)(sK + (wid * 16 + p) * 144 + lane * 2));
      sf[384 + wid * 64 + lane] = s; }
    __syncthreads();
    if (tid < 64) { float s = 0.f;
#pragma unroll
      for (int w8 = 0; w8 < 8; ++w8) s += sf[384 + w8 * 64 + tid];
      c.mst_n[(size_t)(sq * 66 + cs) * 64 + tid] = s; }
    __syncthreads();
  }
}

__device__ void phase_mb(int wv, const Ctx& c) {
  int wvo = wv; asm volatile("" : "+s"(wvo)); int lno; asm volatile("v_mbcnt_lo_u32_b32 %0, -1, 0\n\tv_mbcnt_hi_u32_b32 %0, -1, %0" : "=v"(lno)); int tid = (wvo << 6) | lno;
  u16* mc = c.big + MPRE_ELEMS;
  for (int item = blockIdx.x; item < 64 * 8; item += gridDim.x) {
    const int sq = item >> 3, slab = item & 7;
    unsigned* p = (unsigned*)(mc + (size_t)sq * 66 * 8192 + slab * 1024 + tid * 2);
    const bool nth = (slab == 0 && tid < 64);
    float* np = c.mst_n + (size_t)sq * 66 * 64 + tid;
    float m = -1e30f, c0 = 0.f, c1 = 0.f, cn = 0.f;
#pragma unroll 1
    for (int cb = 0; cb < 66; cb += 11) {
      unsigned loc[11]; float nl[11], bl[11], ml[11];
#pragma unroll
      for (int q = 0; q < 11; ++q) { const int cs = cb + q; loc[q] = 0u; nl[q] = 0.f; bl[q] = 0.f; ml[q] = 0.f;
        if (cs < 65) { loc[q] = p[(size_t)cs * 4096]; bl[q] = c.mst_s[4224 + sq * 66 + cs]; ml[q] = c.mst_s[sq * 66 + cs]; if (nth) nl[q] = np[cs * 64]; } }
#pragma unroll
      for (int q = 0; q < 11; ++q) { const int cs = cb + q;
        p[(size_t)cs * 4096] = pack2(c0, c1);
        if (nth) np[cs * 64] = cn;
        if (slab == 0 && tid == 0) c.mst_s[8448 + sq * 66 + cs] = m;
        if (cs < 65) {
          const float mn = fmaxf(bl[q] + m, ml[q]); const float wp = __expf(bl[q] + m - mn), wl = __expf(ml[q] - mn);
          c0 = wp * c0 + wl * lo2f(loc[q]); c1 = wp * c1 + wl * hi2f(loc[q]); cn = wp * cn + wl * nl[q]; m = mn;
        } }
    }
  }
}

__device__ void phase_mc(int wv, ldsp lds, const Ctx& c) {
  int wvo = wv; asm volatile("" : "+s"(wvo)); int lno; asm volatile("v_mbcnt_lo_u32_b32 %0, -1, 0\n\tv_mbcnt_hi_u32_b32 %0, -1, %0" : "=v"(lno)); int tid = (wvo << 6) | lno; const int wid = tid >> 6, lane = tid & 63;
  ldsp sQ = lds, sK = lds + 18432, sV = lds + 36864, sP = lds + 71680, sC0 = lds + 106496, sC1 = lds + 124928;
  LAS float* sf = (LAS float*)(lds + 143360);
  const u16* pre = c.big; const u16* mc = c.big + MPRE_ELEMS;
  for (int item = blockIdx.x; item < 4 * 8 * 66; item += gridDim.x) {
    const int j = item % 66; const int bh = item / 66; const int h = bh & 7, b = bh >> 3;
    const int row0 = j < 2 ? NL + b * 256 + j * 128 : b * 8192 + (j - 2) * 128;
    const int csf = j, csb = j < 2 ? 1 - j : 67 - j;
    const int sqf = b * 8 + h, sqb = 32 + b * 8 + h;
    const int d2 = tid >> 7, po = tid & 127;
    if (wid < 2) {
      const int dd = wid;
      const float* gp = c.gates + (size_t)(row0 + 2 * lane) * 32 + dd * 16 + h;
      const float ig0 = gp[0], lf0 = logsig(gp[8]), ig1 = gp[32], lf1 = logsig(gp[40]);
      const float s2 = lf0 + lf1; float inc = s2;
#pragma unroll
      for (int d = 1; d < 64; d <<= 1) inc += shup(inc, d, lane, 0.f);
      const float total = lane63(inc); const float ex = inc - s2;
      const float bb0 = dd ? total - ex : ex + lf0;
      const float bb1 = dd ? total - ex - lf0 : ex + s2;
      const float e0 = ig0 - bb0, e1 = ig1 - bb1, e01 = fmaxf(e0, e1);
      const float mpre = c.mst_s[8448 + (dd ? sqb * 66 + csb : sqf * 66 + csf)];
      float pm0, pm1;
      if (!dd) { float P = e01;
#pragma unroll
        for (int d = 1; d < 64; d <<= 1) P = fmaxf(P, shup(P, d, lane, -3.0e38f));
        const float xp = shup(P, 1, lane, -3.0e38f); pm0 = fmaxf(xp, e0); pm1 = fmaxf(xp, e01); }
      else { float S = e01;
#pragma unroll
        for (int d = 1; d < 64; d <<= 1) S = fmaxf(S, shdn(S, d, lane, -3.0e38f));
        const float xs = shdn(S, 1, lane, -3.0e38f); pm1 = fmaxf(xs, e1); pm0 = fmaxf(xs, e01); }
      const float M0 = fmaxf(mpre, pm0), M1 = fmaxf(mpre, pm1);
      const int o = dd * 128 + 2 * lane;
      sf[768 + o] = bb0; sf[769 + o] = bb1; sf[256 + o] = e0; sf[257 + o] = e1; sf[512 + o] = M0; sf[513 + o] = M1;
      sf[1024 + o] = __expf(mpre - M0); sf[1025 + o] = __expf(mpre - M1);
    }
    if (tid >= 256 && tid < 384) { const int q = tid - 256; const int d3 = q >> 6, dd = q & 63; sf[1536 + q] = c.mst_n[(size_t)(d3 ? sqb * 66 + csb : sqf * 66 + csf) * 64 + dd]; }
    { const int row = tid >> 2, part = tid & 3;
      const u16* qp = c.hb + (size_t)(row0 + row) * 1024 + h * 64 + part * 16;
#pragma unroll
      for (int q = 0; q < 2; ++q) { *(LAS u32x4*)(sQ + row * 144 + part * 32 + q * 16) = *(const u32x4*)(qp + q * 8); *(LAS u32x4*)(sK + row * 144 + part * 32 + q * 16) = *(const u32x4*)(qp + 512 + q * 8); }
      const u16* vp = pre + (size_t)(row0 + row) * 3072 + 1024 + h * 128 + part * 32;
#pragma unroll
      for (int q = 0; q < 4; ++q) *(LAS u32x4*)(sV + row * 272 + part * 64 + q * 16) = *(const u32x4*)(vp + q * 8);
      const u16* cf = mc + (size_t)(sqf * 66 + csf) * 8192 + row * 64 + part * 16; const u16* cb = mc + (size_t)(sqb * 66 + csb) * 8192 + row * 64 + part * 16;
#pragma unroll
      for (int q = 0; q < 2; ++q) { *(LAS u32x4*)(sC0 + row * 144 + part * 32 + q * 16) = *(const u32x4*)(cf + q * 8); *(LAS u32x4*)(sC1 + row * 144 + part * 32 + q * 16) = *(const u32x4*)(cb + q * 8); }
    }
    __syncthreads();
    { const int row = tid >> 2, part = tid & 3; float qf = 0.f, qb = 0.f;
#pragma unroll
      for (int q = 0; q < 2; ++q) { const u32x4 u = *(const LAS u32x4*)(sQ + row * 144 + part * 32 + q * 16); const int d0 = part * 16 + q * 8;
        const float v0 = lo2f(u.x), v1 = hi2f(u.x), v2 = lo2f(u.y), v3 = hi2f(u.y), v4 = lo2f(u.z), v5 = hi2f(u.z), v6 = lo2f(u.w), v7 = hi2f(u.w);
        qf += v0 * sf[1536 + d0] + v1 * sf[1537 + d0] + v2 * sf[1538 + d0] + v3 * sf[1539 + d0] + v4 * sf[1540 + d0] + v5 * sf[1541 + d0] + v6 * sf[1542 + d0] + v7 * sf[1543 + d0];
        qb += v0 * sf[1600 + d0] + v1 * sf[1601 + d0] + v2 * sf[1602 + d0] + v3 * sf[1603 + d0] + v4 * sf[1604 + d0] + v5 * sf[1605 + d0] + v6 * sf[1606 + d0] + v7 * sf[1607 + d0]; }
      qf += shx(qf, 1, lane); qf += shx(qf, 2, lane); qb += shx(qb, 1, lane); qb += shx(qb, 2, lane);
      if (part == 0) { sf[1280 + row] = qf; sf[1408 + row] = qb; } }
    f32x4 accS[8];
#pragma unroll
    for (int n = 0; n < 8; ++n) accS[n] = (f32x4){0.f, 0.f, 0.f, 0.f};
#pragma unroll
    for (int k0 = 0; k0 < 64; k0 += 32) {
      const bf16x8 a = frag_row(sQ, 144, wid * 16, k0, lane);
#pragma unroll
      for (int n = 0; n < 8; ++n) { const bf16x8 bb = frag_row(sK, 144, n * 16, k0, lane); accS[n] = MFMA16(a, bb, accS[n]); }
    }
    __syncthreads();
    f32x4 hs[8];
#pragma unroll
    for (int n = 0; n < 8; ++n) hs[n] = (f32x4){0.f, 0.f, 0.f, 0.f};
    const int tb = wid * 16 + 4 * (lane >> 4), sl = lane & 15;
#pragma unroll 1
    for (int dir = 0; dir < 2; ++dir) {
      float rs[4] = {0.f, 0.f, 0.f, 0.f}; float Mt[4];
#pragma unroll
      for (int r = 0; r < 4; ++r) Mt[r] = sf[512 + dir * 128 + tb + r];
#pragma unroll
      for (int n = 0; n < 8; ++n) { const int s = n * 16 + sl; const float es = sf[256 + dir * 128 + s];
#pragma unroll
        for (int r = 0; r < 4; ++r) { const int t = tb + r; const bool in = dir ? (s >= t) : (s <= t);
          const float pv = in ? accS[n][r] * __expf(es - Mt[r]) : 0.f; rs[r] += pv; *(LAS u16*)(sP + t * 272 + s * 2) = f2bf(pv); } }
#pragma unroll
      for (int r = 0; r < 4; ++r) rs[r] = red16l(rs[r], lane);
      float wi4[4], inv4[4];
#pragma unroll
      for (int r = 0; r < 4; ++r) { const int t = tb + r; const float wi = sf[1024 + dir * 128 + t];
        const float den = wi * sf[1280 + dir * 128 + t] + rs[r]; const float mt = sf[768 + dir * 128 + t] + Mt[r];
        wi4[r] = wi; inv4[r] = 1.f / fmaxf(fabsf(den), __expf(-mt)); }
      ldsp sC = dir ? sC1 : sC0;
#pragma unroll
      for (int eh = 0; eh < 2; ++eh) {
        f32x4 a1[4], a2[4];
#pragma unroll
        for (int n = 0; n < 4; ++n) { a1[n] = (f32x4){0.f, 0.f, 0.f, 0.f}; a2[n] = (f32x4){0.f, 0.f, 0.f, 0.f}; }
#pragma unroll
        for (int k0 = 0; k0 < 128; k0 += 32) { const bf16x8 a = frag_row(sP, 272, wid * 16, k0, lane);
#pragma unroll

#define FR_(n) frag_tr(sV, 272, (eh * 4 + (n)) * 16, k0, lane)
          SWEEP(4, 4, FR_, a, a1);
#undef FR_
        }
#pragma unroll
        for (int k0 = 0; k0 < 64; k0 += 32) { const bf16x8 a = frag_row(sQ, 144, wid * 16, k0, lane);
#pragma unroll

#define FR_(n) frag_row(sC, 144, (eh * 4 + (n)) * 16, k0, lane)
          SWEEP(4, 4, FR_, a, a2);
#undef FR_
        }
#pragma unroll
        for (int r = 0; r < 4; ++r)
#pragma unroll
          for (int n = 0; n < 4; ++n) hs[eh * 4 + n][r] += (a1[n][r] + wi4[r] * a2[n][r]) * inv4[r];
      }
    }
#pragma unroll
    for (int r = 0; r < 4; ++r) {
      float s = 0.f;
#pragma unroll
      for (int n = 0; n < 8; ++n) s += hs[n][r];
      const float mu = red16l(s, lane) * (1.f / 128.f); float v = 0.f;
#pragma unroll
      for (int n = 0; n < 8; ++n) { const float d = hs[n][r] - mu; v += d * d; }
      const float rstd = rsqrtf(red16l(v, lane) * (1.f / 128.f) + 1e-6f);
      const size_t row = row0 + tb + r;
#pragma unroll
      for (int n = 0; n < 8; ++n) { const int e = h * 128 + n * 16 + sl;
        const float og = bf2f(pre[row * 3072 + 2048 + e]);
        c.y[row * 1024 + e] = f2bf((hs[n][r] - mu) * rstd * c.m_norm_g[e] * sigmf(og)); }
    }
    __syncthreads();
  }
}

#define RUQ_ELEMS ((size_t)NT * 2048)
__device__ __forceinline__ float ret_lg(const Ctx& c, int dir, int h) { return logsig(c.r_decay[dir * 4 + h]); }

__device__ void phase_ra(int wv, ldsp lds, const Phase& ph, const Ctx& c) {
  int wvo = wv; asm volatile("" : "+s"(wvo)); int lno; asm volatile("v_mbcnt_lo_u32_b32 %0, -1, 0\n\tv_mbcnt_hi_u32_b32 %0, -1, %0" : "=v"(lno)); int tid = (wvo << 6) | lno; const int wid = tid >> 6, lane = tid & 63;
  ldsp sV = lds; ldsp sK = lds + 64 * 272;
  const u16* uq = c.big; u16* rst = c.big + RUQ_ELEMS; const int hp = ph.i0;
  for (int item = blockIdx.x; item < 1024; item += gridDim.x) {
    const int eq = item & 3, J = (item >> 2) & 15, hl = (item >> 6) & 1, b = (item >> 7) & 3, dir = item >> 9;
    const int sq = (dir * 4 + b) * 2 + hl; const float lg = ret_lg(c, dir, hp * 2 + hl);
    int row0, L; if (J == 0) { row0 = NL + b * 256; L = 256; } else { L = 512; row0 = b * 8192 + (dir ? 16 - J : J - 1) * 512; }
    f32x4 acc[16];
#pragma unroll
    for (int n = 0; n < 16; ++n) acc[n] = (f32x4){0.f, 0.f, 0.f, 0.f};
    const u16* vp = uq + (size_t)(row0 + (tid >> 4)) * 2048 + 1024 + hl * 512 + eq * 128 + (tid & 15) * 8;
    const u16* kp = uq + (size_t)(row0 + (tid >> 5)) * 2048 + 512 + hl * 256 + (tid & 31) * 8;
    u32x4 pv[2], pk[4];
#pragma unroll
    for (int q = 0; q < 2; ++q) pv[q] = *(const u32x4*)(vp + (size_t)q * 32 * 2048);
#pragma unroll
    for (int q = 0; q < 4; ++q) pk[q] = *(const u32x4*)(kp + (size_t)q * 16 * 2048);
    LDS_BAR();
#pragma unroll 1
    for (int s0 = 0; s0 < L; s0 += 64) {
      {
#pragma unroll
        for (int q = 0; q < 2; ++q) *(LAS u32x4*)(sV + (q * 32 + (tid >> 4)) * 272 + (tid & 15) * 16) = pv[q];
#pragma unroll
        for (int q = 0; q < 4; ++q) { const int krow = q * 16 + (tid >> 5); const int o = s0 + krow; const float z = __expf(lg * (float)(dir ? o : L - 1 - o)); const u32x4 u = pk[q]; u32x4 w;
          w.x = pack2(lo2f(u.x) * z, hi2f(u.x) * z); w.y = pack2(lo2f(u.y) * z, hi2f(u.y) * z); w.z = pack2(lo2f(u.z) * z, hi2f(u.z) * z); w.w = pack2(lo2f(u.w) * z, hi2f(u.w) * z);
          *(LAS u32x4*)(sK + krow * 528 + (tid & 31) * 16) = w; }
      }
      if (s0 + 64 < L) {
        const size_t adv = (size_t)(s0 + 64) * 2048;
#pragma unroll
        for (int q = 0; q < 2; ++q) pv[q] = *(const u32x4*)(vp + adv + (size_t)q * 32 * 2048);
#pragma unroll
        for (int q = 0; q < 4; ++q) pk[q] = *(const u32x4*)(kp + adv + (size_t)q * 16 * 2048);
      }
      LDS_BAR();
#pragma unroll
      for (int k0 = 0; k0 < 64; k0 += 32) { const bf16x8 a0 = frag_tr(sV, 272, (wid >> 1) * 32, k0, lane), a1 = frag_tr(sV, 272, (wid >> 1) * 32 + 16, k0, lane);
        bf16x8 bq[4];
#pragma unroll
        for (int n = 0; n < 4; ++n) bq[n] = frag_tr(sK, 528, (wid & 1) * 128 + n * 16, k0, lane);
        __builtin_amdgcn_sched_barrier(0);
#pragma unroll
        for (int n = 0; n < 8; ++n) { const bf16x8 cur = bq[n & 3]; if (n + 4 < 8) bq[n & 3] = frag_tr(sK, 528, (wid & 1) * 128 + (n + 4) * 16, k0, lane);
          acc[n] = MFMA16(a0, cur, acc[n]); acc[8 + n] = MFMA16(a1, cur, acc[8 + n]); __builtin_amdgcn_sched_barrier(0); }
      }
      LDS_BAR();
    }
    u16* dst = rst + (size_t)(sq * 16 + J) * 131072 + (size_t)(eq * 128 + (wid >> 1) * 32 + 4 * (lane >> 4)) * 256 + (wid & 1) * 128 + (lane & 15);
#pragma unroll
    for (int mi = 0; mi < 2; ++mi)
#pragma unroll
      for (int n = 0; n < 8; ++n)
#pragma unroll
        for (int r = 0; r < 4; ++r) dst[(mi * 16 + r) * 256 + n * 16] = f2bf(acc[mi * 8 + n][r]);
  }
}

__device__ void phase_rb(int wv, const Phase& ph, const Ctx& c) {
  int wvo = wv; asm volatile("" : "+s"(wvo)); int lno; asm volatile("v_mbcnt_lo_u32_b32 %0, -1, 0\n\tv_mbcnt_hi_u32_b32 %0, -1, %0" : "=v"(lno)); int tid = (wvo << 6) | lno; u16* rst = c.big + RUQ_ELEMS; const int hp = ph.i0;
  for (int item = blockIdx.x; item < 16 * 32; item += gridDim.x) {
    const int sq = item >> 5, slab = item & 31; const int hl = sq & 1, dir = sq >> 3;
    const float g512 = __expf(512.f * ret_lg(c, dir, hp * 2 + hl));
    u32x4* p = (u32x4*)(rst + (size_t)sq * 16 * 131072 + slab * 4096 + tid * 8);
    float cr[8];
#pragma unroll
    for (int q = 0; q < 8; ++q) cr[q] = 0.f;
    u32x4 uu[16];
#pragma unroll
    for (int J = 0; J < 16; ++J) uu[J] = p[(size_t)J * 16384];
#pragma unroll
    for (int J = 0; J < 16; ++J) {
      const u32x4 u = uu[J];
      cr[0] = g512 * cr[0] + lo2f(u.x); cr[1] = g512 * cr[1] + hi2f(u.x); cr[2] = g512 * cr[2] + lo2f(u.y); cr[3] = g512 * cr[3] + hi2f(u.y);
      cr[4] = g512 * cr[4] + lo2f(u.z); cr[5] = g512 * cr[5] + hi2f(u.z); cr[6] = g512 * cr[6] + lo2f(u.w); cr[7] = g512 * cr[7] + hi2f(u.w);
      u32x4 o; o.x = pack2(cr[0], cr[1]); o.y = pack2(cr[2], cr[3]); o.z = pack2(cr[4], cr[5]); o.w = pack2(cr[6], cr[7]);
      p[(size_t)J * 16384] = o;
    }
  }
}

__device__ __forceinline__ bf16x8 scale_frag(bf16x8 a, float s) {
  bf16x8 r;
#pragma unroll
  for (int q = 0; q < 8; ++q) r[q] = (short)f2bf(bf2f((u16)a[q]) * s);
  return r;
}

#define SWEEP2(NT, DEPTH, FRAG, A0, A1, ACC, OFF1) do { bf16x8 bq_[DEPTH]; __builtin_amdgcn_s_setprio(1); \
    _Pragma("unroll") for (int n_ = 0; n_ < DEPTH; ++n_) bq_[n_] = FRAG(n_); __builtin_amdgcn_sched_barrier(0); \
    _Pragma("unroll") for (int n_ = 0; n_ < NT; ++n_) { const bf16x8 cur_ = bq_[n_ % DEPTH]; if (n_ + DEPTH < NT) bq_[n_ % DEPTH] = FRAG(n_ + DEPTH); \
      ACC[n_] = MFMA16(A0, cur_, ACC[n_]); ACC[OFF1 + n_] = MFMA16(A1, cur_, ACC[OFF1 + n_]); __builtin_amdgcn_sched_barrier(0); } __builtin_amdgcn_s_setprio(0); } while (0)
__device__ void phase_rc(int wv, ldsp lds, const Phase& ph, const Ctx& c) {
  ldsp sQ = lds, sKP = lds + 67584, sV = lds + 102400;
  const u16* uq = c.big; const u16* rst = c.big + RUQ_ELEMS; const int hp = ph.i0;
  for (int item = blockIdx.x; item < 512; item += gridDim.x) {
    int wvo = wv; asm volatile("" : "+s"(wvo)); int lno; asm volatile("v_mbcnt_lo_u32_b32 %0, -1, 0\n\tv_mbcnt_hi_u32_b32 %0, -1, %0" : "=v"(lno)); int tid = (wvo << 6) | lno; const int wid = tid >> 6, lane = tid & 63;
    const int i = item & 3, Jo = (item >> 2) & 15, hl = (item >> 6) & 1, b = item >> 7;
    const int h = hp * 2 + hl; const float lgf = ret_lg(c, 0, h), lgb = ret_lg(c, 1, h);
    const int rowb = b * 8192 + Jo * 512;
    const unsigned kofs = (unsigned)((rowb + (tid >> 4)) * 2048 + 512 + hl * 256 + (tid & 15) * 8);
    const unsigned vofs = (unsigned)((rowb + (tid >> 6)) * 2048 + 1024 + hl * 512 + (tid & 63) * 8);
    const unsigned rofs = (unsigned)((tid >> 2) * 256 + (tid & 3) * 8);
    const u16* rs0 = rst + (size_t)(((0 * 4 + b) * 2 + hl) * 16 + Jo) * 131072;
    const u16* rs1 = rst + (size_t)(((1 * 4 + b) * 2 + hl) * 16 + (15 - Jo)) * 131072;
#define kbase (uq + kofs)
#define vbase (uq + vofs)
#define rbase0 (rs0 + rofs)
#define rbase1 (rs1 + rofs)
    const unsigned dK = (unsigned)((tid >> 4) * 272 + (tid & 15) * 16), dV = (unsigned)((tid >> 6) * 1040 + (tid & 63) * 16), dR = (unsigned)((tid >> 2) * 80 + (tid & 3) * 16);
    constexpr int KQ = 32 * 2048, VQ = 8 * 2048, RQ = 128 * 256, KD = 32 * 272, VD = 8 * 1040, RD = 128 * 80;
    u32x4 pf[4];
#pragma unroll
    for (int q = 0; q < 4; ++q) pf[q] = *(const u32x4*)(kbase + q * KQ);
    { const int row = tid >> 5, ch = tid & 31; const u16* qp = uq + (size_t)(rowb + i * 128 + row) * 2048 + hl * 256 + ch * 8;
#pragma unroll
      for (int q = 0; q < 8; ++q) *(LAS u32x4*)(sQ + (q * 16 + row) * 528 + ch * 16) = *(const u32x4*)(qp + (size_t)q * 16 * 2048); }
    f32x4 acc[32];
#pragma unroll
    for (int n = 0; n < 32; ++n) acc[n] = (f32x4){0.f, 0.f, 0.f, 0.f};
    const int mg = wid >> 1, ng = wid & 1, lq = lane >> 4, sl = lane & 15;
#pragma unroll 1
    for (int j = 0; j < 4; ++j) {
      f32x4 accS[8];
#pragma unroll
      for (int n = 0; n < 8; ++n) accS[n] = (f32x4){0.f, 0.f, 0.f, 0.f};
#pragma unroll 1
      for (int dh = 0; dh < 2; ++dh) {
        LDS_BAR();
#pragma unroll
        for (int q = 0; q < 4; ++q) *(LAS u32x4*)(sKP + dK + q * KD) = pf[q];
        { const u16* src = dh == 0 ? kbase + (size_t)j * 128 * 2048 + 128 : vbase + (size_t)(j * 128) * 2048; const int qs = dh == 0 ? KQ : VQ;
#pragma unroll
          for (int q = 0; q < 4; ++q) pf[q] = *(const u32x4*)(src + q * qs); }
        LDS_BAR();
#pragma unroll
        for (int k0 = 0; k0 < 128; k0 += 32) { const bf16x8 a0 = frag_row(sQ, 528, mg * 32, dh * 128 + k0, lane), a1 = frag_row(sQ, 528, mg * 32 + 16, dh * 128 + k0, lane);
#define FR_(n) frag_row(sKP, 272, ng * 64 + (n) * 16, k0, lane)
          SWEEP2(4, 2, FR_, a0, a1, accS, 4);
#undef FR_
        }
      }
      LDS_BAR();
#pragma unroll
      for (int mi = 0; mi < 2; ++mi)
#pragma unroll
        for (int n = 0; n < 4; ++n) { const int sc = ng * 64 + n * 16 + sl; const int os = j * 128 + sc;
#pragma unroll
          for (int r = 0; r < 4; ++r) { const int t = mg * 32 + mi * 16 + 4 * lq + r; const int df = i * 128 + t - os;
            float w = 0.f; if (df >= 0) w += __expf(lgf * (float)df); if (df <= 0) w += __expf(-lgb * (float)df);
            *(LAS u16*)(sKP + t * 272 + sc * 2) = f2bf(accS[mi * 4 + n][r] * w); } }
#pragma unroll 1
      for (int s4 = 0; s4 < 4; ++s4) {
        LDS_BAR();
#pragma unroll
        for (int q = 0; q < 4; ++q) *(LAS u32x4*)(sV + dV + q * VD) = pf[q];
        { const u16* src = s4 < 3 ? vbase + (size_t)(j * 128 + (s4 + 1) * 32) * 2048 : (j < 3 ? kbase + (size_t)(j + 1) * 128 * 2048 : rbase0); const int qs = s4 < 3 ? VQ : (j < 3 ? KQ : RQ);
#pragma unroll
          for (int q = 0; q < 4; ++q) pf[q] = *(const u32x4*)(src + q * qs); }
        LDS_BAR();
        const bf16x8 a0 = frag_row(sKP, 272, mg * 32, s4 * 32, lane), a1 = frag_row(sKP, 272, mg * 32 + 16, s4 * 32, lane);
#define FR_(n) frag_tr(sV, 1040, ng * 256 + (n) * 16, 0, lane)
        SWEEP2(16, 2, FR_, a0, a1, acc, 16);
#undef FR_
      }
    }
#pragma unroll 1
    for (int dir = 0; dir < 2; ++dir) {
      const int off = i * 128 + mg * 32 + sl;
      const float xi0 = dir ? __expf(lgb * (float)(512 - off)) : __expf(lgf * (float)(off + 1));
      const float xi1 = dir ? __expf(lgb * (float)(496 - off)) : __expf(lgf * (float)(off + 17));
#pragma unroll 1
      for (int ds = 0; ds < 8; ++ds) {
        LDS_BAR();
#pragma unroll
        for (int q = 0; q < 4; ++q) *(LAS u32x4*)(sV + dR + q * RD) = pf[q];
        if (ds < 7 || dir == 0) { const u16* src = ds < 7 ? (dir ? rbase1 : rbase0) + (ds + 1) * 32 : rbase1;
#pragma unroll
          for (int q = 0; q < 4; ++q) pf[q] = *(const u32x4*)(src + q * RQ); }
        LDS_BAR();
        const bf16x8 a0 = scale_frag(frag_row(sQ, 528, mg * 32, ds * 32, lane), xi0), a1 = scale_frag(frag_row(sQ, 528, mg * 32 + 16, ds * 32, lane), xi1);
#define FR_(n) frag_row(sV, 80, ng * 256 + (n) * 16, 0, lane)
        SWEEP2(16, 2, FR_, a0, a1, acc, 16);
#undef FR_
      }
    }
#undef kbase
#undef vbase
#undef rbase0
#undef rbase1
    LDS_BAR();
    LAS float* sst = (LAS float*)sKP;
#pragma unroll
    for (int mi = 0; mi < 2; ++mi)
#pragma unroll
      for (int r = 0; r < 4; ++r) { float sm = 0.f;
#pragma unroll
        for (int n = 0; n < 16; ++n) sm += acc[mi * 16 + n][r];
        sm = red16l(sm, lane);
        if (sl == 0) sst[ng * 128 + mg * 32 + mi * 16 + 4 * lq + r] = sm; }
    LDS_BAR();
#pragma unroll
    for (int mi = 0; mi < 2; ++mi)
#pragma unroll
      for (int r = 0; r < 4; ++r) { const int t = mg * 32 + mi * 16 + 4 * lq + r; const float mu = (sst[t] + sst[128 + t]) * (1.f / 512.f); float v = 0.f;
#pragma unroll
        for (int n = 0; n < 16; ++n) { const float d = acc[mi * 16 + n][r] - mu; v += d * d; }
        v = red16l(v, lane);
        if (sl == 0) sst[256 + ng * 128 + t] = v; }
    LDS_BAR();
#pragma unroll
    for (int mi = 0; mi < 2; ++mi)
#pragma unroll
      for (int r = 0; r < 4; ++r) { const int t = mg * 32 + mi * 16 + 4 * lq + r; const float mu = (sst[t] + sst[128 + t]) * (1.f / 512.f);
        const float rstd = rsqrtf((sst[256 + t] + sst[384 + t]) * (1.f / 512.f) + 1e-6f);
        const size_t row = rowb + i * 128 + t;
#pragma unroll
        for (int n = 0; n < 16; ++n) { const int e = h * 512 + ng * 256 + n * 16 + sl; c.y[row * 2048 + e] = f2bf((acc[mi * 16 + n][r] - mu) * rstd * c.r_norm_g[e]); } }
    LDS_BAR();
  }
}

#define XB_TMO      128
#define XB_XCNT(j)  (256  + 64 * (j))
#define XB_XSUB(j)  (1280 + 64 * (j))
#define XB_XGEN(j)  (2304 + 64 * (j))
#define XB_TOP      3328
#define XB_TOPGEN   3392
#define XCD_BAR_WORDS 3456
#define XB_SPIN_CAP (1u << 18)
__device__ __forceinline__ unsigned xb_ld(unsigned* p)              { return __hip_atomic_load(p, __ATOMIC_RELAXED, __HIP_MEMORY_SCOPE_AGENT); }
__device__ __forceinline__ unsigned xb_add(unsigned* p, unsigned v) { return __hip_atomic_fetch_add(p, v, __ATOMIC_RELAXED, __HIP_MEMORY_SCOPE_AGENT); }
__device__ __forceinline__ unsigned xb_xcc_id() { return (unsigned)__builtin_amdgcn_s_getreg((3 << 11) | 20) & 0xFu; }
#define XB_SPIN(cond, bar) do { unsigned _sp = 0; while (cond) { __builtin_amdgcn_s_sleep(1); \
    if ((++_sp & 255u) == 0u) { if (xb_ld(&(bar)[XB_TMO])) break; if (_sp > XB_SPIN_CAP) { atomicAdd(&(bar)[XB_TMO], 1u); break; } } } } while (0)
struct XcdBarrier { unsigned* bar; unsigned x; volatile LAS unsigned* st; };
__device__ __forceinline__ XcdBarrier xcd_barrier_post(unsigned* bar, volatile LAS unsigned* st) {
    XcdBarrier b; b.bar = bar; b.x = xb_xcc_id(); b.st = st;
    if (threadIdx.x == 0) (void)xb_add(&bar[XB_XCNT(b.x)], 1u);
    return b;
}
__device__ __forceinline__ void xcd_barrier_complete(unsigned* bar, unsigned x, unsigned& nloc, unsigned& nx) {
    const unsigned G = gridDim.x * gridDim.y * gridDim.z;
    unsigned sum, cnt, mine, sp = 0u;
    for (;;) {
        sum = 0u; cnt = 0u; mine = 0u;
#pragma unroll
        for (unsigned j = 0; j < 16; ++j) { const unsigned c = xb_ld(&bar[XB_XCNT(j)]); sum += c; cnt += (c > 0u) ? 1u : 0u; mine = (j == x) ? c : mine; }
        if (sum == G) break;
        __builtin_amdgcn_s_sleep(1);
        if ((++sp & 255u) == 0u) { if (xb_ld(&bar[XB_TMO])) break; if (sp > XB_SPIN_CAP) { atomicAdd(&bar[XB_TMO], 1u); break; } }
    }
    nloc = mine > 0u ? mine : 1u; nx = cnt > 0u ? cnt : 1u;
}
__device__ __forceinline__ void xcd_barrier(const XcdBarrier& b, int wv) {
    asm volatile("s_waitcnt vmcnt(0)" ::: "memory");
    __syncthreads();
    int lno; asm volatile("v_mbcnt_lo_u32_b32 %0, -1, 0\n\tv_mbcnt_hi_u32_b32 %0, -1, %0" : "=v"(lno));
    if (wv == 0 && lno == 0) {
        unsigned* bar = b.bar;
        __builtin_amdgcn_s_waitcnt(0);
        unsigned nloc = b.st[0], nx = b.st[1];
        if (nloc == 0u) { xcd_barrier_complete(bar, b.x, nloc, nx); b.st[0] = nloc; b.st[1] = nx; }
        const unsigned old = xb_add(&bar[XB_XSUB(b.x)], 1u);
        const unsigned gen = old / nloc;
        if (old + 1u == (gen + 1u) * nloc) {
            __builtin_amdgcn_fence(__ATOMIC_RELEASE, "agent");
            asm volatile("s_waitcnt vmcnt(0)" ::: "memory");
            const unsigned og = xb_add(&bar[XB_TOP], 1u);
            const unsigned tg = og / nx;
            if (og + 1u == (tg + 1u) * nx) xb_add(&bar[XB_TOPGEN], 1u);
            else XB_SPIN(xb_ld(&bar[XB_TOPGEN]) == tg, bar);
            __builtin_amdgcn_fence(__ATOMIC_ACQUIRE, "agent");
            xb_add(&bar[XB_XGEN(b.x)], 1u);
            asm volatile("s_waitcnt vmcnt(0)" ::: "memory");
        } else {
            XB_SPIN(xb_ld(&bar[XB_XGEN(b.x)]) == gen, bar);
            __builtin_amdgcn_fence(__ATOMIC_ACQUIRE, "agent");
            asm volatile("s_waitcnt vmcnt(0)" ::: "memory");
        }
    }
    __syncthreads();
}

__global__ void __launch_bounds__(512) fwd_megakernel(Params p) {
  extern __shared__ __attribute__((aligned(16))) unsigned char shm[];
  ldsp lds = (ldsp)shm;
  cg::grid_group grid = cg::this_grid();
  const int wv = __builtin_amdgcn_readfirstlane((int)(threadIdx.x >> 6));
  volatile LAS unsigned* xst = (volatile LAS unsigned*)(lds + LDS_BYTES - 16);
  if (threadIdx.x == 0) { xst[0] = 0u; xst[1] = 0u; }
  __syncthreads();
  const XcdBarrier xb = xcd_barrier_post(p.c.bar, xst);
#pragma unroll 1
  for (int pi = 0; pi < p.nph; ++pi) {
    const Phase& ph = p.ph[pi];
    switch (ph.type) {
      case PH_INIT:
#ifndef NO_INIT
      phase_init(wv, lds, p.c);
#endif
      break;
      case PH_NORM:
#ifndef NO_NORM
      phase_norm(wv, lds, ph, p.c);
#endif
      break;
      case PH_GEMM:
#ifndef NO_GEMM
      gemm_phase(wv, lds, ph, p.c);
#endif
      break;
      case PH_MCONV:
#ifndef NO_MCONV
      phase_mconv(wv, p.c);
#endif
      break;
      case PH_MA:
#ifndef NO_MA
      phase_ma(wv, lds, p.c);
#endif
      break;
      case PH_MB:
#ifndef NO_MB
      phase_mb(wv, p.c);
#endif
      break;
      case PH_MC:
#ifndef NO_MC
      phase_mc(wv, lds, p.c);
#endif
      break;
      case PH_RA:
#ifndef NO_RA
      phase_ra(wv, lds, ph, p.c);
#endif
      break;
      case PH_RB:
#ifndef NO_RB
      phase_rb(wv, ph, p.c);
#endif
      break;
      case PH_RC:
#ifndef NO_RC
      phase_rc(wv, lds, ph, p.c);
#endif
      break;
      case PH_FINAL: phase_final(wv, p.c); break;
      default: break;
    }
    if (pi == 0) grid.sync(); else xcd_barrier(xb, wv);
  }
}

static void add_phase(Params& P, int type, int M, int N, int K, int i0, int i1, float f0, int pad, const void* A, const void* B, void* O, const void* X) {
  const int reps = (((DUP_TYPES >> type) & 1u) && (type != PH_GEMM || ((DUP_EPIS >> i0) & 1u))) ? 2 : 1;
  for (int rep = 0; rep < reps; ++rep) {
  Phase& ph = P.ph[P.nph++]; ph.type = type; ph.M = M; ph.N = N; ph.K = K; ph.i0 = i0; ph.i1 = i1; ph.f0 = f0; ph.pad = pad; ph.A = A; ph.B = B; ph.O = O; ph.X = X;
  }
}

extern "C" void kernel_launch(void* const* d_in, const int* in_sizes, int n_in, void* d_out, int out_size, void* d_ws, size_t ws_size, hipStream_t stream) {
  static int grid_blocks = 0;
  if (!grid_blocks) {
    int dev = 0, cus = 0, per_cu = 0;
    hipGetDevice(&dev);
    hipDeviceGetAttribute(&cus, hipDeviceAttributeMultiprocessorCount, dev);
    hipFuncSetAttribute((const void*)fwd_megakernel, hipFuncAttributeMaxDynamicSharedMemorySize, LDS_BYTES);
    hipOccupancyMaxActiveBlocksPerMultiprocessor(&per_cu, (const void*)fwd_megakernel, 512, LDS_BYTES);
    if (per_cu < 1) per_cu = 1;
    grid_blocks = cus * per_cu;
  }
  Params P; memset(&P, 0, sizeof(P));
  Ctx& c = P.c;
  c.x = (const float*)d_in[0]; c.c = (const float*)d_in[1]; c.ctx = (const float*)d_in[2]; c.c_ctx = (const float*)d_in[3];
  c.mod_w = (const float*)d_in[4]; c.mod_b = (const float*)d_in[5]; c.norm_g = (const float*)d_in[6]; c.w13 = (const float*)d_in[7]; c.w2 = (const float*)d_in[8];
  c.m_w_in = (const float*)d_in[9]; c.m_gate_b = (const float*)d_in[10]; c.m_conv_w = (const float*)d_in[11]; c.m_norm_g = (const float*)d_in[12]; c.m_w_out = (const float*)d_in[13];
  c.r_w_in = (const float*)d_in[14]; c.r_decay = (const float*)d_in[15]; c.r_norm_g = (const float*)d_in[16]; c.r_w_out = (const float*)d_in[17]; c.final_g = (const float*)d_in[18];
  c.out = (float*)d_out; c.y = (u16*)d_out;
  char* w = (char*)d_ws; size_t off = 0;
  auto take = [&](size_t bytes) { char* r = w + off; off += (bytes + 255) & ~(size_t)255; return r; };
  c.bar = (unsigned*)take((size_t)XCD_BAR_WORDS * 4);
  c.modv = (float*)take((size_t)2 * 5 * 9216 * 4);
  c.rope = (float*)take((size_t)8192 * 128 * 8);
  c.gates = (float*)take((size_t)NT * 32 * 4);
  c.mst_n = (float*)take((size_t)64 * 66 * 64 * 4);
  c.mst_s = (float*)take((size_t)3 * 4224 * 4);
  c.xr = (float*)take((size_t)NT * 1024 * 4);
  c.hb = (u16*)take((size_t)NT * 1024 * 2);
  c.wb = (u16*)take((size_t)(5632 + 2816) * 1024 * 2);
  c.big = (u16*)take((size_t)NT * 3072 * 2 + (size_t)64 * 66 * 8192 * 2);
  c.part = (float*)((char*)c.big + (size_t)NT * 2816 * 2);
  c.part2 = (float*)take((size_t)4 * 1024 * 1024 * 4);
  if (off > ws_size) { fprintf(stderr, "workspace too small: need %zu have %zu\n", off, ws_size); return; }
  u16* hid = c.big;
  for (int l = 0; l < 2; ++l) {
    if (l == 0) add_phase(P, PH_INIT, 0, 0, 0, 0, 0, 0.f, 0, nullptr, nullptr, nullptr, nullptr);
    const float* modl = c.modv + (size_t)l * 5 * 9216;
    add_phase(P, PH_NORM, NT, l == 0 ? 1 : (NSPL << 8), 0, l, 0, 0.5f, 0, nullptr, nullptr, nullptr, c.modv + 8 * 1024);
    add_phase(P, PH_GEMM, NT, 5632, 1024, EPI_SWIGLU, 0, 0.f, 0, c.hb, c.wb, hid, nullptr);
    add_phase(P, PH_GEMM, NT, 1024, 2816, EPI_RESID, SPLITF | (l == 0 ? 2 : 0), 0.5f, 0, hid, c.wb + (size_t)5632 * 1024, c.xr, modl + 2 * 1024);
    if (l == 0) {
      add_phase(P, PH_NORM, NT, NSPL << 8, 0, l, 1, 0.5f, 1, nullptr, nullptr, nullptr, modl + 2 * 1024);
      add_phase(P, PH_GEMM, NT, 3328, 1024, EPI_MLSTM_U, 0, 0.f, 0, c.hb, c.wb, c.big, nullptr);
      add_phase(P, PH_MCONV, 0, 0, 0, 0, 0, 0.f, 0, nullptr, nullptr, nullptr, nullptr);
      add_phase(P, PH_MA, 0, 0, 0, 0, 0, 0.f, 0, nullptr, nullptr, nullptr, nullptr);
      add_phase(P, PH_MB, 0, 0, 0, 0, 0, 0.f, 0, nullptr, nullptr, nullptr, nullptr);
      add_phase(P, PH_MC, 0, 0, 0, 0, 0, 0.f, 0, nullptr, nullptr, nullptr, nullptr);
      add_phase(P, PH_GEMM, NT, 1024, 1024, EPI_RESID, 1 | 4, 1.0f, 0, c.y, c.wb + (size_t)3328 * 1024, c.xr, modl + 5 * 1024);
    } else {
      add_phase(P, PH_NORM, NT, NSPL << 8, 0, l, 1, 0.5f, 2, nullptr, nullptr, nullptr, modl + 2 * 1024);
      for (int hp = 0; hp < 2; ++hp) {
        add_phase(P, PH_GEMM, NT, 2048, 1024, EPI_RET_U, 0, 0.f, 0, c.hb, c.wb + (size_t)hp * 2048 * 1024, c.big, nullptr);
        add_phase(P, PH_RA, 0, 0, 0, hp, 0, 0.f, 0, nullptr, nullptr, nullptr, nullptr);
        add_phase(P, PH_RB, 0, 0, 0, hp, 0, 0.f, 0, nullptr, nullptr, nullptr, nullptr);
        add_phase(P, PH_RC, 0, 0, 0, hp, 0, 0.f, 0, nullptr, nullptr, nullptr, nullptr);
      }
      add_phase(P, PH_GEMM, NL, 2048, 1024, EPI_GATE, 0, 0.f, 0, c.hb, c.wb + (size_t)4096 * 1024, c.y, nullptr);
      add_phase(P, PH_GEMM, NL, 1024, 2048, EPI_RESID, 0, 1.0f, 0, c.y, c.wb + (size_t)6144 * 1024, c.xr, modl + 5 * 1024);
    }
    const int M2 = l == 1 ? NL : NT;
    add_phase(P, PH_NORM, M2, l == 0 ? ((4 << 8) | 2) : 0, 1, l, 2, 1.0f, 0, nullptr, nullptr, nullptr, modl + 5 * 1024);
    add_phase(P, PH_GEMM, M2, 5632, 1024, EPI_SWIGLU, 0, 0.f, 0, c.hb, c.wb, hid, nullptr);
    add_phase(P, PH_GEMM, M2, 1024, 2816, EPI_RESID, l == 0 ? SPLITF : 16, 0.5f, 0, hid, c.wb + (size_t)5632 * 1024, c.xr, modl + 8 * 1024);
  }
#ifdef EXTRA_NOPS
  for (int q = 0; q < EXTRA_NOPS; ++q) add_phase(P, PH_NOP, 0, 0, 0, 0, 0, 0.f, 0, nullptr, nullptr, nullptr, nullptr);
#endif
  add_phase(P, PH_FINAL, 0, 0, 0, 0, 0, 0.f, 0, nullptr, nullptr, nullptr, nullptr);
  hipMemsetAsync(c.bar, 0, (size_t)XCD_BAR_WORDS * 4, stream);
  void* args[] = {&P};
  hipError_t e = hipLaunchCooperativeKernel((const void*)fwd_megakernel, dim3(grid_blocks), dim3(512), args, LDS_BYTES, stream);
  if (e != hipSuccess) fprintf(stderr, "cooperative launch failed: %s (grid %d)\n", hipGetErrorString(e), grid_blocks);
}
```
